# Optimizing an MI355X kernel written in HIP

```python
import math
import jax
import jax.numpy as jnp
from jax import lax
import numpy as np

D_MODEL = 2048
BATCH = 2
SEQ = 4096
DEPTH = 1
DEC_BATCH = 8
DEC_SEQ = 8
PAST_LEN = 16384
PAGE_SIZE = 128

MIX_WIDTH = D_MODEL
MLSTM_WIDTH = MIX_WIDTH // 2
ATT_WIDTH = MIX_WIDTH - MLSTM_WIDTH
MLSTM_HEADS = 4
MLSTM_HEAD_DIM = MLSTM_WIDTH // MLSTM_HEADS
MLSTM_CHUNK = 128
ATT_HEADS = 8
ATT_HEAD_DIM = ATT_WIDTH // ATT_HEADS
MOBA_BLOCK = 256
MOBA_TOPK = 3
QUERY_BLOCK = 128
ROPE_THETA = 10000.0
D_FF = ((8 * D_MODEL // 3 + 255) // 256) * 256
CONV_WIDTH = 3
NORM_EPS = 1e-6
FORGET_BIAS = 3.0
N_IN = 4 * MLSTM_WIDTH + 2 * MLSTM_HEADS + 3 * ATT_WIDTH

kernel_name = 'hymba_mlstm_moba_convffn_step'


def _in_splits():
    sizes = [MLSTM_WIDTH] * 4 + [MLSTM_HEADS] * 2 + [ATT_WIDTH] * 3
    return [int(s) for s in np.cumsum(sizes)[:-1]]


def _rms_norm(x, g):
    xf = x.astype(jnp.float32)
    y = xf * lax.rsqrt(jnp.mean(xf * xf, axis=-1, keepdims=True) + NORM_EPS)
    return (y * g.astype(jnp.float32)).astype(x.dtype)


def _rope(x, pos):
    half = x.shape[-1] // 2
    inv_freq = ROPE_THETA ** (-jnp.arange(half, dtype=jnp.float32) / half)
    ang = pos.astype(jnp.float32)[:, None] * inv_freq[None, :]
    cos = jnp.cos(ang)[None, :, None, :]
    sin = jnp.sin(ang)[None, :, None, :]
    xf = x.astype(jnp.float32)
    x1, x2 = xf[..., :half], xf[..., half:]
    return jnp.concatenate([x1 * cos - x2 * sin, x2 * cos + x1 * sin], axis=-1).astype(x.dtype)


def _mlstm_chunk(carry, inp):
    c_prev, n_prev, m_prev = carry
    q, k, v, ig, lf = inp
    L = q.shape[1]
    b = jnp.cumsum(lf, axis=1).transpose(0, 2, 1)
    ig = ig.transpose(0, 2, 1)
    causal = jnp.tril(jnp.ones((L, L), dtype=bool))
    log_d = jnp.where(causal, b[..., :, None] - b[..., None, :] + ig[..., None, :], -jnp.inf)
    log_inter = b + m_prev[..., None]
    m_t = jnp.maximum(log_inter, jnp.max(log_d, axis=-1))
    s = jnp.einsum('blhd,bshd->bhls', q, k) * jnp.exp(log_d - m_t[..., None])
    inter = jnp.exp(log_inter - m_t)
    num = jnp.einsum('bhls,bshv->bhlv', s, v) + inter[..., None] * jnp.einsum('bhvd,blhd->bhlv', c_prev, q)
    den = jnp.sum(s, axis=-1) + inter * jnp.einsum('bhd,blhd->bhl', n_prev, q)
    h = num / jnp.maximum(jnp.abs(den), jnp.exp(-m_t))[..., None]
    m_new = m_t[..., -1]
    w = jnp.exp(b[..., -1:] - b + ig - m_new[..., None])
    decay = jnp.exp(b[..., -1] + m_prev - m_new)
    c_new = decay[..., None, None] * c_prev + jnp.einsum('bhs,bshv,bshd->bhvd', w, v, k)
    n_new = decay[..., None] * n_prev + jnp.einsum('bhs,bshd->bhd', w, k)
    return (c_new, n_new, m_new), h.transpose(0, 2, 1, 3)


def _mlstm(q, k, v, ig, lf, c0, n0, m0):
    B, T = q.shape[:2]
    cs = math.gcd(T, MLSTM_CHUNK)
    nc = T // cs

    def chunks(a):
        return jnp.moveaxis(a.astype(jnp.float32).reshape((B, nc, cs) + a.shape[2:]), 1, 0)

    carry0 = (c0.astype(jnp.float32), n0.astype(jnp.float32), m0.astype(jnp.float32))
    (c, n, m), h = lax.scan(_mlstm_chunk, carry0, (chunks(q), chunks(k), chunks(v), chunks(ig), chunks(lf)))
    h = jnp.moveaxis(h, 0, 1).reshape(B, T, MLSTM_HEADS, MLSTM_HEAD_DIM)
    return h, c, n, m


def _moba_blocks(k, v):
    B, L, H, D = k.shape
    nb = -(-L // MOBA_BLOCK)
    pad = nb * MOBA_BLOCK - L

    def blocks(a):
        a = jnp.pad(a, ((0, 0), (0, pad), (0, 0), (0, 0)))
        return a.reshape(B, nb, MOBA_BLOCK, H, D).transpose(0, 3, 1, 2, 4)

    kb = blocks(k)
    vb = blocks(v)
    kmean = jnp.mean(kb.astype(jnp.float32), axis=3)
    return kb, vb, kmean


def _moba_attend(q, qpos, kb, vb, kmean):
    B, Q, H, D = q.shape
    nb = kb.shape[2]
    n_sel = min(MOBA_TOPK, nb - 1)
    qf = q.astype(jnp.float32)
    own = qpos // MOBA_BLOCK
    bi = jnp.arange(B)[:, None, None]
    hi = jnp.arange(H)[None, None, :]
    kpos_own = own[:, None] * MOBA_BLOCK + jnp.arange(MOBA_BLOCK)[None, :]
    sel = [jnp.broadcast_to(own[None, :, None], (B, Q, H))]
    masks = [(kpos_own <= qpos[:, None])[None, :, None, :]]
    if n_sel > 0:
        blk = jnp.einsum('bqhd,bhnd->bqhn', qf, kmean)
        past = jnp.arange(nb)[None, :] < own[:, None]
        blk = jnp.where(past[None, :, None, :], blk, -jnp.inf)
        _, top = lax.top_k(blk, n_sel)
        for s in range(n_sel):
            sel.append(top[..., s])
            masks.append((own > s)[None, :, None, None])
    scale = D ** -0.5
    scores = []
    for idx, mask in zip(sel, masks):
        ks = kb[bi, hi, idx]
        sc = jnp.einsum('bqhd,bqhkd->bqhk', qf, ks.astype(jnp.float32)) * scale
        scores.append(jnp.where(mask, sc, -jnp.inf))
    p = jax.nn.softmax(jnp.concatenate(scores, axis=-1), axis=-1)
    out = jnp.zeros((B, Q, H, D), jnp.float32)
    for s, idx in enumerate(sel):
        vs = vb[bi, hi, idx]
        out = out + jnp.einsum('bqhk,bqhkd->bqhd', p[..., s * MOBA_BLOCK:(s + 1) * MOBA_BLOCK], vs.astype(jnp.float32))
    return out.astype(q.dtype)


def _conv_ffn(x, conv_state, norm_g, w_up, conv_w, conv_b, w_down):
    T = x.shape[1]
    u = _rms_norm(x, norm_g) @ w_up
    ext = jnp.concatenate([conv_state.astype(u.dtype), u], axis=1)
    conv = conv_b + conv_w[0] * ext[:, 0:T]
    for j in range(1, CONV_WIDTH):
        conv = conv + conv_w[j] * ext[:, j:j + T]
    gate, up = jnp.split(conv, 2, axis=-1)
    y = (jax.nn.silu(gate) * up) @ w_down
    return y, ext[:, T:]


def _decoder_layer(x, pos, past_k, past_v, c0, n0, m0, conv0,
                   norm1_g, w_in, b_gates, mlstm_norm_g, w_out, norm2_g, w_up, conv_w, conv_b, w_down):
    B, T, _ = x.shape
    h = _rms_norm(x, norm1_g)
    proj = h @ w_in
    mq, mk, mv, mo, mi, mf, aq, ak, av = jnp.split(proj, _in_splits(), axis=-1)

    def heads_m(a):
        return a.reshape(B, T, MLSTM_HEADS, MLSTM_HEAD_DIM)

    def heads_a(a):
        return a.reshape(B, T, ATT_HEADS, ATT_HEAD_DIM)

    ig = (mi + b_gates[:MLSTM_HEADS]).astype(jnp.float32)
    lf = jax.nn.log_sigmoid((mf + b_gates[MLSTM_HEADS:]).astype(jnp.float32))
    hm, c_new, n_new, m_new = _mlstm(heads_m(mq), heads_m(mk) * (MLSTM_HEAD_DIM ** -0.5), heads_m(mv),
                                     ig, lf, c0, n0, m0)
    hm = _rms_norm(hm, mlstm_norm_g.reshape(MLSTM_HEADS, MLSTM_HEAD_DIM)) * jax.nn.sigmoid(heads_m(mo).astype(jnp.float32))

    q = _rope(heads_a(aq), pos)
    k_new = _rope(heads_a(ak), pos)
    v_new = heads_a(av)
    if past_k is None:
        k_all, v_all = k_new, v_new
    else:
        k_all = jnp.concatenate([past_k.astype(k_new.dtype), k_new], axis=1)
        v_all = jnp.concatenate([past_v.astype(v_new.dtype), v_new], axis=1)
    kb, vb, kmean = _moba_blocks(k_all, v_all)
    qc = math.gcd(T, QUERY_BLOCK)
    nq = T // qc
    q_blocks = jnp.moveaxis(q.reshape(B, nq, qc, ATT_HEADS, ATT_HEAD_DIM), 1, 0)
    attn = lax.map(lambda qp: _moba_attend(qp[0], qp[1], kb, vb, kmean), (q_blocks, pos.reshape(nq, qc)))
    attn = jnp.moveaxis(attn, 0, 1).reshape(B, T, ATT_WIDTH)

    mixed = jnp.concatenate([hm.reshape(B, T, MLSTM_WIDTH).astype(x.dtype), attn], axis=-1) @ w_out
    x = x + mixed
    ffn, conv_new = _conv_ffn(x, conv0, norm2_g, w_up, conv_w, conv_b, w_down)
    x = x + ffn
    return x, k_new, v_new, c_new.astype(x.dtype), n_new.astype(x.dtype), m_new.astype(x.dtype), conv_new


def setup_inputs(seed: int = 0) -> dict:
    key = jax.random.key(seed)
    ks = jax.random.split(key, 24)
    f32 = jnp.float32
    n_pages = PAST_LEN // PAGE_SIZE
    n_used = DEC_BATCH * n_pages
    n_pool = n_used + max(1, n_used // 4)
    two_f = 2 * D_FF

    def nrm(k, shape, s):
        return s * jax.random.normal(k, shape, f32)

    x_prompt = nrm(ks[0], (BATCH, SEQ, D_MODEL), 1.0)
    x_sample = nrm(ks[1], (DEC_BATCH, DEC_SEQ, D_MODEL), 1.0)
    cache_k = nrm(ks[2], (DEPTH, n_pool, PAGE_SIZE, ATT_HEADS, ATT_HEAD_DIM), 1.0)
    cache_v = nrm(ks[3], (DEPTH, n_pool, PAGE_SIZE, ATT_HEADS, ATT_HEAD_DIM), 1.0)
    page_table = jax.random.permutation(ks[4], n_pool)[:n_used].reshape(DEC_BATCH, n_pages).astype(jnp.int32)
    state_mlstm_C = nrm(ks[5], (DEPTH, DEC_BATCH, MLSTM_HEADS, MLSTM_HEAD_DIM, MLSTM_HEAD_DIM), MLSTM_HEAD_DIM ** -0.5)
    state_mlstm_n = nrm(ks[6], (DEPTH, DEC_BATCH, MLSTM_HEADS, MLSTM_HEAD_DIM), 0.1)
    state_mlstm_m = nrm(ks[7], (DEPTH, DEC_BATCH, MLSTM_HEADS), 1.0)
    state_conv = nrm(ks[8], (DEPTH, DEC_BATCH, CONV_WIDTH - 1, two_f), 1.0)
    norm1_g = 1.0 + nrm(ks[9], (DEPTH, D_MODEL), 0.02)
    w_in = nrm(ks[10], (DEPTH, D_MODEL, N_IN), D_MODEL ** -0.5)
    b_gates = jnp.concatenate([nrm(ks[11], (DEPTH, MLSTM_HEADS), 0.1),
                               FORGET_BIAS + nrm(ks[12], (DEPTH, MLSTM_HEADS), 0.1)], axis=-1)
    mlstm_norm_g = 1.0 + nrm(ks[13], (DEPTH, MLSTM_WIDTH), 0.02)
    w_out = nrm(ks[14], (DEPTH, MIX_WIDTH, D_MODEL), MIX_WIDTH ** -0.5)
    norm2_g = 1.0 + nrm(ks[15], (DEPTH, D_MODEL), 0.02)
    w_up = nrm(ks[16], (DEPTH, D_MODEL, two_f), D_MODEL ** -0.5)
    conv_w = nrm(ks[17], (DEPTH, CONV_WIDTH, two_f), CONV_WIDTH ** -0.5)
    conv_b = nrm(ks[18], (DEPTH, two_f), 0.02)
    w_down = nrm(ks[19], (DEPTH, D_FF, D_MODEL), D_FF ** -0.5)
    norm_f_g = 1.0 + nrm(ks[20], (D_MODEL,), 0.02)
    return {'x_prompt': x_prompt, 'x_sample': x_sample, 'cache_k': cache_k, 'cache_v': cache_v,
            'page_table': page_table, 'state_mlstm_C': state_mlstm_C, 'state_mlstm_n': state_mlstm_n,
            'state_mlstm_m': state_mlstm_m, 'state_conv': state_conv, 'norm1_g': norm1_g, 'w_in': w_in,
            'b_gates': b_gates, 'mlstm_norm_g': mlstm_norm_g, 'w_out': w_out, 'norm2_g': norm2_g,
            'w_up': w_up, 'conv_w': conv_w, 'conv_b': conv_b, 'w_down': w_down, 'norm_f_g': norm_f_g}


def reference(x_prompt, x_sample, cache_k, cache_v, page_table, state_mlstm_C, state_mlstm_n, state_mlstm_m,
              state_conv, norm1_g, w_in, b_gates, mlstm_norm_g, w_out, norm2_g, w_up, conv_w, conv_b, w_down,
              norm_f_g):
    bp, tp, _ = x_prompt.shape
    bs, ts, _ = x_sample.shape
    n_pages = PAST_LEN // PAGE_SIZE
    past_len = n_pages * PAGE_SIZE
    dt = x_prompt.dtype
    pos_p = jnp.arange(tp, dtype=jnp.int32)
    pos_s = past_len + jnp.arange(ts, dtype=jnp.int32)
    c0p = jnp.zeros((bp, MLSTM_HEADS, MLSTM_HEAD_DIM, MLSTM_HEAD_DIM), dt)
    n0p = jnp.zeros((bp, MLSTM_HEADS, MLSTM_HEAD_DIM), dt)
    m0p = jnp.zeros((bp, MLSTM_HEADS), dt)
    conv0p = jnp.zeros((bp, CONV_WIDTH - 1, 2 * D_FF), dt)
    xp, xs = x_prompt, x_sample
    states_p, states_s = [], []
    for layer in range(DEPTH):
        params = (norm1_g[layer], w_in[layer], b_gates[layer], mlstm_norm_g[layer], w_out[layer],
                  norm2_g[layer], w_up[layer], conv_w[layer], conv_b[layer], w_down[layer])
        xp, *sp = _decoder_layer(xp, pos_p, None, None, c0p, n0p, m0p, conv0p, *params)
        past_k = cache_k[layer][page_table].reshape(bs, past_len, ATT_HEADS, ATT_HEAD_DIM)
        past_v = cache_v[layer][page_table].reshape(bs, past_len, ATT_HEADS, ATT_HEAD_DIM)
        xs, *ss = _decoder_layer(xs, pos_s, past_k, past_v, state_mlstm_C[layer], state_mlstm_n[layer],
                                 state_mlstm_m[layer], state_conv[layer], *params)
        states_p.append(sp)
        states_s.append(ss)
    y_prompt = _rms_norm(xp, norm_f_g)
    y_sample = _rms_norm(xs, norm_f_g)
    k_p, v_p, c_p, n_p, m_p, conv_p = [jnp.stack(z) for z in zip(*states_p)]
    k_s, v_s, c_s, n_s, m_s, conv_s = [jnp.stack(z) for z in zip(*states_s)]
    return (y_prompt, y_sample, k_p, v_p, k_s, v_s, c_p, n_p, m_p, c_s, n_s, m_s, conv_p, conv_s)
```

```cpp
#include <hip/hip_runtime.h>
#include <cstdio>
#include <cstdint>

#define GAS __attribute__((address_space(1)))
#define LAS __attribute__((address_space(3)))
typedef unsigned short u16;
typedef short bf16x8 __attribute__((ext_vector_type(8)));
typedef short s16x4 __attribute__((ext_vector_type(4)));
typedef float f32x4 __attribute__((ext_vector_type(4)));
typedef float f32x2 __attribute__((ext_vector_type(2)));
typedef float f32x16 __attribute__((ext_vector_type(16)));
typedef unsigned u32x4 __attribute__((ext_vector_type(4)));
typedef unsigned u32x2 __attribute__((ext_vector_type(2)));
typedef GAS unsigned gu32;

constexpr int DM = 2048, BP = 2, TP = 4096, MP = BP * TP, BS = 8, TS = 8, MS = BS * TS, MT = MP + MS;
constexpr int MW = 1024, AW = 1024, MH = 4, MD = 256, AH = 8, AD = 128, CH = 128, NCH = TP / CH;
constexpr int DFF = 5632, NUP = 2 * DFF, NIN = 7176, NING = 7168;
constexpr int PAST = 16384, PAGE = 128, NPAGES = PAST / PAGE, NBS = PAST / 256;
constexpr float EPS = 1e-6f;
constexpr float ATT_SCALE = 0.08838834764831845f;

constexpr size_t O_YP = 0, O_YS = O_YP + (size_t)MP * DM, O_KP = O_YS + (size_t)MS * DM, O_VP = O_KP + (size_t)MP * AW, O_KS = O_VP + (size_t)MP * AW,
                 O_VS = O_KS + (size_t)MS * AW, O_CP = O_VS + (size_t)MS * AW, O_NP = O_CP + (size_t)BP * MH * MD * MD, O_MP = O_NP + (size_t)BP * MH * MD,
                 O_CS = O_MP + (size_t)BP * MH, O_NS = O_CS + (size_t)BS * MH * MD * MD, O_MS = O_NS + (size_t)BS * MH * MD, O_CVP = O_MS + (size_t)BS * MH,
                 O_CVS = O_CVP + (size_t)BP * 2 * NUP, O_END = O_CVS + (size_t)BS * 2 * NUP;

__device__ __forceinline__ unsigned f2bf(float f) { unsigned u = __builtin_bit_cast(unsigned, f); return (u + 0x7fffu + ((u >> 16) & 1u)) >> 16; }
__device__ __forceinline__ float bf2f(unsigned h) { return __builtin_bit_cast(float, h << 16); }
__device__ __forceinline__ float bflo(unsigned w) { return __builtin_bit_cast(float, w << 16); }
__device__ __forceinline__ float bfhi(unsigned w) { return __builtin_bit_cast(float, w & 0xffff0000u); }
typedef __bf16 bf16x2_t __attribute__((ext_vector_type(2)));
__device__ __forceinline__ unsigned cvtpk(float lo, float hi) { f32x2 v = {lo, hi}; bf16x2_t b = __builtin_convertvector(v, bf16x2_t); return __builtin_bit_cast(unsigned, b); }
__device__ __forceinline__ unsigned cvtpk_asm(float lo, float hi) { unsigned r; asm volatile("v_cvt_pk_bf16_f32 %0, %1, %2" : "=v"(r) : "v"(lo), "v"(hi)); return r; }
__device__ __forceinline__ u32x4 pack8f(f32x4 a, f32x4 b) { u32x4 w; w.x = cvtpk(a[0], a[1]); w.y = cvtpk(a[2], a[3]); w.z = cvtpk(b[0], b[1]); w.w = cvtpk(b[2], b[3]); return w; }
__device__ __forceinline__ f32x4 ldg4(const float* p) { return *(const GAS f32x4*)p; }
__device__ __forceinline__ void stg4(float* p, f32x4 v) { *(GAS f32x4*)p = v; }
__device__ __forceinline__ u32x4 ldgu4(const void* p) { return *(const GAS u32x4*)p; }
__device__ __forceinline__ void stgu4(void* p, u32x4 v) { *(GAS u32x4*)p = v; }
__device__ __forceinline__ u32x2 ldgu2(const void* p) { return *(const GAS u32x2*)p; }
__device__ __forceinline__ void stgu2(void* p, u32x2 v) { *(GAS u32x2*)p = v; }
__device__ __forceinline__ float ldgf(const float* p) { return *(const GAS float*)p; }
__device__ __forceinline__ void stgf(float* p, float v) { *(GAS float*)p = v; }
__device__ __forceinline__ void stg4_sc1(float* p, f32x4 v) { asm volatile("global_store_dwordx4 %0, %1, off sc1" :: "v"((GAS float*)p), "v"(v) : "memory"); }
__device__ __forceinline__ float wave_sum(float v) {
#pragma unroll
    for (int o = 1; o < 64; o <<= 1) v += __shfl_xor(v, o);
    return v;
}
__device__ __forceinline__ float wave_max(float v) {
#pragma unroll
    for (int o = 1; o < 64; o <<= 1) v = fmaxf(v, __shfl_xor(v, o));
    return v;
}
__device__ __forceinline__ float dot4(f32x4 a, f32x4 b) { return (a[0] * b[0] + a[1] * b[1]) + (a[2] * b[2] + a[3] * b[3]); }
__device__ __forceinline__ float sigmoidf_(float x) { return 1.0f / (1.0f + __expf(-x)); }
#define LDS_WAIT() asm volatile("s_waitcnt lgkmcnt(0)" ::: "memory")
#define VM_WAIT() asm volatile("s_waitcnt vmcnt(0)" ::: "memory")
#define WG_BAR() do { asm volatile("s_waitcnt lgkmcnt(0)" ::: "memory"); __builtin_amdgcn_s_barrier(); asm volatile("" ::: "memory"); } while (0)
namespace pg8 {
#define PG8_LAS __attribute__((address_space(3)))
typedef unsigned short bf16_t;
typedef short bf16x8 __attribute__((ext_vector_type(8)));
typedef float f32x4 __attribute__((ext_vector_type(4)));
typedef unsigned u32x4 __attribute__((ext_vector_type(4)));
constexpr int BM = 256, BK = 64, HALF = 128, HTB = HALF * BK * 2  , STAGE_BYTES = 8 * HTB, NXCD = 8, WGM = 8;

__host__ __device__ __forceinline__ int lds_byte(int r, int c) { const int st = (r >> 4) * 2 + (c >> 5), rr = r & 15, cc = c & 31, ob = rr * 64 + cc * 2; return st * 1024 + (ob ^ (((ob >> 9) & 1) << 5)); }
__host__ __device__ __forceinline__ void stage_rc(int b, int& R, int& C) { const int st = b / 1024, sb = b % 1024, swz = sb ^ (((sb >> 9) & 1) << 5); R = (st >> 1) * 16 + swz / 64; C = (st & 1) * 32 + (swz % 64) / 2; }
__host__ __device__ __forceinline__ int perm32(int rho) { const int n = rho >> 4, i = rho & 15; return 8 * (i >> 2) + 4 * n + (i & 3); }

struct Unit { int pm, pn; };
struct Gemm { const bf16_t* A; const bf16_t* Bt; int M, N, K; };

struct StaticOrder {
    int nM, nN, nwg, G, c;
    __host__ __device__ void init(int M, int N, int G_, int c_) { nM = M / BM; nN = N / BM; nwg = nM * nN; G = G_; c = c_; }
    __host__ __device__ bool next(int i, Unit& u) const {
        const long L = (long)i * G + c; if (L >= nwg) return false;
        int wgid = (int)L; { const int q = nwg / NXCD, r = nwg % NXCD, xcd = wgid % NXCD, off = wgid / NXCD; wgid = (xcd < r ? xcd * (q + 1) : r * (q + 1) + (xcd - r) * q) + off; }
        const int nig = WGM * nN, gid = wgid / nig, fm = gid * WGM, gsz = (nM - fm) < WGM ? (nM - fm) : WGM;
        u.pm = fm + ((wgid % nig) % gsz); u.pn = (wgid % nig) / gsz; return true;
    }
    __device__ __forceinline__ void a_ready(const Unit&) const {}
    __device__ __forceinline__ void done(const Unit&) const {}
};

__device__ __forceinline__ unsigned cvt_pk_bf16(float lo, float hi) { unsigned r; asm volatile("v_cvt_pk_bf16_f32 %0, %1, %2" : "=v"(r) : "v"(lo), "v"(hi)); return r; }
template <class Epi, class Sched, bool ALIGN_EPI = false, bool SP2 = false>
__device__ __forceinline__ void gemm_phase(PG8_LAS unsigned char* lds, const Gemm g, const Sched& S, const Epi& E) {
    const int tid = threadIdx.x, wid = __builtin_amdgcn_readfirstlane(tid >> 6), lane = tid & 63, wr = wid >> 2, wc = wid & 3, fr = lane & 15, fq = lane >> 4;
    const int K = g.K, nt = K / BK;
    unsigned voffA[2], voffB[2];
#pragma unroll
    for (int i = 0; i < 2; ++i) { int R, C; stage_rc(tid * 16 + i * 8192, R, C); const int Rb = Epi::PERM ? ((R & ~31) + perm32(R & 31)) : R;
        voffA[i] = (unsigned)(R * K + C) * 2u; voffB[i] = (unsigned)(Rb * K + C) * 2u; }
    const size_t kstep = (size_t)(BK * 2);
    const size_t hstep = (size_t)HALF * K * 2;
    const size_t tstep = 2 * hstep;
    const unsigned ldsw = (unsigned)wid * 1024u;
    const int aoff = lds_byte(wr * 64 + fr, fq * 8), boff = lds_byte(wc * 32 + fr, fq * 8);
#define PG8_SA(b, h) (((b) * 2 + (h)) * HTB)
#define PG8_SB(b, h) ((4 + (b) * 2 + (h)) * HTB)
#define PG8_STAGE(bufoff, gbase, voff) do { _Pragma("unroll") for (int _i = 0; _i < 2; ++_i) \
        __builtin_amdgcn_global_load_lds((const unsigned*)((const char*)(gbase) + (voff)[_i]), (PG8_LAS unsigned*)(lds + (bufoff) + ldsw + _i * 8192), 16, 0, 0); } while (0)
#define PG8_LDA(dst, b, h) do { _Pragma("unroll") for (int m = 0; m < 4; ++m) _Pragma("unroll") for (int k = 0; k < 2; ++k) dst[m][k] = *(const PG8_LAS bf16x8*)(lds + PG8_SA(b, h) + aoff + m * 2048 + k * 1024); } while (0)
#define PG8_LDB(dst, b, h) do { _Pragma("unroll") for (int n = 0; n < 2; ++n) _Pragma("unroll") for (int k = 0; k < 2; ++k) dst[n][k] = *(const PG8_LAS bf16x8*)(lds + PG8_SB(b, h) + boff + n * 2048 + k * 1024); } while (0)
#define PG8_MMA(ai, bj, At, Bt) do { __builtin_amdgcn_s_setprio(1); _Pragma("unroll") for (int m = 0; m < 4; ++m) _Pragma("unroll") for (int n = 0; n < 2; ++n) _Pragma("unroll") for (int k = 0; k < 2; ++k) \
        acc[ai][bj][m][n] = __builtin_amdgcn_mfma_f32_16x16x32_bf16(Bt[n][k], At[m][k], acc[ai][bj][m][n], 0, 0, 0); __builtin_amdgcn_s_setprio(0); } while (0)
#define PG8_WAIT_V(n) asm volatile("s_waitcnt vmcnt(" #n ")" ::: "memory")
#define PG8_WAIT_L(n) asm volatile("s_waitcnt lgkmcnt(" #n ")" ::: "memory")
#define PG8_BAR __builtin_amdgcn_s_barrier()
#define PG8_SCHED __builtin_amdgcn_sched_barrier(0)
    Unit cur, nxt; int ui = 0;
    if (!S.next(0, cur)) return;
    f32x4 acc[2][2][4][2];
#pragma unroll
    for (int a = 0; a < 2; ++a)
#pragma unroll
        for (int b = 0; b < 2; ++b)
#pragma unroll
            for (int m = 0; m < 4; ++m)
#pragma unroll
                for (int n = 0; n < 2; ++n) acc[a][b][m][n] = (f32x4){0.f, 0.f, 0.f, 0.f};
    bf16x8 At[4][2], B0[2][2], B1[2][2];
    const char* cA = (const char*)g.A + (size_t)cur.pm * tstep; const char* cB = (const char*)g.Bt + (size_t)cur.pn * tstep;
    S.a_ready(cur);
    if constexpr (SP2) {
        PG8_STAGE(PG8_SB(0, 0), cB, voffB); PG8_STAGE(PG8_SB(0, 1), cB + hstep, voffB); PG8_STAGE(PG8_SA(0, 0), cA, voffA); PG8_STAGE(PG8_SA(0, 1), cA + hstep, voffA);
        if (wr == 1) PG8_BAR;
        PG8_WAIT_V(2); PG8_BAR;
        PG8_STAGE(PG8_SB(1, 0), cB + kstep, voffB); PG8_STAGE(PG8_SA(1, 0), cA + kstep, voffA); PG8_STAGE(PG8_SB(1, 1), cB + hstep + kstep, voffB);
        PG8_WAIT_V(6); PG8_BAR;
    } else {
        PG8_STAGE(PG8_SB(0, 0), cB, voffB); PG8_STAGE(PG8_SA(0, 0), cA, voffA); PG8_STAGE(PG8_SB(0, 1), cB + hstep, voffB); PG8_STAGE(PG8_SA(0, 1), cA + hstep, voffA);
        if (wr == 1) PG8_BAR;
        PG8_WAIT_V(4); PG8_BAR;
        PG8_STAGE(PG8_SB(1, 0), cB + kstep, voffB); PG8_STAGE(PG8_SA(1, 0), cA + kstep, voffA); PG8_STAGE(PG8_SB(1, 1), cB + hstep + kstep, voffB);
        PG8_WAIT_V(6); PG8_BAR;
    }
    for (;;) {
        const bool has_next = S.next(ui + 1, nxt);
        const char* nA = has_next ? (const char*)g.A + (size_t)nxt.pm * tstep : cA; const char* nB = has_next ? (const char*)g.Bt + (size_t)nxt.pn * tstep : cB;
        for (int t = 0; t < nt; t += 2) {
            const bool last = (t == nt - 2);
            const char* a1 = cA + (size_t)(t + 1) * kstep;
            const char* a2 = last ? nA : cA + (size_t)(t + 2) * kstep; const char* b2 = last ? nB : cB + (size_t)(t + 2) * kstep;
            const char* a3 = a2 + kstep; const char* b3 = b2 + kstep;
            if (last && has_next) S.a_ready(nxt);
            if constexpr (SP2) {
            PG8_LDB(B0, 0, 0); PG8_LDB(B1, 0, 1); PG8_SCHED; PG8_LDA(At, 0, 0); PG8_STAGE(PG8_SA(1, 1), a1 + hstep, voffA);
            PG8_WAIT_V(8); PG8_WAIT_L(0); PG8_BAR; PG8_MMA(0, 0, At, B0); PG8_MMA(0, 1, At, B1); PG8_BAR; PG8_SCHED;
            PG8_LDA(At, 0, 1); PG8_STAGE(PG8_SB(0, 0), b2, voffB); PG8_STAGE(PG8_SB(0, 1), b2 + hstep, voffB); PG8_STAGE(PG8_SA(0, 0), a2, voffA);
            PG8_WAIT_V(8); PG8_WAIT_L(0); PG8_BAR; PG8_MMA(1, 0, At, B0); PG8_MMA(1, 1, At, B1); PG8_BAR; PG8_SCHED;
            PG8_LDB(B0, 1, 0); PG8_LDB(B1, 1, 1); PG8_SCHED; PG8_LDA(At, 1, 0); PG8_STAGE(PG8_SA(0, 1), a2 + hstep, voffA);
            PG8_WAIT_V(8); PG8_WAIT_L(0); PG8_BAR; PG8_MMA(0, 0, At, B0); PG8_MMA(0, 1, At, B1); PG8_BAR; PG8_SCHED;
            PG8_LDA(At, 1, 1); PG8_STAGE(PG8_SB(1, 0), b3, voffB); PG8_STAGE(PG8_SB(1, 1), b3 + hstep, voffB); PG8_STAGE(PG8_SA(1, 0), a3, voffA);
            PG8_WAIT_V(8); PG8_WAIT_L(0); PG8_BAR; PG8_MMA(1, 0, At, B0); PG8_MMA(1, 1, At, B1); PG8_BAR; PG8_SCHED;
            } else {
            PG8_LDB(B0, 0, 0); PG8_SCHED; PG8_LDA(At, 0, 0); PG8_STAGE(PG8_SA(1, 1), a1 + hstep, voffA);
            PG8_WAIT_L(8); PG8_BAR; PG8_WAIT_L(0); PG8_MMA(0, 0, At, B0); PG8_BAR; PG8_SCHED;
            PG8_LDB(B1, 0, 1); PG8_STAGE(PG8_SB(0, 0), b2, voffB);
            PG8_BAR; PG8_WAIT_L(0); PG8_MMA(0, 1, At, B1); PG8_BAR;
            PG8_LDA(At, 0, 1); PG8_STAGE(PG8_SA(0, 0), a2, voffA);
            PG8_BAR; PG8_WAIT_L(0); PG8_MMA(1, 0, At, B0); PG8_BAR; PG8_SCHED;
            PG8_STAGE(PG8_SB(0, 1), b2 + hstep, voffB);
            PG8_WAIT_V(6); PG8_BAR; PG8_MMA(1, 1, At, B1); PG8_BAR;
            PG8_LDB(B0, 1, 0); PG8_SCHED; PG8_LDA(At, 1, 0); PG8_STAGE(PG8_SA(0, 1), a2 + hstep, voffA);
            PG8_WAIT_L(8); PG8_BAR; PG8_WAIT_L(0); PG8_MMA(0, 0, At, B0); PG8_BAR; PG8_SCHED;
            PG8_LDB(B1, 1, 1); PG8_STAGE(PG8_SB(1, 0), b3, voffB);
            PG8_BAR; PG8_WAIT_L(0); PG8_MMA(0, 1, At, B1); PG8_BAR;
            PG8_LDA(At, 1, 1); PG8_STAGE(PG8_SA(1, 0), a3, voffA);
            PG8_BAR; PG8_WAIT_L(0); PG8_MMA(1, 0, At, B0); PG8_BAR; PG8_SCHED;
            PG8_STAGE(PG8_SB(1, 1), b3 + hstep, voffB);
            PG8_WAIT_V(6); PG8_BAR; PG8_MMA(1, 1, At, B1); PG8_BAR;
            }
        }
        if constexpr (ALIGN_EPI) { if (wr == 0) PG8_BAR; }
        if constexpr (!Epi::AFTER_DRAIN) { E(acc, cur, wr, wc, fr, fq); S.done(cur); }
        if (!has_next) break;
#pragma unroll
        for (int a = 0; a < 2; ++a)
#pragma unroll
            for (int b = 0; b < 2; ++b)
#pragma unroll
                for (int m = 0; m < 4; ++m)
#pragma unroll
                    for (int n = 0; n < 2; ++n) acc[a][b][m][n] = (f32x4){0.f, 0.f, 0.f, 0.f};
        cur = nxt; cA = nA; cB = nB; ++ui;
        if constexpr (ALIGN_EPI) { if (wr == 1) PG8_BAR; }
    }
    PG8_WAIT_V(0);
    if constexpr (!ALIGN_EPI) { if (wr == 0) PG8_BAR; }
    PG8_BAR;
    if constexpr (Epi::AFTER_DRAIN) { E.fused(acc, cur, wr, wc, fr, fq, lds, wid, lane); S.done(cur); }
#undef PG8_SA
#undef PG8_SB
#undef PG8_STAGE
#undef PG8_LDA
#undef PG8_LDB
#undef PG8_MMA
#undef PG8_WAIT_V
#undef PG8_WAIT_L
#undef PG8_BAR
#undef PG8_SCHED
}
}

using pg8::Unit;

struct EpiIn {
    static constexpr bool PERM = true, AFTER_DRAIN = false;
    u16 *MQ, *AQ; float *kout; const float *rcos, *rsin;
    __device__ __forceinline__ void operator()(f32x4 (&acc)[2][2][4][2], const Unit& u, int wr, int wc, int fr, int fq) const {
        const int row0 = u.pm * 256 + wr * 64 + fr;
        if (u.pn < 16) {
            const int sec = u.pn >> 2; u16* base = MQ + (size_t)sec * (8u << 20); const float sc = (sec == 1) ? 0.0625f : 1.0f;
            const int col0 = (u.pn & 3) * 256 + wc * 32 + 8 * fq;
#pragma unroll
            for (int ai = 0; ai < 2; ++ai)
#pragma unroll
                for (int m = 0; m < 4; ++m) { u16* rowp = base + (size_t)(row0 + ai * 128 + m * 16) * MW + col0;
#pragma unroll
                    for (int bj = 0; bj < 2; ++bj) stgu4(rowp + bj * 128, pack8f(acc[ai][bj][m][0] * sc, acc[ai][bj][m][1] * sc)); }
        } else {
            const int a = u.pn - 16, sec = a >> 2, pt = a & 3, head = 2 * pt + (wc >> 1), dl0 = 32 * (wc & 1) + 8 * fq, b = u.pm >> 4;
            u16* dbase = AQ + (size_t)sec * (8u << 20) + (size_t)(b * AH + head) * TP * AD;
            float* fbase = kout + (size_t)(sec == 2 ? 1 : 0) * ((size_t)MP * AW) + (size_t)b * TP * AW + head * AD;
#pragma unroll
            for (int ai = 0; ai < 2; ++ai)
#pragma unroll
                for (int m = 0; m < 4; ++m) {
                    const int t = (row0 + ai * 128 + m * 16) & (TP - 1);
                    f32x4 x1a = acc[ai][0][m][0], x1b = acc[ai][0][m][1], x2a = acc[ai][1][m][0], x2b = acc[ai][1][m][1];
                    if (sec < 2) {
                        const f32x4 c0 = ldg4(rcos + t * 64 + dl0), c1 = ldg4(rcos + t * 64 + dl0 + 4), s0 = ldg4(rsin + t * 64 + dl0), s1 = ldg4(rsin + t * 64 + dl0 + 4);
                        const f32x4 o1a = x1a * c0 - x2a * s0, o2a = x2a * c0 + x1a * s0, o1b = x1b * c1 - x2b * s1, o2b = x2b * c1 + x1b * s1;
                        x1a = o1a; x2a = o2a; x1b = o1b; x2b = o2b;
                    }
                    u16* dst = dbase + (size_t)t * AD + dl0;
                    stgu4(dst, pack8f(x1a, x1b)); stgu4(dst + 64, pack8f(x2a, x2b));
                    if (sec >= 1) { float* fo = fbase + (size_t)t * AW + dl0; stg4(fo, x1a); stg4(fo + 4, x1b); stg4(fo + 64, x2a); stg4(fo + 68, x2b); }
                }
        }
    }
};

template <bool WITH_G> struct EpiRes {
    static constexpr bool PERM = true, AFTER_DRAIN = false;
    const float* res; float* out; u16* outg; const float* g; float* SS;
    __device__ __forceinline__ void operator()(f32x4 (&acc)[2][2][4][2], const Unit& u, int wr, int wc, int fr, int fq) const {
        const int row0 = u.pm * 256 + wr * 64 + fr, col0 = u.pn * 256 + wc * 32 + 8 * fq;
        f32x4 gv[2][2];
        if (WITH_G) {
#pragma unroll
            for (int bj = 0; bj < 2; ++bj)
#pragma unroll
                for (int n = 0; n < 2; ++n) gv[bj][n] = ldg4(g + col0 + bj * 128 + 4 * n);
        }
#pragma unroll
        for (int ai = 0; ai < 2; ++ai)
#pragma unroll
            for (int m = 0; m < 4; ++m) {
                const int row = row0 + ai * 128 + m * 16; const size_t off = (size_t)row * DM + col0; float ss = 0.f;
#pragma unroll
                for (int bj = 0; bj < 2; ++bj) {
                    const f32x4 v0 = acc[ai][bj][m][0] + ldg4(res + off + bj * 128), v1 = acc[ai][bj][m][1] + ldg4(res + off + bj * 128 + 4);
                    stg4(out + off + bj * 128, v0); stg4(out + off + bj * 128 + 4, v1);
                    ss += dot4(v0, v0) + dot4(v1, v1);
                    if (WITH_G) stgu4(outg + off + bj * 128, pack8f(v0 * gv[bj][0], v1 * gv[bj][1]));
                }
                ss += __shfl_xor(ss, 16); ss += __shfl_xor(ss, 32);
                if (fq == 0) stgf(SS + (size_t)row * 32 + u.pn * 4 + wc, ss);
            }
    }
};

__device__ __forceinline__ float dpp_ror1f(float x) { return __int_as_float(__builtin_amdgcn_mov_dpp(__float_as_int(x), 0x121, 0xf, 0xf, false)); }
__device__ __forceinline__ float dpp_ror2f(float x) { return __int_as_float(__builtin_amdgcn_mov_dpp(__float_as_int(x), 0x122, 0xf, 0xf, false)); }
__device__ __forceinline__ f32x4 dpp_ror1(f32x4 v) { f32x4 r; r.x = dpp_ror1f(v.x); r.y = dpp_ror1f(v.y); r.z = dpp_ror1f(v.z); r.w = dpp_ror1f(v.w); return r; }
__device__ __forceinline__ f32x4 dpp_ror2(f32x4 v) { f32x4 r; r.x = dpp_ror2f(v.x); r.y = dpp_ror2f(v.y); r.z = dpp_ror2f(v.z); r.w = dpp_ror2f(v.w); return r; }
__device__ __forceinline__ f32x4 silu_mul(f32x4 g, f32x4 up) { f32x4 r;
#pragma unroll
    for (int i = 0; i < 4; ++i) r[i] = g[i] * __builtin_amdgcn_rcpf(1.0f + __builtin_amdgcn_exp2f(-1.4426950408889634f * g[i])) * up[i]; return r; }

__device__ __forceinline__ void up_fixup(int P, int pn, const float* UB, const float* conv_w, const float* conv_b, u16* ACT, int tid) {
    if (tid < 128) {
        const int j = tid;
        const float* ua = UB + ((size_t)(P - 1) * 4 + 2) * NUP + pn * 256;
        const float* ub = UB + ((size_t)P * 4 + 0) * NUP + pn * 256;
        float cv[2][2];
#pragma unroll
        for (int h = 0; h < 2; ++h) {
            const int tc = h * 128 + j, oc = h * DFF + pn * 128 + j;
            const float um2 = ldgf(ua + tc), um1 = ldgf(ua + NUP + tc), u0 = ldgf(ub + tc), u1 = ldgf(ub + NUP + tc);
            const float w0 = ldgf(conv_w + oc), w1 = ldgf(conv_w + NUP + oc), w2 = ldgf(conv_w + 2 * NUP + oc), cb = ldgf(conv_b + oc);
            cv[h][0] = cb + w0 * um2 + w1 * um1 + w2 * u0; cv[h][1] = cb + w0 * um1 + w1 * u0 + w2 * u1;
        }
#pragma unroll
        for (int r = 0; r < 2; ++r) { const float g = cv[0][r]; const float a = g / (1.0f + __expf(-g)) * cv[1][r];
            *(GAS u16*)(ACT + (size_t)(P * 256 + r) * DFF + pn * 128 + j) = (u16)f2bf(a); }
    }
}

struct EpiUp {
    static constexpr bool PERM = true, AFTER_DRAIN = false;
    LAS unsigned char* xl;
    const float* SS1; const float *conv_w, *conv_b; u16* ACT; float* UB; gu32* cnt; float* conv_out; void* dbg_ufull;
    __device__ __forceinline__ void operator()(f32x4 (&acc)[2][2][4][2], const Unit& u, int wr, int wc, int fr, int fq) const {
        const int tid = threadIdx.x;
        LAS float* XCH = (LAS float*)xl; LAS float* RS = (LAS float*)(xl + 8192); volatile LAS unsigned* FL = (volatile LAS unsigned*)(xl + 8192 + 1024);
        { const int row = tid >> 1, half = tid & 1; const float* p = SS1 + (size_t)(u.pm * 256 + row) * 32 + half * 16;
          const f32x4 a = ldg4(p), b = ldg4(p + 4), c = ldg4(p + 8), d = ldg4(p + 12);
          float s = ((a[0] + a[1]) + (a[2] + a[3])) + ((b[0] + b[1]) + (b[2] + b[3])) + ((c[0] + c[1]) + (c[2] + c[3])) + ((d[0] + d[1]) + (d[2] + d[3]));
          s += __shfl_xor(s, 1);
          if (half == 0) RS[row] = 1.0f / sqrtf(s * (1.0f / DM) + EPS); }
        WG_BAR();
#pragma unroll
        for (int ai = 0; ai < 2; ++ai)
#pragma unroll
            for (int m = 0; m < 4; ++m) { const float rs = RS[ai * 128 + wr * 64 + m * 16 + fr];
#pragma unroll
                for (int bj = 0; bj < 2; ++bj)
#pragma unroll
                    for (int n = 0; n < 2; ++n) acc[ai][bj][m][n] = acc[ai][bj][m][n] * rs; }
#ifdef DBG_UFULL
        { float* UF = (float*)dbg_ufull;
#pragma unroll
          for (int ai = 0; ai < 2; ++ai)
#pragma unroll
            for (int m = 0; m < 4; ++m)
#pragma unroll
              for (int bj = 0; bj < 2; ++bj)
#pragma unroll
                for (int n = 0; n < 2; ++n) stg4(UF + (size_t)(u.pm * 256 + ai * 128 + wr * 64 + m * 16 + fr) * NUP + u.pn * 256 + bj * 128 + 32 * wc + 8 * fq + 4 * n, acc[ai][bj][m][n]); }
#endif
        const bool bstart = (u.pm & 15) == 0, bend = (u.pm & 15) == 15;
        const int tcl = 32 * wc + 8 * fq;
#pragma unroll
        for (int ai = 0; ai < 2; ++ai) {
            const int g = ai * 2 + wr;
            if (fr >= 14) {
#pragma unroll
                for (int bj = 0; bj < 2; ++bj)
#pragma unroll
                    for (int n = 0; n < 2; ++n) *(LAS f32x4*)(XCH + (g * 2 + (fr - 14)) * 256 + bj * 128 + tcl + 4 * n) = acc[ai][bj][3][n];
                if (g == 3) {
#pragma unroll
                    for (int bj = 0; bj < 2; ++bj)
#pragma unroll
                        for (int n = 0; n < 2; ++n) {
                            if (!bend) stg4_sc1(UB + ((size_t)u.pm * 4 + 2 + (fr - 14)) * NUP + u.pn * 256 + bj * 128 + tcl + 4 * n, acc[ai][bj][3][n]);
                            else stg4(conv_out + ((size_t)(u.pm >> 4) * 2 + (fr - 14)) * NUP + bj * DFF + u.pn * 128 + tcl + 4 * n, acc[ai][bj][3][n]);
                        }
                }
            }
            if (g == 0 && fr < 2 && !bstart) {
#pragma unroll
                for (int bj = 0; bj < 2; ++bj)
#pragma unroll
                    for (int n = 0; n < 2; ++n) stg4_sc1(UB + ((size_t)u.pm * 4 + fr) * NUP + u.pn * 256 + bj * 128 + tcl + 4 * n, acc[ai][bj][0][n]);
            }
        }
        asm volatile("s_waitcnt vmcnt(0)" ::: "memory");
        WG_BAR();
        if (tid == 0) {
            unsigned f0 = 0u, f1 = 0u;
            if (!bstart) f0 = (__hip_atomic_fetch_add(cnt + u.pm * 44 + u.pn, 1u, __ATOMIC_RELAXED, __HIP_MEMORY_SCOPE_AGENT) == 1u) ? 1u : 0u;
            if (!bend) f1 = (__hip_atomic_fetch_add(cnt + (u.pm + 1) * 44 + u.pn, 1u, __ATOMIC_RELAXED, __HIP_MEMORY_SCOPE_AGENT) == 1u) ? 1u : 0u;
            if (f0 | f1) { __builtin_amdgcn_fence(__ATOMIC_ACQUIRE, "agent"); asm volatile("s_waitcnt vmcnt(0)" ::: "memory"); }
            FL[0] = f0; FL[1] = f1;
        }
#pragma unroll
        for (int n = 0; n < 2; ++n) {
            f32x4 cw[2][3], cbv[2];
#pragma unroll
            for (int bj = 0; bj < 2; ++bj) { const int oc = bj * DFF + u.pn * 128 + tcl + 4 * n;
                cw[bj][0] = ldg4(conv_w + oc); cw[bj][1] = ldg4(conv_w + NUP + oc); cw[bj][2] = ldg4(conv_w + 2 * NUP + oc); cbv[bj] = ldg4(conv_b + oc); }
#pragma unroll
            for (int ai = 0; ai < 2; ++ai) {
                const int g = ai * 2 + wr;
#pragma unroll
                for (int m = 0; m < 4; ++m) {
                    f32x4 cv[2];
#pragma unroll
                    for (int bj = 0; bj < 2; ++bj) {
                        const f32x4 cur = acc[ai][bj][m][n]; const f32x4 a1 = dpp_ror1(cur), a2 = dpp_ror2(cur); f32x4 p1, p2;
                        if (m > 0) { const f32x4 b1 = dpp_ror1(acc[ai][bj][m - 1][n]), b2 = dpp_ror2(acc[ai][bj][m - 1][n]);
#pragma unroll
                            for (int i = 0; i < 4; ++i) { p1[i] = fr == 0 ? b1[i] : a1[i]; p2[i] = fr < 2 ? b2[i] : a2[i]; } }
                        else { f32x4 X0 = (f32x4){0.f, 0.f, 0.f, 0.f}, X1 = X0;
                            if (g > 0) { X0 = *(LAS f32x4*)(XCH + ((g - 1) * 2 + 0) * 256 + bj * 128 + tcl + 4 * n); X1 = *(LAS f32x4*)(XCH + ((g - 1) * 2 + 1) * 256 + bj * 128 + tcl + 4 * n); }
#pragma unroll
                            for (int i = 0; i < 4; ++i) { p1[i] = fr == 0 ? X1[i] : a1[i]; p2[i] = fr == 0 ? X0[i] : (fr == 1 ? X1[i] : a2[i]); } }
                        cv[bj] = cbv[bj] + cw[bj][0] * p2 + cw[bj][1] * p1 + cw[bj][2] * cur;
                    }
                    const f32x4 a = silu_mul(cv[0], cv[1]);
                    const bool skip = (g == 0 && m == 0 && fr < 2 && !bstart);
                    if (!skip) { u32x2 w; w.x = cvtpk(a[0], a[1]); w.y = cvtpk(a[2], a[3]);
                        stgu2(ACT + (size_t)(u.pm * 256 + g * 64 + m * 16 + fr) * DFF + u.pn * 128 + tcl + 4 * n, w); }
                }
            }
        }
        WG_BAR();
        const unsigned f0 = FL[0], f1 = FL[1];
        if (f0) up_fixup(u.pm, u.pn, UB, conv_w, conv_b, ACT, tid);
        if (f1) up_fixup(u.pm + 1, u.pn, UB, conv_w, conv_b, ACT, tid);
        WG_BAR();
    }
};

namespace moba {
constexpr int D = 128, NW = 8, QBLK = 32, KVBLK = 64, QB = NW * QBLK;
constexpr int SHM_V = KVBLK * D * 2, SHM_K = KVBLK * D * 2;
constexpr int ATT_LDS = 2 * SHM_V + 2 * SHM_K + NW * 64 * 4;
constexpr float SCALE = 0.08838834764831845f, THR = 8.f;
constexpr int OSTRIDE = 2048;
#define KSWZ(row, colB) ((row) * 256 + ((colB) ^ (((row) & 7) << 4)))
#define SBAR() __builtin_amdgcn_sched_barrier(0)
__device__ __forceinline__ int v_st(int k, int c) { const int kk = (k & ~0xC) | ((k & 4) << 1) | ((k & 8) >> 1); return ((kk >> 3) * 4 + (c >> 5)) * 512 + ((kk & 7) * 32 + (c & 31)) * 2; }
__device__ __forceinline__ int v_rd_base(int lane) { return ((lane & 3) << 3) | (((lane >> 2) & 3) << 6) | (((lane >> 4) & 1) << 5) | (((lane >> 5) & 1) << 8); }
constexpr int v_rd_off(int d0, int ks, int half) { return d0 * 512 + ks * 4096 + half * 2048; }
__device__ __forceinline__ int crow(int r, int hi) { return (r & 3) + 8 * (r >> 2) + 4 * hi; }
__device__ __forceinline__ bf16x8 load8(const u16* p) { return *(const GAS bf16x8*)p; }
__device__ __forceinline__ void mask_tile(f32x16& p0, f32x16& p1, int dq) {
    const float NEG = -__builtin_inff();
#pragma unroll
    for (int r = 0; r < 16; ++r) {
        const int c = (r & 3) + 8 * (r >> 2);
        if (dq - c < 0) p0[r] = NEG;
        if (dq - c - 32 < 0) p1[r] = NEG;
    }
}
__device__ __forceinline__ void mask_all(f32x16& p0, f32x16& p1, bool keep) {
    const float NEG = -__builtin_inff();
#pragma unroll
    for (int r = 0; r < 16; ++r) { p0[r] = keep ? p0[r] : NEG; p1[r] = keep ? p1[r] : NEG; }
}
__device__ __forceinline__ void partialSM(f32x16& p0, f32x16& p1, float& m_reg, float& mn, float& alpha, bool keep) {
    float pmax = p0[0];
#pragma unroll
    for (int r = 1; r < 16; ++r) pmax = fmaxf(pmax, p0[r]);
#pragma unroll
    for (int r = 0; r < 16; ++r) pmax = fmaxf(pmax, p1[r]);
    { auto rr = __builtin_amdgcn_permlane32_swap(__float_as_uint(pmax), __float_as_uint(pmax), false, false);
      pmax = fmaxf(__uint_as_float(rr[0]), __uint_as_float(rr[1])); }
    pmax = keep ? pmax : -__builtin_inff();
    constexpr float C2 = 1.4426950408889634f * SCALE;
    if (__builtin_expect(__all((pmax - m_reg) * SCALE <= THR), 1)) { mn = m_reg; alpha = 1.f; }
    else { mn = fmaxf(m_reg, pmax); alpha = __builtin_amdgcn_exp2f((m_reg - mn) * C2); m_reg = mn; }
    const float mnL = keep ? -mn * C2 : -__builtin_inff();
#pragma unroll
    for (int r = 0; r < 16; ++r) p0[r] = fmaf(p0[r], C2, mnL);
#pragma unroll
    for (int r = 0; r < 16; ++r) p1[r] = fmaf(p1[r], C2, mnL);
#pragma unroll
    for (int r = 0; r < 16; ++r) p0[r] = __builtin_amdgcn_exp2f(p0[r]);
}
__device__ __forceinline__ void finishSM(f32x16& p0, f32x16& p1, float alpha, float& l_reg, bf16x8& pa0, bf16x8& pa1, bf16x8& pa2, bf16x8& pa3) {
#pragma unroll
    for (int r = 0; r < 16; ++r) p1[r] = __builtin_amdgcn_exp2f(p1[r]);
    float ps = 0;
#pragma unroll
    for (int r = 0; r < 16; ++r) ps += p0[r];
#pragma unroll
    for (int r = 0; r < 16; ++r) ps += p1[r];
    { auto rr = __builtin_amdgcn_permlane32_swap(__float_as_uint(ps), __float_as_uint(ps), false, false);
      ps = __uint_as_float(rr[0]) + __uint_as_float(rr[1]); }
    l_reg = l_reg * alpha + ps;
#define PK4(P, B_, OUT) do { unsigned a0 = cvtpk_asm(P[B_+0], P[B_+1]), a1 = cvtpk_asm(P[B_+2], P[B_+3]);                          \
        unsigned b0 = cvtpk_asm(P[B_+4], P[B_+5]), b1 = cvtpk_asm(P[B_+6], P[B_+7]);                                             \
        auto r0 = __builtin_amdgcn_permlane32_swap(a0, b0, false, false); auto r1 = __builtin_amdgcn_permlane32_swap(a1, b1, false, false); \
        u32x4 w = {r0[0], r1[0], r0[1], r1[1]}; OUT = *reinterpret_cast<bf16x8*>(&w); } while (0)
    PK4(p0, 0, pa0); PK4(p0, 8, pa1); PK4(p1, 0, pa2); PK4(p1, 8, pa3);
#undef PK4
}
template <int KB>
__device__ __forceinline__ void qkt(f32x16& p0, f32x16& p1, const char* K_lds, int r32, int hi, const bf16x8* qr) {
    p0 = f32x16{}; p1 = f32x16{};
    const char* kb[4];
#pragma unroll
    for (int dd = 0; dd < 4; ++dd) kb[dd] = K_lds + KB * SHM_K + KSWZ(r32, (dd * 16 + hi * 8) * 2);
#pragma unroll
    for (int d0 = 0; d0 < 8; ++d0) { const char* a = kb[d0 & 3] + (d0 >> 2) * 128;
        bf16x8 b0 = *reinterpret_cast<const bf16x8*>(a);
        bf16x8 b1 = *reinterpret_cast<const bf16x8*>(a + 32 * 256);
        p0 = __builtin_amdgcn_mfma_f32_32x32x16_bf16(b0, qr[d0], p0, 0, 0, 0);
        p1 = __builtin_amdgcn_mfma_f32_32x32x16_bf16(b1, qr[d0], p1, 0, 0, 0); }
}
template <int VB>
__device__ __forceinline__ void pv_tile(f32x16* o, int vb0, bf16x8 pa0, bf16x8 pa1, bf16x8 pa2, bf16x8 pa3) {
#define TRRD(dst, off) asm volatile("ds_read_b64_tr_b16 %0, %1 offset:%2" : "=&v"(dst) : "v"(vb0), "i"(off) : "memory")
#define PV_D0(d0) do { s16x4 l0, l1, l2, l3, h0, h1, h2, h3; constexpr int b_ = VB * SHM_V + v_rd_off(d0, 0, 0); \
        TRRD(l0, b_); TRRD(h0, b_ + 2048); TRRD(l1, b_ + 4096); TRRD(h1, b_ + 6144); TRRD(l2, b_ + 8192); TRRD(h2, b_ + 10240); TRRD(l3, b_ + 12288); TRRD(h3, b_ + 14336); \
        asm volatile("s_waitcnt lgkmcnt(0)" ::: "memory"); SBAR();   \
        o[d0] = __builtin_amdgcn_mfma_f32_32x32x16_bf16(pa0, (bf16x8){l0[0], l0[1], l0[2], l0[3], h0[0], h0[1], h0[2], h0[3]}, o[d0], 0, 0, 0);   \
        o[d0] = __builtin_amdgcn_mfma_f32_32x32x16_bf16(pa1, (bf16x8){l1[0], l1[1], l1[2], l1[3], h1[0], h1[1], h1[2], h1[3]}, o[d0], 0, 0, 0);   \
        o[d0] = __builtin_amdgcn_mfma_f32_32x32x16_bf16(pa2, (bf16x8){l2[0], l2[1], l2[2], l2[3], h2[0], h2[1], h2[2], h2[3]}, o[d0], 0, 0, 0);   \
        o[d0] = __builtin_amdgcn_mfma_f32_32x32x16_bf16(pa3, (bf16x8){l3[0], l3[1], l3[2], l3[3], h3[0], h3[1], h3[2], h3[3]}, o[d0], 0, 0, 0); } while (0)
    PV_D0(0); PV_D0(1); PV_D0(2); PV_D0(3);
#undef PV_D0
#undef TRRD
}

struct HeadRef { const u16* Q; const u16* K; const u16* V; };
typedef __amdgpu_buffer_rsrc_t rsrc_t;
__device__ __forceinline__ rsrc_t mkrsrc(const u16* p) { return __builtin_amdgcn_make_buffer_rsrc((void*)p, 0, 4096 * 128 * 2, 0x00020000); }
__device__ __forceinline__ bf16x8 bload8(rsrc_t r, int voff, int soff) { return __builtin_bit_cast(bf16x8, __builtin_amdgcn_raw_buffer_load_b128(r, voff, soff, 0)); }
struct BlockRef { u16* O; int own, j_lo, j_hi; float* part; gu32* flag; };
struct Seam { bf16x8 qr[8]; bf16x8 st_v0, st_v1, st_k0, st_k1; };
#define ROW(p, k0, rr) ((p) + (size_t)((k0) + (rr)) * D + sc)
#define VMW() asm volatile("s_waitcnt vmcnt(0)" ::: "memory")
#define VMWN(n) asm volatile("s_waitcnt vmcnt(%0)" :: "i"(n) : "memory")
#define SLOAD_H(Kp, Vp, k0) do { const int so_ = (k0) * (D * 2); S.st_v0 = bload8(rV, voff, so_); S.st_v1 = bload8(rV, voff, so_ + 32 * D * 2);              \
                         S.st_k0 = bload8(rK, voff, so_); S.st_k1 = bload8(rK, voff, so_ + 32 * D * 2); } while (0)
#define SWRITE_HK(bf) do { *(bf16x8*)(K_lds + (bf) * SHM_K + kws) = S.st_k0; *(bf16x8*)(K_lds + (bf) * SHM_K + kws + 32 * 256) = S.st_k1; } while (0)
#define SWRITE_HV(bf) do { *(bf16x8*)(V_lds + (bf) * SHM_V + vst0) = S.st_v0; *(bf16x8*)(V_lds + (bf) * SHM_V + vst1) = S.st_v1; } while (0)
#define SWRITE_H(bf) do { SWRITE_HV(bf); SWRITE_HK(bf); } while (0)
__device__ __forceinline__ void moba_prime(const HeadRef& H, const BlockRef& cur, char* lds, Seam& S) {
    const int tid = threadIdx.x, wid = __builtin_amdgcn_readfirstlane(tid >> 6), lane = tid & 63, r32 = lane & 31, hi = lane >> 5;
    const int sr = tid >> 4, sc = (tid & 15) * 8, kws = KSWZ(sr, sc * 2); char* K_lds = lds + 2 * SHM_V;
    const int kb0 = cur.j_lo * KVBLK;
    const rsrc_t rK = mkrsrc(H.K), rV = mkrsrc(H.V), rQ = mkrsrc(H.Q); const int voff = (sr * D + sc) * 2, qoff = ((wid * QBLK + r32) * D + hi * 8) * 2;
#pragma unroll
    for (int d0 = 0; d0 < 8; ++d0) S.qr[d0] = bload8(rQ, qoff, cur.own * (QB * D * 2) + d0 * 32);
    SLOAD_H(H.K, H.V, kb0); VMW(); SWRITE_HK(0);
    __syncthreads();
}
template <int MODE>
__device__ __forceinline__ void moba_block(const HeadRef& H, const BlockRef& cur, const BlockRef& nxt, char* lds, Seam& S, const unsigned* sel, gu32* tmo) {
    int tid_ = threadIdx.x; asm volatile("" : "+v"(tid_));
    const int tid = tid_, wid = __builtin_amdgcn_readfirstlane(tid >> 6), lane = tid & 63, r32 = lane & 31, hi = lane >> 5;
    const int j_lo = cur.j_lo, NT = cur.j_hi - cur.j_lo;
    const int kbn = nxt.j_lo * KVBLK;
    const int P0 = cur.own * QB;
    const int qlo = P0 + wid * QBLK, qm = qlo + r32 - 4 * hi;
    const unsigned mysel = sel[wid * QBLK + r32];
    char* V_lds = lds; char* K_lds = lds + 2 * SHM_V;
    float* ws = (float*)(lds + 2 * SHM_V + 2 * SHM_K) + wid * 64; float* li_l = ws, * al_l = ws + 32;
    float m_reg = -1e30f, l_reg = 0; f32x16 o[4] = {};
    const int sr = tid >> 4, sc = (tid & 15) * 8, vst0 = v_st(sr, sc), vst1 = v_st(32 + sr, sc), kws = KSWZ(sr, sc * 2);
    const int vb0 = (int)(uintptr_t)V_lds + v_rd_base(lane);
    const u16* Kh = H.K; const u16* Vh = H.V; (void)Kh; (void)Vh;
    const rsrc_t rK = mkrsrc(H.K), rV = mkrsrc(H.V), rQ = mkrsrc(H.Q); const int voff = (sr * D + sc) * 2, qoff = ((wid * QBLK + r32) * D + hi * 8) * 2;
#define RESC(a) do { if (__any((a) < 1.f)) { if (hi == 0) al_l[r32] = (a); asm volatile("s_waitcnt lgkmcnt(0)" ::: "memory");              \
                     for (int d_ = 0; d_ < 4; ++d_) for (int r = 0; r < 16; ++r) o[d_][r] *= al_l[crow(r, hi)]; } } while (0)
#define KBASE(t) ((j_lo + (t)) * KVBLK)
#define MASKT(P0_, P1_, t) const int kb_ = KBASE(t); const int nb_ = kb_ >> 8; bool keep_ = true;                                   \
        if (nb_ < cur.own) { keep_ = ((mysel >> nb_) & 1u) != 0u; }                                                                     \
        else if (kb_ + KVBLK - 1 > qlo) { mask_tile(P0_, P1_, qm - kb_); }
#define MSM(P0_, P1_, mnX_, alX_, t) do { MASKT(P0_, P1_, t) partialSM(P0_, P1_, m_reg, mnX_, alX_, keep_); } while (0)
    constexpr int NQL = 8;
#define SEAM_K0() do { VMWN(NQL); SWRITE_HK(0); SBAR(); } while (0)
    f32x16 pA0, pA1, pB0, pB1; float mnA, mnB, alA, alB; bf16x8 pa0, pa1, pa2, pa3;
    SWRITE_HV(0); SBAR();
    if (NT > 1) { SLOAD_H(Kh, Vh, KBASE(1)); }
    SBAR(); qkt<0>(pA0, pA1, K_lds, r32, hi, S.qr);
    MSM(pA0, pA1, mnA, alA, 0);
    if (NT > 1) { VMW(); SWRITE_H(1); }
    __syncthreads();
#define HALF_STEP(PX0, PX1, mnX, alX, PY0, PY1, alY, t, KB, VB, SB) do {                                                      \
        SBAR(); qkt<KB>(PX0, PX1, K_lds, r32, hi, S.qr);                                             \
        finishSM(PY0, PY1, alY, l_reg, pa0, pa1, pa2, pa3); SBAR();                                                           \
        if ((t) + 1 < NT) { SLOAD_H(Kh, Vh, KBASE((t) + 1)); SBAR(); }                                               \
        pv_tile<VB>(o, vb0, pa0, pa1, pa2, pa3); MSM(PX0, PX1, mnX, alX, (t));                                        \
        __syncthreads();                                                                                                      \
        if ((t) + 1 < NT) { VMW(); SWRITE_H(SB); }                                                                          \
        RESC(alX); __syncthreads(); } while (0)
    for (int t = 1; t + 1 < NT; t += 2) {
        HALF_STEP(pB0, pB1, mnB, alB, pA0, pA1, alA, t, 1, 0, 0);
        HALF_STEP(pA0, pA1, mnA, alA, pB0, pB1, alB, t + 1, 0, 1, 1);
    }
    const bool even = (NT & 1) == 0;
    if (even) { SBAR(); qkt<1>(pB0, pB1, K_lds, r32, hi, S.qr); SBAR(); }
    SLOAD_H(H.K, H.V, kbn); SBAR();
#pragma unroll
    for (int d0 = 0; d0 < 8; ++d0) S.qr[d0] = bload8(rQ, qoff, nxt.own * (QB * D * 2) + d0 * 32);
    SBAR();
    finishSM(pA0, pA1, alA, l_reg, pa0, pa1, pa2, pa3); SBAR();
    pv_tile<0>(o, vb0, pa0, pa1, pa2, pa3);
    if (even) { MSM(pB0, pB1, mnB, alB, NT - 1); __syncthreads(); RESC(alB);
        finishSM(pB0, pB1, alB, l_reg, pa0, pa1, pa2, pa3); SBAR(); pv_tile<1>(o, vb0, pa0, pa1, pa2, pa3); }
    SBAR(); SEAM_K0();
    constexpr float C2 = 1.4426950408889634f * SCALE;
    if (MODE == 1) {
        float* Pw = cur.part + (size_t)(wid * QBLK) * D;
#pragma unroll
        for (int r = 0; r < 16; ++r) { const int orow = crow(r, hi);
#pragma unroll
            for (int d0 = 0; d0 < 4; ++d0) { float* p = Pw + (size_t)orow * D + d0 * 32 + r32; const float v = o[d0][r];
                asm volatile("global_store_dword %0, %1, off sc1" :: "v"((GAS float*)p), "v"(v) : "memory"); } }
        if (hi == 0) { float* p = cur.part + (size_t)QB * D + (size_t)(wid * QBLK + r32) * 2; f32x2 ml = {m_reg, l_reg};
            asm volatile("global_store_dwordx2 %0, %1, off sc1" :: "v"((GAS float*)p), "v"(ml) : "memory"); }
        asm volatile("s_waitcnt vmcnt(0)" ::: "memory");
        __syncthreads();
        if (tid == 0) __hip_atomic_store(cur.flag, 1u, __ATOMIC_RELAXED, __HIP_MEMORY_SCOPE_AGENT);
    } else {
        float f1 = 1.0f, f2 = 0.0f;
        if (MODE == 2) {
            if (wid == 0) { unsigned sp = 0;
                while (__builtin_amdgcn_readfirstlane(__hip_atomic_load(cur.flag, __ATOMIC_RELAXED, __HIP_MEMORY_SCOPE_AGENT)) == 0u) {
                    __builtin_amdgcn_s_sleep(2);
                    if (++sp > (1u << 22)) { if (lane == 0) __hip_atomic_store(tmo, 1u, __ATOMIC_RELAXED, __HIP_MEMORY_SCOPE_AGENT); break; } }
                __builtin_amdgcn_fence(__ATOMIC_ACQUIRE, "agent"); }
            asm volatile("s_waitcnt vmcnt(0)" ::: "memory");
            __syncthreads();
            const float* pml = cur.part + (size_t)QB * D + (size_t)(wid * QBLK + r32) * 2;
            const float m2 = ldgf(pml), l2 = ldgf(pml + 1);
            const float mN = fmaxf(m_reg, m2), a1 = __builtin_amdgcn_exp2f((m_reg - mN) * C2), a2 = __builtin_amdgcn_exp2f((m2 - mN) * C2);
            const float lt = a1 * l_reg + a2 * l2; const float il = 1.0f / lt; f1 = a1 * il; f2 = a2 * il;
        } else { f1 = 1.0f / l_reg; }
        if (hi == 0) { li_l[r32] = f1; al_l[r32] = f2; } asm volatile("s_waitcnt lgkmcnt(0)" ::: "memory");
        u16* op = cur.O + (size_t)(wid * QBLK + 4 * hi) * OSTRIDE + r32;
        const float* pp = cur.part + (size_t)(wid * QBLK + 4 * hi) * D + r32;
#pragma unroll
        for (int r = 0; r < 16; ++r) { const int orow = crow(r, hi); const float g1 = li_l[orow], g2 = al_l[orow];
#pragma unroll
            for (int d0 = 0; d0 < 4; ++d0) { float v = o[d0][r] * g1;
                if (MODE == 2) v += g2 * ldgf(pp + d0 * 32);
                const float vn = __shfl_xor(v, 1);
                if ((r32 & 1) == 0) *(GAS unsigned*)(op + d0 * 32) = cvtpk_asm(v, vn); }
            const int step = ((r & 3) == 3) ? 5 : 1; op += (size_t)step * OSTRIDE; pp += (size_t)step * D;
            asm volatile("" : "+v"(op), "+v"(pp)); }
    }
    __syncthreads();
#undef RESC
#undef KBASE
#undef MASKT
#undef MSM
#undef SEAM_K0
#undef HALF_STEP
}
#undef ROW
#undef VMW
#undef VMWN
#undef SLOAD_H
#undef SWRITE_HK
#undef SWRITE_HV
#undef SWRITE_H
#undef KSWZ
#undef SBAR
}

__device__ __forceinline__ f32x4 mfma16(bf16x8 a, bf16x8 b, f32x4 c) { return __builtin_amdgcn_mfma_f32_16x16x32_bf16(a, b, c, 0, 0, 0); }
constexpr int VT_LD = 136;
constexpr int KL_LD = 264;

__device__ __forceinline__ void chunk_gates(const float* GATES, int row0, int h, int lane, float& b0, float& b1, float& a0, float& a1) {
    const float i0 = ldgf(GATES + (size_t)(row0 + 2 * lane) * 8 + h), i1 = ldgf(GATES + (size_t)(row0 + 2 * lane + 1) * 8 + h);
    const float f0 = ldgf(GATES + (size_t)(row0 + 2 * lane) * 8 + 4 + h), f1 = ldgf(GATES + (size_t)(row0 + 2 * lane + 1) * 8 + 4 + h);
    float s = f0 + f1;
#pragma unroll
    for (int o = 1; o < 64; o <<= 1) { const float t = __shfl_up(s, o); if (lane >= o) s += t; }
    b1 = s; b0 = s - f1; a0 = i0 - b0; a1 = i1 - b1;
}

template <bool SCALE_W>
__device__ __forceinline__ void stage_T(const u16* src, LAS u16* T, const LAS float* w, int tid) {
    const int sp = tid & 63, s = 2 * sp;
#pragma unroll
    for (int i = 0; i < 4; ++i) {
        const int cc = (tid >> 6) + 8 * i;
        const u32x4 r0 = ldgu4(src + (size_t)s * MW + 8 * cc), r1 = ldgu4(src + (size_t)(s + 1) * MW + 8 * cc);
        float w0 = 1.f, w1 = 1.f; if (SCALE_W) { w0 = w[s]; w1 = w[s + 1]; }
#pragma unroll
        for (int e = 0; e < 4; ++e) {
            const unsigned x0 = r0[e], x1 = r1[e];
            unsigned lo, hi;
            if (SCALE_W) { lo = cvtpk(bflo(x0) * w0, bflo(x1) * w1); hi = cvtpk(bfhi(x0) * w0, bfhi(x1) * w1); }
            else { lo = (x0 & 0xffffu) | (x1 << 16); hi = (x0 >> 16) | (x1 & 0xffff0000u); }
            *(LAS unsigned*)(T + (size_t)(8 * cc + 2 * e) * VT_LD + s) = lo;
            *(LAS unsigned*)(T + (size_t)(8 * cc + 2 * e + 1) * VT_LD + s) = hi;
        }
    }
}

__device__ __forceinline__ void mlstm_A_unit(int unit, const u16* MK, const u16* MV, const float* GATES, u16* U, float* UN, float* CHS, LAS unsigned char* lds, int tid, int wave, int lane) {
    const int bh = unit >> 5, c = unit & 31, b = bh >> 2, h = bh & 3, row0 = b * TP + c * CH;
    LAS u16* VT = (LAS u16*)lds; LAS u16* KT = (LAS u16*)(lds + 256 * VT_LD * 2); LAS float* W = (LAS float*)(lds + 2 * 256 * VT_LD * 2);
    if (wave == 0) {
        float b0, b1, a0, a1; chunk_gates(GATES, row0, h, lane, b0, b1, a0, a1);
        const float G = wave_max(fmaxf(a0, a1)); const float A = __shfl(b1, 63);
        W[2 * lane] = __expf(a0 - G); W[2 * lane + 1] = __expf(a1 - G);
        if (lane == 0) { stgf(CHS + (size_t)(bh * NCH + c) * 2, A); stgf(CHS + (size_t)(bh * NCH + c) * 2 + 1, G); }
    }
    WG_BAR();
    stage_T<false>(MV + (size_t)row0 * MW + h * MD, VT, W, tid);
    stage_T<true>(MK + (size_t)row0 * MW + h * MD, KT, W, tid);
    WG_BAR();
    const int fr = lane & 15, fq = lane >> 4;
    u16* Uo = U + (size_t)(bh * NCH + c) * MD * MD;
#pragma unroll 1
    for (int vh = 0; vh < 2; ++vh) {
        f32x4 acc[2][8];
#pragma unroll
        for (int i = 0; i < 2; ++i)
#pragma unroll
            for (int j = 0; j < 8; ++j) acc[i][j] = (f32x4){0.f, 0.f, 0.f, 0.f};
#pragma unroll
        for (int ks = 0; ks < 4; ++ks) {
            bf16x8 af[2];
#pragma unroll
            for (int i = 0; i < 2; ++i) af[i] = *(const LAS bf16x8*)(KT + (size_t)(32 * wave + 16 * i + fr) * VT_LD + 32 * ks + 8 * fq);
#pragma unroll
            for (int j = 0; j < 8; ++j) { const bf16x8 bfr = *(const LAS bf16x8*)(VT + (size_t)(16 * (8 * vh + j) + fr) * VT_LD + 32 * ks + 8 * fq);
#pragma unroll
                for (int i = 0; i < 2; ++i) acc[i][j] = mfma16(af[i], bfr, acc[i][j]); }
        }
#pragma unroll
        for (int i = 0; i < 2; ++i)
#pragma unroll
            for (int j = 0; j < 8; ++j) { u32x2 w; w.x = cvtpk(acc[i][j][0], acc[i][j][1]); w.y = cvtpk(acc[i][j][2], acc[i][j][3]);
                stgu2(Uo + (size_t)(16 * (8 * vh + j) + fr) * MD + 32 * wave + 16 * i + 4 * fq, w); }
    }
    if (tid < 256) { float s = 0.f;
#pragma unroll
        for (int i = 0; i < 16; ++i) { const u32x4 x = *(const LAS u32x4*)(KT + (size_t)tid * VT_LD + 8 * i);
#pragma unroll
            for (int e = 0; e < 4; ++e) s += bflo(x[e]) + bfhi(x[e]); }
        stgf(UN + (size_t)(bh * NCH + c) * MD + tid, s); }
    WG_BAR();
}

__device__ __forceinline__ void mlstm_B(int gid, int gstride, const u16* U, const float* UN, const float* CHS, u16* CST, float* NST, float* MST, float* Cout, float* nout, float* mout) {
    for (int g = gid; g < 8 * 16384 + 8 * 64; g += gstride) {
        if (g < 8 * 16384) {
            const int bh = g >> 14, e = (g & 16383) * 4;
            float m = 0.f; f32x4 C = (f32x4){0.f, 0.f, 0.f, 0.f};
#pragma unroll 8
            for (int c = 0; c < NCH; ++c) {
                const float A = ldgf(CHS + (size_t)(bh * NCH + c) * 2), G = ldgf(CHS + (size_t)(bh * NCH + c) * 2 + 1);
                const float M = fmaxf(m, G), sC = __expf(m - M), sU = __expf(G - M);
                const size_t off = (size_t)(bh * NCH + c) * MD * MD + e;
                u32x2 w; w.x = cvtpk(C[0], C[1]); w.y = cvtpk(C[2], C[3]); stgu2(CST + off, w);
                if (e == 0) stgf(MST + bh * 33 + c, m);
                const u32x2 u = ldgu2(U + off);
                C[0] = sC * C[0] + sU * bflo(u.x); C[1] = sC * C[1] + sU * bfhi(u.x); C[2] = sC * C[2] + sU * bflo(u.y); C[3] = sC * C[3] + sU * bfhi(u.y);
                m = A + M;
            }
            stg4(Cout + (size_t)bh * MD * MD + e, C);
            if (e == 0) { stgf(mout + bh, m); stgf(MST + bh * 33 + 32, m); }
        } else {
            const int g2 = g - 8 * 16384, bh = g2 >> 6, e = (g2 & 63) * 4;
            float m = 0.f; f32x4 N = (f32x4){0.f, 0.f, 0.f, 0.f};
            for (int c = 0; c < NCH; ++c) {
                const float A = ldgf(CHS + (size_t)(bh * NCH + c) * 2), G = ldgf(CHS + (size_t)(bh * NCH + c) * 2 + 1);
                const float M = fmaxf(m, G), sC = __expf(m - M), sU = __expf(G - M);
                const size_t off = (size_t)(bh * NCH + c) * MD + e;
                stg4(NST + off, N);
                const f32x4 u = ldg4(UN + off);
                N = sC * N + sU * u; m = A + M;
            }
            stg4(nout + (size_t)bh * MD + e, N);
        }
    }
}

__device__ __forceinline__ void mlstm_C_unit(int unit, const u16* MQ, const u16* MK, const u16* MV, const u16* MO, const float* GATES, const u16* CST, const float* NST, const float* MST,
                                             const float* gm, u16* MIX, LAS unsigned char* lds, int tid, int wave, int lane) {
    const int bh = unit >> 5, c = unit & 31, b = bh >> 2, h = bh & 3, row0 = b * TP + c * CH;
    LAS u16* VT = (LAS u16*)lds; LAS u16* KL = (LAS u16*)(lds + 256 * VT_LD * 2);
    LAS float* AS = (LAS float*)(lds + 256 * VT_LD * 2 + 128 * KL_LD * 2); LAS float* MTt = AS + 128; LAS float* INTER = AS + 256; LAS float* EMT = AS + 384;
    if (wave == 0) {
        float b0, b1, a0, a1; chunk_gates(GATES, row0, h, lane, b0, b1, a0, a1);
        const float mc = ldgf(MST + bh * 33 + c);
        float pm = fmaxf(a0, a1);
#pragma unroll
        for (int o = 1; o < 64; o <<= 1) { const float t = __shfl_up(pm, o); if (lane >= o) pm = fmaxf(pm, t); }
        float pprev = __shfl_up(pm, 1); if (lane == 0) pprev = -__builtin_inff();
        const float p0 = fmaxf(pprev, a0), p1 = pm;
        const float M0 = fmaxf(mc, p0), M1 = fmaxf(mc, p1);
        AS[2 * lane] = a0; AS[2 * lane + 1] = a1; MTt[2 * lane] = M0; MTt[2 * lane + 1] = M1;
        INTER[2 * lane] = __expf(mc - M0); INTER[2 * lane + 1] = __expf(mc - M1);
        EMT[2 * lane] = __expf(-(b0 + M0)); EMT[2 * lane + 1] = __expf(-(b1 + M1));
    }
    { const u16* ksrc = MK + (size_t)row0 * MW + h * MD;
#pragma unroll
      for (int i = 0; i < 8; ++i) { const int q = tid + 512 * i, s = q >> 5, cc = q & 31;
          *(LAS u32x4*)(KL + (size_t)s * KL_LD + 8 * cc) = ldgu4(ksrc + (size_t)s * MW + 8 * cc); } }
    stage_T<false>(MV + (size_t)row0 * MW + h * MD, VT, nullptr, tid);
    const int fr = lane & 15, fq = lane >> 4, t = 16 * wave + fr;
    bf16x8 qf[8];
    { const u16* qrow = MQ + (size_t)(row0 + t) * MW + h * MD + 8 * fq;
#pragma unroll
      for (int ks = 0; ks < 8; ++ks) qf[ks] = __builtin_bit_cast(bf16x8, ldgu4(qrow + 32 * ks)); }
    float nq = 0.f;
    { const float* np = NST + (size_t)(bh * NCH + c) * MD + 8 * fq;
#pragma unroll
      for (int ks = 0; ks < 8; ++ks) { const f32x4 n0 = ldg4(np + 32 * ks), n1 = ldg4(np + 32 * ks + 4); const u32x4 qw = __builtin_bit_cast(u32x4, qf[ks]);
          nq += n0[0] * bflo(qw.x) + n0[1] * bfhi(qw.x) + n0[2] * bflo(qw.y) + n0[3] * bfhi(qw.y) + n1[0] * bflo(qw.z) + n1[1] * bfhi(qw.z) + n1[2] * bflo(qw.w) + n1[3] * bfhi(qw.w); }
      nq += __shfl_xor(nq, 16); nq += __shfl_xor(nq, 32); }
    f32x4 acc[16];
#pragma unroll
    for (int j = 0; j < 16; ++j) acc[j] = (f32x4){0.f, 0.f, 0.f, 0.f};
    { const u16* cp = CST + (size_t)(bh * NCH + c) * MD * MD + (size_t)fr * MD + 8 * fq;
#pragma unroll
      for (int j = 0; j < 16; ++j)
#pragma unroll
          for (int ks = 0; ks < 8; ++ks) acc[j] = mfma16(__builtin_bit_cast(bf16x8, ldgu4(cp + (size_t)(16 * j) * MD + 32 * ks)), qf[ks], acc[j]); }
    WG_BAR();
    const float inter = INTER[t], Mt = MTt[t];
#pragma unroll
    for (int j = 0; j < 16; ++j) acc[j] = acc[j] * inter;
    float den = 0.f;
    for (int kk = 0; 2 * kk <= wave; ++kk) {
        f32x4 st[2];
#pragma unroll
        for (int i = 0; i < 2; ++i) { st[i] = (f32x4){0.f, 0.f, 0.f, 0.f}; const int sb = 2 * kk + i;
            if (sb <= wave) {
#pragma unroll
                for (int ks = 0; ks < 8; ++ks) st[i] = mfma16(*(const LAS bf16x8*)(KL + (size_t)(16 * sb + fr) * KL_LD + 32 * ks + 8 * fq), qf[ks], st[i]);
#pragma unroll
                for (int r = 0; r < 4; ++r) { const int s = 16 * sb + 4 * fq + r; const float wgt = (s <= t) ? __expf(AS[s] - Mt) : 0.f; st[i][r] *= wgt; den += st[i][r]; }
            } }
        u32x4 pw; pw.x = cvtpk(st[0][0], st[0][1]); pw.y = cvtpk(st[0][2], st[0][3]); pw.z = cvtpk(st[1][0], st[1][1]); pw.w = cvtpk(st[1][2], st[1][3]);
        const bf16x8 pf = __builtin_bit_cast(bf16x8, pw);
#pragma unroll
        for (int j = 0; j < 16; ++j) { const LAS u16* vp = VT + (size_t)(16 * j + fr) * VT_LD + 32 * kk + 4 * fq;
            const u32x2 lo = *(const LAS u32x2*)vp, hi = *(const LAS u32x2*)(vp + 16); u32x4 aw; aw.x = lo.x; aw.y = lo.y; aw.z = hi.x; aw.w = hi.y;
            acc[j] = mfma16(__builtin_bit_cast(bf16x8, aw), pf, acc[j]); }
    }
    den += __shfl_xor(den, 16); den += __shfl_xor(den, 32);
    den += inter * nq;
    const float idn = 1.0f / fmaxf(fabsf(den), EMT[t]);
    float ss = 0.f;
#pragma unroll
    for (int j = 0; j < 16; ++j) { acc[j] = acc[j] * idn; ss += dot4(acc[j], acc[j]); }
    ss += __shfl_xor(ss, 16); ss += __shfl_xor(ss, 32);
    const float rs = 1.0f / sqrtf(ss * (1.0f / MD) + EPS);
    const u16* op = MO + (size_t)(row0 + t) * MW + h * MD + 4 * fq; u16* mp = MIX + (size_t)(row0 + t) * DM + h * MD + 4 * fq; const float* gp = gm + h * MD + 4 * fq;
#pragma unroll
    for (int j = 0; j < 16; ++j) { const u32x2 ow = ldgu2(op + 16 * j); const f32x4 gv = ldg4(gp + 16 * j);
        const float o0 = sigmoidf_(bflo(ow.x)), o1 = sigmoidf_(bfhi(ow.x)), o2 = sigmoidf_(bflo(ow.y)), o3 = sigmoidf_(bfhi(ow.y));
        u32x2 w; w.x = cvtpk(acc[j][0] * rs * gv[0] * o0, acc[j][1] * rs * gv[1] * o1); w.y = cvtpk(acc[j][2] * rs * gv[2] * o2, acc[j][3] * rs * gv[3] * o3);
        stgu2(mp + 16 * j, w); }
    WG_BAR();
}

__device__ __forceinline__ void transpose_item(const float* W, int K, int Nsrc, u16* WT, int k0, int n0, int sc0, LAS float* scr, int lane) {
#pragma unroll 8
    for (int i = 0; i < 32; ++i) { const int kk = 2 * i + (lane >> 5); scr[kk * 33 + (lane & 31)] = ldgf(W + (size_t)(k0 + kk) * Nsrc + sc0 + (lane & 31)); }
    LDS_WAIT(); asm volatile("" ::: "memory");
    const int c = lane & 7;
#pragma unroll
    for (int j = 0; j < 4; ++j) { const int n = (lane >> 3) + 8 * j; const LAS float* s = scr + (8 * c) * 33 + n;
        u32x4 o; o.x = cvtpk(s[0 * 33], s[1 * 33]); o.y = cvtpk(s[2 * 33], s[3 * 33]); o.z = cvtpk(s[4 * 33], s[5 * 33]); o.w = cvtpk(s[6 * 33], s[7 * 33]);
        stgu4(WT + (size_t)(n0 + n) * K + k0 + 8 * c, o); }
    LDS_WAIT(); asm volatile("" ::: "memory");
}
__device__ __forceinline__ int win_src_col(int n) {
    if (n < 4096) return n;
    const int a = n - 4096, sec = a >> 10, r = a & 1023, pt = r >> 8, tc = r & 255;
    return 4104 + sec * 1024 + (pt * 2 + ((tc >> 6) & 1)) * 128 + (tc >> 7) * 64 + (tc & 63);
}
__device__ __forceinline__ int wup_src_col(int n) { const int pn = n >> 8, tc = n & 255; return tc < 128 ? pn * 128 + tc : DFF + pn * 128 + (tc - 128); }

__device__ __forceinline__ void sincos_d(double a, float& s, float& c) {
    const double n = __builtin_rint(a * 0.15915494309189535);
    double r = __builtin_fma(-n, 6.283185307179586, a); r = __builtin_fma(-n, 2.4492935982947064e-16, r);
    const double r2 = r * r; double ts = 1.0, ss = 1.0, tc = 1.0, cs = 1.0;
#pragma unroll
    for (int k = 1; k <= 14; ++k) { tc *= -r2 * (1.0 / ((2.0 * k - 1.0) * (2.0 * k))); cs += tc; ts *= -r2 * (1.0 / ((2.0 * k) * (2.0 * k + 1.0))); ss += ts; }
    s = (float)(r * ss); c = (float)cs;
}

__device__ __forceinline__ void norm1_row(const float* xrow, u16* orow, float* grow, const LAS float* GW, const LAS float* G1, const float* bg, int lane) {
    f32x4 v[8]; float s = 0.f, ga[8];
#pragma unroll
    for (int j = 0; j < 8; ++j) ga[j] = 0.f;
#pragma unroll
    for (int i = 0; i < 8; ++i) { v[i] = ldg4(xrow + 256 * i + 4 * lane); s += dot4(v[i], v[i]);
#pragma unroll
        for (int j = 0; j < 8; ++j) ga[j] += dot4(v[i], *(const LAS f32x4*)(GW + j * DM + 256 * i + 4 * lane));
        asm volatile("" ::: "memory"); }
    s = wave_sum(s); const float rstd = 1.0f / sqrtf(s * (1.0f / DM) + EPS);
#pragma unroll
    for (int j = 0; j < 8; ++j) ga[j] = wave_sum(ga[j]) * rstd;
#pragma unroll
    for (int i = 0; i < 8; ++i) { const f32x4 g = *(const LAS f32x4*)(G1 + 256 * i + 4 * lane); u32x2 w; w.x = cvtpk(v[i][0] * rstd * g[0], v[i][1] * rstd * g[1]); w.y = cvtpk(v[i][2] * rstd * g[2], v[i][3] * rstd * g[3]);
        stgu2(orow + 256 * i + 4 * lane, w); }
    if (lane < 8) { float z = 0.f;
#pragma unroll
        for (int j = 0; j < 8; ++j) z = (lane == j) ? ga[j] : z;
        z += ldgf(bg + lane);
        if (lane >= 4) z = fminf(z, 0.f) - log1pf(__expf(-fabsf(z)));
        stgf(grow + lane, z); }
}

__device__ __forceinline__ void kmean_prompt_unit(int unit, const u16* AK, float* KM, LAS unsigned char* lds, int tid) {
    const u16* src = AK + (size_t)unit * 256 * AD;
    const int cc = tid & 15, rg = tid >> 4; f32x4 s0 = {0.f, 0.f, 0.f, 0.f}, s1 = s0;
#pragma unroll
    for (int i = 0; i < 8; ++i) { const u32x4 x = ldgu4(src + (size_t)(rg * 8 + i) * AD + 8 * cc);
        s0[0] += bflo(x.x); s0[1] += bfhi(x.x); s0[2] += bflo(x.y); s0[3] += bfhi(x.y); s1[0] += bflo(x.z); s1[1] += bfhi(x.z); s1[2] += bflo(x.w); s1[3] += bfhi(x.w); }
    LAS float* R = (LAS float*)lds;
    *(LAS f32x4*)(R + (rg * 16 + cc) * 8) = s0; *(LAS f32x4*)(R + (rg * 16 + cc) * 8 + 4) = s1;
    WG_BAR();
    if (tid < 128) { float s = 0.f;
#pragma unroll
        for (int g = 0; g < 32; ++g) s += R[(g * 16 + (tid >> 3)) * 8 + (tid & 7)];
        stgf(KM + (size_t)unit * AD + tid, s * (1.0f / 256.0f)); }
    WG_BAR();
}

__device__ __forceinline__ void kmean_sample_unit(int unit, const float* cache_k, const int* page_table, float* KMS, LAS unsigned char* lds, int tid) {
    const int b = unit >> 6, n = unit & 63, c4 = tid & 255, rh = tid >> 8;
    f32x4 s = {0.f, 0.f, 0.f, 0.f};
#pragma unroll
    for (int pg = 0; pg < 2; ++pg) {
        const int page = *(const GAS int*)(page_table + b * NPAGES + 2 * n + pg);
        const float* base = cache_k + (size_t)page * PAGE * AW + (size_t)rh * AW + 4 * c4;
#pragma unroll 16
        for (int r = 0; r < 64; ++r) s = s + ldg4(base + (size_t)(2 * r) * AW);
    }
    LAS float* R = (LAS float*)lds;
    if (rh == 1) *(LAS f32x4*)(R + 4 * c4) = s;
    WG_BAR();
    if (rh == 0) { s = s + *(LAS f32x4*)(R + 4 * c4); s = s * (1.0f / 256.0f); const int h = c4 >> 5, d = (c4 & 31) * 4;
        stg4(KMS + ((size_t)(b * AH + h) * NBS + n) * AD + d, s); }
    WG_BAR();
}

__device__ __forceinline__ void skinny_unit(const u16* A, const u16* Bt, int K, int ca, int cb, LAS unsigned char* lds, int tid, int wave, int lane) {
    const int fr = lane & 15, fq = lane >> 4, kw = K >> 3, k0 = wave * kw;
    f32x4 acc[4][2];
#pragma unroll
    for (int i = 0; i < 4; ++i) { acc[i][0] = (f32x4){0.f, 0.f, 0.f, 0.f}; acc[i][1] = acc[i][0]; }
    const u16* ap = A + (size_t)fr * K + k0 + 8 * fq; const u16* bpa = Bt + (size_t)(ca + fr) * K + k0 + 8 * fq; const u16* bpb = Bt + (size_t)(cb + fr) * K + k0 + 8 * fq;
#pragma unroll 2
    for (int ks = 0; ks < kw; ks += 32) {
        const bf16x8 b0 = __builtin_bit_cast(bf16x8, ldgu4(bpa + ks)), b1 = __builtin_bit_cast(bf16x8, ldgu4(bpb + ks));
#pragma unroll
        for (int mb = 0; mb < 4; ++mb) { const bf16x8 a = __builtin_bit_cast(bf16x8, ldgu4(ap + (size_t)(16 * mb) * K + ks));
            acc[mb][0] = mfma16(a, b0, acc[mb][0]); acc[mb][1] = mfma16(a, b1, acc[mb][1]); }
    }
    LAS float* red = (LAS float*)lds + wave * 2048;
#pragma unroll
    for (int mb = 0; mb < 4; ++mb)
#pragma unroll
        for (int cbk = 0; cbk < 2; ++cbk)
#pragma unroll
            for (int r = 0; r < 4; ++r) red[(16 * mb + 4 * fq + r) * 32 + 16 * cbk + fr] = acc[mb][cbk][r];
    WG_BAR();
    f32x4 s = {0.f, 0.f, 0.f, 0.f};
#pragma unroll
    for (int w = 0; w < 8; ++w) s = s + *(const LAS f32x4*)((LAS float*)lds + w * 2048 + 4 * tid);
    *(LAS f32x4*)((LAS float*)(lds + 65536) + 4 * tid) = s;
    WG_BAR();
}

__device__ __forceinline__ void sample_select_unit(int unit, const float* QS, const float* KMS, int* SEL, LAS unsigned char* lds, int tid) {
    const int b = unit >> 3, h = unit & 7, q = tid >> 6, n = tid & 63;
    const float* qp = QS + ((size_t)(b * TS + q) * AH + h) * AD; const float* kp = KMS + ((size_t)(b * AH + h) * NBS + n) * AD;
    float s = 0.f;
#pragma unroll 8
    for (int d = 0; d < AD; d += 4) s += dot4(ldg4(qp + d), ldg4(kp + d));
    LAS float* SC = (LAS float*)lds; SC[q * 64 + n] = s;
    WG_BAR();
    if (tid < 8) { float b0 = -__builtin_inff(), b1 = b0, b2 = b0; int i0 = 0, i1 = 0, i2 = 0;
        for (int j = 0; j < 64; ++j) { const float v = SC[tid * 64 + j];
            if (v > b0) { b2 = b1; i2 = i1; b1 = b0; i1 = i0; b0 = v; i0 = j; } else if (v > b1) { b2 = b1; i2 = i1; b1 = v; i1 = j; } else if (v > b2) { b2 = v; i2 = j; } }
        int* o = SEL + ((size_t)(b * TS + tid) * AH + h) * 4; *(GAS int*)o = i0; *(GAS int*)(o + 1) = i1; *(GAS int*)(o + 2) = i2; }
    WG_BAR();
}
__device__ __forceinline__ void sample_attend_unit(int unit, const float* QS, const float* KSN, const float* VSN, const float* cache_k, const float* cache_v, const int* page_table, const int* SEL,
                                                   u16* MIX, LAS unsigned char* lds, int tid, int wave, int lane) {
    const int b = unit >> 6, q = (unit >> 3) & 7, h = unit & 7, row = b * TS + q;
    LAS float* SC = (LAS float*)lds;
    LAS float* RED = SC + 800;
    LAS float* WR = RED + 2048;
    const int* sp = SEL + ((size_t)row * AH + h) * 4;
    int pages[6];
#pragma unroll
    for (int s = 0; s < 3; ++s) { const int blk = *(const GAS int*)(sp + s); pages[2 * s] = *(const GAS int*)(page_table + b * NPAGES + 2 * blk); pages[2 * s + 1] = *(const GAS int*)(page_table + b * NPAGES + 2 * blk + 1); }
    const float* qp = QS + ((size_t)row * AH + h) * AD;
    const int sub = lane & 15, kq = lane >> 4;
    const f32x4 q0 = ldg4(qp + 8 * sub), q1 = ldg4(qp + 8 * sub + 4);
#pragma unroll 4
    for (int it = 0; it < 24; ++it) {
        const int k = it * 32 + wave * 4 + kq, pg = k >> 7, pp = k & 127;
        int page = pages[0];
#pragma unroll
        for (int s = 1; s < 6; ++s) page = (pg == s) ? pages[s] : page;
        const float* kp = cache_k + ((size_t)page * PAGE + pp) * AW + h * AD + 8 * sub;
        float d = dot4(ldg4(kp), q0) + dot4(ldg4(kp + 4), q1);
        d += __shfl_xor(d, 1); d += __shfl_xor(d, 2); d += __shfl_xor(d, 4); d += __shfl_xor(d, 8);
        if (sub == 0) SC[k] = d * ATT_SCALE;
    }
    if (wave == 0 && kq <= q && kq < 4) { const float* kp = KSN + ((size_t)(b * TS + kq) * AH + h) * AD + 8 * sub; float d = dot4(ldg4(kp), q0) + dot4(ldg4(kp + 4), q1);
        d += __shfl_xor(d, 1); d += __shfl_xor(d, 2); d += __shfl_xor(d, 4); d += __shfl_xor(d, 8); if (sub == 0) SC[768 + kq] = d * ATT_SCALE; }
    if (wave == 1 && kq + 4 <= q) { const float* kp = KSN + ((size_t)(b * TS + kq + 4) * AH + h) * AD + 8 * sub; float d = dot4(ldg4(kp), q0) + dot4(ldg4(kp + 4), q1);
        d += __shfl_xor(d, 1); d += __shfl_xor(d, 2); d += __shfl_xor(d, 4); d += __shfl_xor(d, 8); if (sub == 0) SC[768 + kq + 4] = d * ATT_SCALE; }
    WG_BAR();
    const int nk = 768 + q + 1;
    float mx = -__builtin_inff();
    for (int k = tid; k < nk; k += 512) mx = fmaxf(mx, SC[k]);
    mx = wave_max(mx); if (lane == 0) WR[wave] = mx;
    WG_BAR();
    mx = WR[0];
#pragma unroll
    for (int w = 1; w < 8; ++w) mx = fmaxf(mx, WR[w]);
    float sm = 0.f;
    for (int k = tid; k < nk; k += 512) { const float p = __expf(SC[k] - mx); SC[k] = p; sm += p; }
    sm = wave_sum(sm); if (lane == 0) WR[8 + wave] = sm;
    WG_BAR();
    sm = 0.f;
#pragma unroll
    for (int w = 0; w < 8; ++w) sm += WR[8 + w];
    const float isum = 1.0f / sm;
    const int d4 = tid & 31, g = tid >> 5; f32x4 o = {0.f, 0.f, 0.f, 0.f};
#pragma unroll 8
    for (int it = 0; it < 48; ++it) { const int k = it * 16 + g, pg = k >> 7, pp = k & 127;
        int page = pages[0];
#pragma unroll
        for (int s = 1; s < 6; ++s) page = (pg == s) ? pages[s] : page;
        o = o + ldg4(cache_v + ((size_t)page * PAGE + pp) * AW + h * AD + 4 * d4) * SC[k]; }
    if (g <= q && g < 8) o = o + ldg4(VSN + ((size_t)(b * TS + g) * AH + h) * AD + 4 * d4) * SC[768 + g];
    *(LAS f32x4*)(RED + g * 128 + 4 * d4) = o;
    WG_BAR();
    if (tid < 128) { float s = 0.f;
#pragma unroll
        for (int gg = 0; gg < 16; ++gg) s += RED[gg * 128 + tid];
        *(GAS u16*)(MIX + (size_t)(MP + row) * DM + MW + h * AD + tid) = (u16)f2bf(s * isum); }
    WG_BAR();
}

__device__ __forceinline__ void sample_mlstm_unit(int unit, const float* QKVO  , const float* GATES, const float* C0, const float* n0, const float* m0, const float* gm,
                                                  float* Cout, float* nout, float* mout, u16* MIX, LAS unsigned char* lds, int tid, int wave, int lane) {
    const int b = unit >> 2, h = unit & 3, r0 = b * TS;
    LAS float* QL = (LAS float*)lds; LAS float* KL = QL + 2048; LAS float* VL = KL + 2048; LAS float* CQ = VL + 2048; LAS float* HS = CQ + 2048;
    LAS float* SP = HS + 2048;
    LAS float* SCL = SP + 64;
    for (int i = tid; i < 2048; i += 512) { const int t = i >> 8, d = i & 255; const float* rp = QKVO + (size_t)(r0 + t) * 4096 + h * MD + d;
        QL[i] = ldgf(rp); KL[i] = ldgf(rp + 1024) * 0.0625f; VL[i] = ldgf(rp + 2048); }
    if (tid < 8) {
        const float mp = ldgf(m0 + b * MH + h); float bc = 0.f, pm = -__builtin_inff(); float a_[8], M_[8], b_[8];
#pragma unroll
        for (int t = 0; t < 8; ++t) { const float ig = ldgf(GATES + (size_t)(MP + r0 + t) * 8 + h), lf = ldgf(GATES + (size_t)(MP + r0 + t) * 8 + 4 + h);
            bc += lf; b_[t] = bc; a_[t] = ig - bc; pm = fmaxf(pm, a_[t]); M_[t] = fmaxf(mp, pm); }
        const int t = tid;
        float at = 0.f, Mt = 0.f, bt = 0.f;
#pragma unroll
        for (int j = 0; j < 8; ++j) { at = (j == t) ? a_[j] : at; Mt = (j == t) ? M_[j] : Mt; bt = (j == t) ? b_[j] : bt; }
        SCL[t] = at; SCL[8 + t] = Mt; SCL[16 + t] = __expf(mp - Mt); SCL[24 + t] = __expf(-(bt + Mt)); SCL[32 + t] = __expf(at - M_[7]);
        if (t == 0) { SCL[64] = __expf(mp - M_[7]); SCL[65] = b_[7] + M_[7]; }
    }
    WG_BAR();
    if (tid < 64) { const int t = tid >> 3, s = tid & 7; float d = 0.f;
        for (int i = 0; i < 256; ++i) d += QL[t * 256 + i] * KL[s * 256 + i];
        SP[tid] = (s <= t) ? d * __expf(SCL[s] - SCL[8 + t]) : 0.f; }
    else if (tid < 72) { const int t = tid - 64; float d = 0.f;
        for (int i = 0; i < 256; ++i) d += QL[t * 256 + i] * ldgf(n0 + (size_t)(b * MH + h) * MD + i);
        SCL[48 + t] = d; }
    WG_BAR();
    { f32x4 qv[8], kv[8];
#pragma unroll
      for (int t = 0; t < 8; ++t) { qv[t] = *(const LAS f32x4*)(QL + t * 256 + 4 * lane); kv[t] = *(const LAS f32x4*)(KL + t * 256 + 4 * lane); }
      const float decay = SCL[64];
      const float* Cb = C0 + (size_t)(b * MH + h) * MD * MD; float* Co = Cout + (size_t)(b * MH + h) * MD * MD;
      for (int i = 0; i < 32; ++i) { const int v = wave + 8 * i;
          const f32x4 c4 = ldg4(Cb + (size_t)v * MD + 4 * lane); f32x4 nc = c4 * decay; float part[8];
#pragma unroll
          for (int t = 0; t < 8; ++t) { part[t] = dot4(c4, qv[t]); nc = nc + kv[t] * (SCL[32 + t] * VL[t * 256 + v]); }
          stg4(Co + (size_t)v * MD + 4 * lane, nc);
#pragma unroll
          for (int t = 0; t < 8; ++t) part[t] = wave_sum(part[t]);
          if (lane < 8) { float z = 0.f;
#pragma unroll
              for (int t = 0; t < 8; ++t) z = (lane == t) ? part[t] : z;
              CQ[lane * 256 + v] = z; } } }
    if (tid < 256) { const int d = tid; float nn = SCL[64] * ldgf(n0 + (size_t)(b * MH + h) * MD + d);
        for (int s = 0; s < 8; ++s) nn += SCL[32 + s] * KL[s * 256 + d];
        stgf(nout + (size_t)(b * MH + h) * MD + d, nn); }
    if (tid == 0) stgf(mout + b * MH + h, SCL[65]);
    WG_BAR();
    { const int v = tid & 255, th = tid >> 8;
#pragma unroll
      for (int i = 0; i < 4; ++i) { const int t = th + 2 * i; float num = SCL[16 + t] * CQ[t * 256 + v], den = SCL[16 + t] * SCL[48 + t];
          for (int s = 0; s <= t; ++s) { num += SP[t * 8 + s] * VL[s * 256 + v]; den += SP[t * 8 + s]; }
          HS[t * 256 + v] = num / fmaxf(fabsf(den), SCL[24 + t]); } }
    WG_BAR();
    { float ss = 0.f;
#pragma unroll
      for (int i = 0; i < 4; ++i) { const float x = HS[wave * 256 + lane + 64 * i]; ss += x * x; }
      ss = wave_sum(ss); if (lane == 0) SCL[56 + wave] = 1.0f / sqrtf(ss * (1.0f / MD) + EPS); }
    WG_BAR();
    { const int v = tid & 255, th = tid >> 8;
#pragma unroll
      for (int i = 0; i < 4; ++i) { const int t = th + 2 * i; const float o = ldgf(QKVO + (size_t)(r0 + t) * 4096 + 3072 + h * MD + v);
          const float y = HS[t * 256 + v] * SCL[56 + t] * ldgf(gm + h * MD + v) * sigmoidf_(o);
          *(GAS u16*)(MIX + (size_t)(MP + r0 + t) * DM + h * MD + v) = (u16)f2bf(y); } }
    WG_BAR();
}

constexpr int NWAVES = 8, NTHREADS = 512;
#ifndef MK_N_LAUNCHES
#define MK_N_LAUNCHES 1
#endif
constexpr int N_PHASES = 9;
constexpr size_t MiB = 1u << 20;
constexpr size_t WS_CTL = 0, CTL_ZERO_BYTES = 1 * MiB;
constexpr size_t WS_WIN = 2 * MiB, WS_WOUT = 30 * MiB, WS_WUP = 38 * MiB, WS_WDN = 82 * MiB, WS_ROPE = 104 * MiB, WS_GATES = 108 * MiB, WS_XN = 109 * MiB;
constexpr size_t WS_MQ = 142 * MiB, WS_MK = 158 * MiB, WS_MV = 174 * MiB, WS_MO = 190 * MiB, WS_AQ = 206 * MiB, WS_AK = 222 * MiB, WS_AV = 238 * MiB;
constexpr size_t WS_U = 254 * MiB, WS_CST = 286 * MiB, WS_SMALL = 318 * MiB, WS_MIXED = 334 * MiB, WS_X1 = 367 * MiB, WS_X1G = 433 * MiB, WS_SS = 466 * MiB;
constexpr size_t WS_ACT = 470 * MiB, WS_UB = 561 * MiB, WS_PART = 567 * MiB, WS_END = 585 * MiB;
constexpr size_t SM_CHS = 0, SM_MST = 64 * 1024, SM_KMP = 128 * 1024, SM_UN = 256 * 1024, SM_NST = 512 * 1024, SM_QKVO = 1 * MiB, SM_KMS = 2 * MiB, SM_QS = 4 * MiB,
                 SM_KSN = 4 * MiB + 256 * 1024, SM_VSN = 4 * MiB + 512 * 1024, SM_SEL = 4 * MiB + 768 * 1024, SM_SSS1 = 4 * MiB + 800 * 1024, SM_SSS2 = 4 * MiB + 832 * 1024;
constexpr int CW_TMO = 0, CW_BAR = 4096, CW_UPCNT = 8192, CW_AFLAG = 16384;
constexpr int RING_BYTES = 131072, XCH_OFF = 131072, MISC_OFF = 163840 - 256, LDS_BYTES = 163840;
constexpr int SELT_OFF = 67584, KML_OFF = 69632;

#define RLX_AGENT __ATOMIC_RELAXED, __HIP_MEMORY_SCOPE_AGENT
static_assert(WS_MK - WS_MQ == 16 * MiB && WS_MV - WS_MK == 16 * MiB && WS_MO - WS_MV == 16 * MiB && WS_AK - WS_AQ == 16 * MiB && WS_AV - WS_AK == 16 * MiB, "EpiIn's section strides");
static_assert(SM_KSN - SM_QS == 256 * 1024 && SM_VSN - SM_KSN == 256 * 1024 && O_VP - O_KP == (size_t)MP * AW && O_VS - O_KS == (size_t)MS * AW, "skinny_epi_in's section strides");
#define XB_TMO      128
#define XB_XCNT(j)  (256  + 64 * (j))
#define XB_XSUB(j)  (1280 + 64 * (j))
#define XB_XGEN(j)  (2304 + 64 * (j))
#define XB_TOP      3328
#define XB_TOPGEN   3392
#define XCD_BAR_WORDS 3456
#define XB_SPIN_CAP (1u << 18)

__device__ __forceinline__ unsigned xb_ld(unsigned* p)              { return __hip_atomic_load(p, __ATOMIC_RELAXED, __HIP_MEMORY_SCOPE_AGENT); }
__device__ __forceinline__ unsigned xb_add(unsigned* p, unsigned v) { return __hip_atomic_fetch_add(p, v, __ATOMIC_RELAXED, __HIP_MEMORY_SCOPE_AGENT); }
__device__ __forceinline__ unsigned xb_xcc_id() { return (unsigned)__builtin_amdgcn_s_getreg((3 << 11) | 20) & 0xFu; }
#define XB_SPIN(cond, bar) do { unsigned _sp = 0; while (cond) { __builtin_amdgcn_s_sleep(1); \
    if ((++_sp & 255u) == 0u) { if (xb_ld(&(bar)[XB_TMO])) break; if (_sp > XB_SPIN_CAP) { atomicAdd(&(bar)[XB_TMO], 1u); break; } } } } while (0)

struct XcdBarrier {
    unsigned* bar; unsigned x;
    volatile LAS unsigned* st;
};

__device__ __forceinline__ XcdBarrier xcd_barrier_post(unsigned* bar, volatile LAS unsigned* st) {
    XcdBarrier b; b.bar = bar; b.x = xb_xcc_id(); b.st = st;
    if (threadIdx.x == 0) (void)xb_add(&bar[XB_XCNT(b.x)], 1u);
    return b;
}
__device__ __forceinline__ void xcd_barrier_complete(unsigned* bar, unsigned x, unsigned& nloc, unsigned& nx) {
    const unsigned G = gridDim.x * gridDim.y * gridDim.z;
    unsigned sum, cnt, mine, sp = 0u;
    for (;;) {
        sum = 0u; cnt = 0u; mine = 0u;
#pragma unroll
        for (unsigned j = 0; j < 16; ++j) { const unsigned c = xb_ld(&bar[XB_XCNT(j)]); sum += c; cnt += (c > 0u) ? 1u : 0u; mine = (j == x) ? c : mine; }
        if (sum == G) break;
        __builtin_amdgcn_s_sleep(1);
        if ((++sp & 255u) == 0u) { if (xb_ld(&bar[XB_TMO])) break; if (sp > XB_SPIN_CAP) { atomicAdd(&bar[XB_TMO], 1u); break; } }
    }
    nloc = mine > 0u ? mine : 1u; nx = cnt > 0u ? cnt : 1u;
}

__device__ __forceinline__ void xcd_barrier(const XcdBarrier& b) {
    asm volatile("s_waitcnt vmcnt(0)" ::: "memory");
    __syncthreads();
    if (threadIdx.x == 0) {
        unsigned* bar = b.bar;
        __builtin_amdgcn_s_waitcnt(0);
        unsigned nloc = b.st[0], nx = b.st[1];
        if (nloc == 0u) { xcd_barrier_complete(bar, b.x, nloc, nx); b.st[0] = nloc; b.st[1] = nx; }
        const unsigned old = xb_add(&bar[XB_XSUB(b.x)], 1u);
        const unsigned gen = old / nloc;
        if (old + 1u == (gen + 1u) * nloc) {
            __builtin_amdgcn_fence(__ATOMIC_RELEASE, "agent");
            asm volatile("s_waitcnt vmcnt(0)" ::: "memory");
            const unsigned og = xb_add(&bar[XB_TOP], 1u);
            const unsigned tg = og / nx;
            if (og + 1u == (tg + 1u) * nx) xb_add(&bar[XB_TOPGEN], 1u);
            else XB_SPIN(xb_ld(&bar[XB_TOPGEN]) == tg, bar);
            __builtin_amdgcn_fence(__ATOMIC_ACQUIRE, "agent");
            xb_add(&bar[XB_XGEN(b.x)], 1u);
            asm volatile("s_waitcnt vmcnt(0)" ::: "memory");
        } else {
            XB_SPIN(xb_ld(&bar[XB_XGEN(b.x)]) == gen, bar);
            __builtin_amdgcn_fence(__ATOMIC_ACQUIRE, "agent");
            asm volatile("s_waitcnt vmcnt(0)" ::: "memory");
        }
    }
    __syncthreads();
}

__device__ __forceinline__ void moba_select(int bh16, int own, const u16* AQ, const float* KMP, LAS unsigned* SELT, LAS float* KML, int tid) {
    if (own <= 3) { if (tid < 256) SELT[tid] = (1u << own) - 1u; return; }
    *(LAS f32x4*)(KML + 4 * tid) = ldg4(KMP + (size_t)bh16 * 16 * AD + 4 * tid);
    const int row = tid >> 1, half = tid & 1;
    const u16* qp = AQ + ((size_t)bh16 * TP + own * 256 + row) * AD + 64 * half;
    u32x4 qv[8];
#pragma unroll
    for (int i = 0; i < 8; ++i) qv[i] = ldgu4(qp + 8 * i);
    WG_BAR();
    float b0 = -__builtin_inff(), b1 = b0, b2 = b0; int i0 = 0, i1 = 0, i2 = 0;
    for (int n = 0; n < own; ++n) {
        const LAS float* kp = KML + n * AD + 64 * half; float s = 0.f;
#pragma unroll
        for (int i = 0; i < 8; ++i) { const f32x4 k0 = *(const LAS f32x4*)(kp + 8 * i), k1 = *(const LAS f32x4*)(kp + 8 * i + 4);
            s += bflo(qv[i].x) * k0[0] + bfhi(qv[i].x) * k0[1] + bflo(qv[i].y) * k0[2] + bfhi(qv[i].y) * k0[3] + bflo(qv[i].z) * k1[0] + bfhi(qv[i].z) * k1[1] + bflo(qv[i].w) * k1[2] + bfhi(qv[i].w) * k1[3]; }
        s += __shfl_xor(s, 1);
        if (s > b0) { b2 = b1; i2 = i1; b1 = b0; i1 = i0; b0 = s; i0 = n; } else if (s > b1) { b2 = b1; i2 = i1; b1 = s; i1 = n; } else if (s > b2) { b2 = s; i2 = n; }
    }
    if (half == 0) SELT[row] = (1u << i0) | (1u << i1) | (1u << i2);
}

__device__ __forceinline__ void skinny_epi_in(int pn, int j, const LAS float* RES, float* QKVO, float* QS, float* kout, const float* rcos, const float* rsin, int tid) {
    if (tid >= 256) return;
    const int row = tid >> 2, q = tid & 3; const f32x4 a = *(const LAS f32x4*)(RES + row * 32 + 4 * q), bq = *(const LAS f32x4*)(RES + row * 32 + 16 + 4 * q);
    if (pn < 16) { float* p = QKVO + (size_t)row * 4096 + pn * 256 + 16 * j + 4 * q; stg4(p, a); stg4(p + 128, bq); return; }
    const int aa = pn - 16, sec = aa >> 2, pt = aa & 3, tc = 16 * j + 4 * q, head = 2 * pt + (tc >> 6), dl = tc & 63, t = row & 7;
    f32x4 x1 = a, x2 = bq;
    if (sec < 2) { const f32x4 c = ldg4(rcos + (size_t)(TP + t) * 64 + dl), s = ldg4(rsin + (size_t)(TP + t) * 64 + dl); x1 = a * c - bq * s; x2 = bq * c + a * s; }
    float* dst = QS + (size_t)sec * 65536 + ((size_t)row * AH + head) * AD + dl;
    if (sec >= 1) { float* fo = kout + (size_t)(sec - 1) * ((size_t)MS * AW) + (size_t)row * AW + head * AD + dl; stg4(fo, x1); stg4(fo + 64, x2); }
}
template <bool WITH_G>
__device__ __forceinline__ void skinny_epi_res(int su, int ca, const LAS float* RES, const float* res, float* out, u16* outg, const float* g, float* SSS, int tid) {
    if (tid >= 256) return;
    const int row = tid >> 2, q = tid & 3; float ss = 0.f;
#pragma unroll
    for (int h = 0; h < 2; ++h) { const int col = ca + 128 * h + 4 * q; const f32x4 v = *(const LAS f32x4*)(RES + row * 32 + 16 * h + 4 * q) + ldg4(res + (size_t)row * DM + col);
        stg4(out + (size_t)row * DM + col, v); ss += dot4(v, v);
        if (WITH_G) { const f32x4 gv = ldg4(g + col); u32x2 w; w.x = cvtpk(v[0] * gv[0], v[1] * gv[1]); w.y = cvtpk(v[2] * gv[2], v[3] * gv[3]); stgu2(outg + (size_t)row * DM + col, w); } }
    ss += __shfl_xor(ss, 1); ss += __shfl_xor(ss, 2);
    if (q == 0) stgf(SSS + row * 64 + su, ss);
}
__device__ __forceinline__ void skinny_epi_up(int pn, int j, LAS float* RES, const LAS float* RSTDL, const float* stconv, const float* conv_w, const float* conv_b, u16* ACTs, float* conv_out, int tid) {
    { const int row = tid >> 3; f32x4 v = *(LAS f32x4*)(RES + 4 * tid); v = v * RSTDL[row]; *(LAS f32x4*)(RES + 4 * tid) = v; }
    WG_BAR();
    if (tid < 256) {
        const int row = tid >> 2, q = tid & 3, b = row >> 3, t = row & 7;
        float cv[2][4];
#pragma unroll
        for (int h = 0; h < 2; ++h)
#pragma unroll
            for (int e = 0; e < 4; ++e) {
                const int tcol = 16 * h + 4 * q + e, oc = h * DFF + pn * 128 + 16 * j + 4 * q + e;
                const float u0 = RES[row * 32 + tcol];
                const float um1 = (t >= 1) ? RES[(row - 1) * 32 + tcol] : ldgf(stconv + ((size_t)b * 2 + 1) * NUP + oc);
                const float um2 = (t >= 2) ? RES[(row - 2) * 32 + tcol] : ldgf(stconv + ((size_t)b * 2 + t) * NUP + oc);
                cv[h][e] = ldgf(conv_b + oc) + ldgf(conv_w + oc) * um2 + ldgf(conv_w + NUP + oc) * um1 + ldgf(conv_w + 2 * NUP + oc) * u0;
                if (t >= 6) stgf(conv_out + ((size_t)b * 2 + (t - 6)) * NUP + oc, u0);
            }
        u32x2 w; float a[4];
#pragma unroll
        for (int e = 0; e < 4; ++e) a[e] = cv[0][e] / (1.0f + __expf(-cv[0][e])) * cv[1][e];
        w.x = cvtpk(a[0], a[1]); w.y = cvtpk(a[2], a[3]);
        stgu2(ACTs + (size_t)row * DFF + pn * 128 + 16 * j + 4 * q, w);
    }
}

#ifdef DBG_SCALE_MASK
#define DBG_YS(m) ((((m) < MP) ? ((DBG_SCALE_MASK >> 0) & 1) : ((DBG_SCALE_MASK >> 1) & 1)) ? 2.0f : 1.0f)
#else
#define DBG_YS(m) 1.0f
#endif
#ifndef PH_MASK
#define PH_MASK 0x1ff
#endif
struct Args { const void* in[20]; float* out; unsigned char* ws; int ph_lo, ph_hi, li, pad; };

__global__ void __launch_bounds__(NTHREADS, 2) hymba_fwd(Args args) {
    extern __shared__ __attribute__((aligned(16))) unsigned char lds_raw[];
    LAS unsigned char* lds = (LAS unsigned char*)lds_raw;
    volatile LAS unsigned* MISC = (volatile LAS unsigned*)(lds + MISC_OFF);
    const int tid = threadIdx.x, lane = tid & 63, wave = __builtin_amdgcn_readfirstlane(tid >> 6);
    const int G = gridDim.x; const int bx = blockIdx.x; const int vcu = (G % 8 == 0) ? (bx % 8) * (G / 8) + bx / 8 : bx;
    unsigned char* ws = args.ws; float* out = args.out;
    gu32* ctl = (gu32*)(ws + WS_CTL);
    const float* x_p = (const float*)args.in[0]; const float* x_s = (const float*)args.in[1]; const float* cache_k = (const float*)args.in[2]; const float* cache_v = (const float*)args.in[3];
    const int* page_table = (const int*)args.in[4]; const float* st_C = (const float*)args.in[5]; const float* st_n = (const float*)args.in[6]; const float* st_m = (const float*)args.in[7];
    const float* st_conv = (const float*)args.in[8]; const float* g1 = (const float*)args.in[9]; const float* w_in = (const float*)args.in[10]; const float* b_gates = (const float*)args.in[11];
    const float* gmn = (const float*)args.in[12]; const float* w_out = (const float*)args.in[13]; const float* g2 = (const float*)args.in[14]; const float* w_up = (const float*)args.in[15];
    const float* conv_w = (const float*)args.in[16]; const float* conv_b = (const float*)args.in[17]; const float* w_down = (const float*)args.in[18]; const float* gf = (const float*)args.in[19];
    u16* WIN = (u16*)(ws + WS_WIN); u16* WOUT = (u16*)(ws + WS_WOUT); u16* WUP = (u16*)(ws + WS_WUP); u16* WDN = (u16*)(ws + WS_WDN);
    float* RCOS = (float*)(ws + WS_ROPE); float* RSIN = (float*)(ws + WS_ROPE + 2 * MiB); float* GATES = (float*)(ws + WS_GATES); u16* XN = (u16*)(ws + WS_XN);
    u16* MQ = (u16*)(ws + WS_MQ); u16* MK = (u16*)(ws + WS_MK); u16* MV = (u16*)(ws + WS_MV); u16* MO = (u16*)(ws + WS_MO);
    u16* AQ = (u16*)(ws + WS_AQ); u16* AK = (u16*)(ws + WS_AK); u16* AV = (u16*)(ws + WS_AV);
    u16* UU = (u16*)(ws + WS_U); u16* CST = (u16*)(ws + WS_CST); unsigned char* sm = ws + WS_SMALL;
    float* CHS = (float*)(sm + SM_CHS); float* MST = (float*)(sm + SM_MST); float* KMP = (float*)(sm + SM_KMP); float* UN = (float*)(sm + SM_UN); float* NST = (float*)(sm + SM_NST);
    float* QKVO = (float*)(sm + SM_QKVO); float* KMS = (float*)(sm + SM_KMS); float* QS = (float*)(sm + SM_QS); float* KSN = (float*)(sm + SM_KSN); float* VSN = (float*)(sm + SM_VSN);
    int* SEL = (int*)(sm + SM_SEL); float* SSS1 = (float*)(sm + SM_SSS1); float* SSS2 = (float*)(sm + SM_SSS2);
    u16* MIXED = (u16*)(ws + WS_MIXED); float* X1 = (float*)(ws + WS_X1); u16* X1G = (u16*)(ws + WS_X1G); float* SS1 = (float*)(ws + WS_SS); float* SS2 = (float*)(ws + WS_SS + 2 * MiB);
    u16* ACT = (u16*)(ws + WS_ACT); float* UB = (float*)(ws + WS_UB); float* PART = (float*)(ws + WS_PART);

    for (int u = tid; u < 64; u += NTHREADS) ((LAS unsigned*)(lds + MISC_OFF))[u] = 0u;
    __syncthreads();
    XcdBarrier bar; bar.bar = (unsigned*)(ctl + CW_BAR); bar.x = 0; bar.st = nullptr;
    if (MK_N_LAUNCHES != N_PHASES) bar = xcd_barrier_post((unsigned*)(ctl + CW_BAR) + args.li * XCD_BAR_WORDS, MISC + 8);
    const int lo = args.ph_lo, hi = args.ph_hi;
#define IN(k) (((PH_MASK >> (k)) & 1) && lo <= (k) && (k) < hi)
#define SEAM(k) do { if (IN(k) && IN((k) + 1)) xcd_barrier(bar); } while (0)
    const int gw = vcu * NWAVES + wave, NGW = G * NWAVES;

    if (IN(0)) {
#if PH_MASK != 0x1ff
        for (size_t i = (size_t)bx * NTHREADS + tid; i < O_END / 4; i += (size_t)G * NTHREADS) stg4(out + 4 * i, (f32x4){0.f, 0.f, 0.f, 0.f});
#endif
        LAS float* scr = (LAS float*)(lds + wave * 16384);
        constexpr int I_IN = 32 * 224, I_OUT = 32 * 64, I_UP = 32 * 352, I_DN = 88 * 64, NITEMS = I_IN + I_OUT + I_UP + I_DN;
        for (int it = gw; it < NITEMS; it += NGW) {
            int r = it;
            if (r < I_IN) { const int kb = r / 224, n0 = (r % 224) * 32; transpose_item(w_in, DM, NIN, WIN, kb * 64, n0, win_src_col(n0), scr, lane); continue; } r -= I_IN;
            if (r < I_OUT) { const int kb = r / 64, n0 = (r % 64) * 32; transpose_item(w_out, DM, DM, WOUT, kb * 64, n0, n0, scr, lane); continue; } r -= I_OUT;
            if (r < I_UP) { const int kb = r / 352, n0 = (r % 352) * 32; transpose_item(w_up, DM, NUP, WUP, kb * 64, n0, wup_src_col(n0), scr, lane); continue; } r -= I_UP;
            { const int kb = r / 64, n0 = (r % 64) * 32; transpose_item(w_down, DFF, DM, WDN, kb * 64, n0, n0, scr, lane); }
        }
        for (int idx = vcu * NTHREADS + tid; idx < (TP + TS) * 64; idx += G * NTHREADS) {
            const int p = idx >> 6, i = idx & 63; const int pos = p < TP ? p : PAST + (p - TP);
            const double inv = exp(-(double)i * (9.210340371976184 / 64.0));
            float s, c; sincos_d((double)pos * inv, s, c); stgf(RCOS + idx, c); stgf(RSIN + idx, s);
        }
        __syncthreads();
        LAS float* GW = (LAS float*)lds; LAS float* G1L = (LAS float*)(lds + 65536);
        for (int i = tid; i < 8 * DM; i += NTHREADS) { const int k = i >> 3, j = i & 7; GW[j * DM + k] = ldgf(g1 + k) * ldgf(w_in + (size_t)k * NIN + 4096 + j); }
        for (int i = tid; i < DM; i += NTHREADS) G1L[i] = ldgf(g1 + i);
        __syncthreads();
        for (int m = gw; m < MT; m += NGW) norm1_row(m < MP ? x_p + (size_t)m * DM : x_s + (size_t)(m - MP) * DM, XN + (size_t)m * DM, GATES + (size_t)m * 8, GW, G1L, b_gates, lane);
        __syncthreads();
    }
    SEAM(0);
    if (IN(1)) {
        pg8::Gemm g{XN, WIN, MP, NING, DM}; pg8::StaticOrder S; S.init(MP, NING, G, bx);
        EpiIn E{MQ, AQ, out + O_KP, RCOS, RSIN};
        pg8::gemm_phase<EpiIn, pg8::StaticOrder, true, true>(lds, g, S, E);
        for (int su = vcu; su < 224; su += G) { const int pn = su >> 3, j = su & 7;
            skinny_unit(XN + (size_t)MP * DM, WIN, DM, pn * 256 + 16 * j, pn * 256 + 16 * j + 128, lds, tid, wave, lane);
            skinny_epi_in(pn, j, (const LAS float*)(lds + 65536), QKVO, QS, out + O_KS, RCOS, RSIN, tid);
            WG_BAR(); }
    }
    SEAM(1);
    if (IN(2)) {
        for (int it = vcu; it < 1024; it += G) {
            int tid_o = tid; asm volatile("" : "+v"(tid_o)); const int lane_o = tid_o & 63, wave_o = __builtin_amdgcn_readfirstlane(tid_o >> 6);
            if (it < 256) mlstm_A_unit(it, MK, MV, GATES, UU, UN, CHS, lds, tid_o, wave_o, lane_o);
            else if (it < 512) kmean_prompt_unit(it - 256, AK, KMP, lds, tid_o);
            else kmean_sample_unit(it - 512, cache_k, page_table, KMS, lds, tid_o);
        }
    }
    SEAM(2);
    if (IN(3)) {
        mlstm_B(vcu * NTHREADS + tid, G * NTHREADS, UU, UN, CHS, CST, NST, MST, out + O_CP, out + O_NP, out + O_MP);
        for (int su = vcu; su < 64; su += G) sample_select_unit(su, QS, KMS, SEL, lds, tid);
    }
    SEAM(3);
    if (IN(4)) {
#ifndef P4_MASK
#define P4_MASK 0xf
#endif
        const int natt = G >> 1;
        if ((P4_MASK & 1) && vcu < natt) {
            for (int item = vcu; item < 128; item += natt) {
                const int bh16 = item >> 3, x = item & 7;
                int tid_o = tid; asm volatile("" : "+v"(tid_o));
                const u16* Qb = AQ + (size_t)bh16 * TP * AD; const u16* Kb = AK + (size_t)bh16 * TP * AD; const u16* Vb = AV + (size_t)bh16 * TP * AD;
                const int b = bh16 >> 3, h = bh16 & 7;
                u16* Ob = MIXED + (size_t)b * TP * DM + MW + h * AD;
                const moba::HeadRef H{Qb, Kb, Vb};
                moba::BlockRef c0{Ob + (size_t)(15 - x) * 256 * DM, 15 - x, 0, 4 * (16 - x), nullptr, nullptr};
                moba::BlockRef c1{Ob + (size_t)x * 256 * DM, x, 0, 4 * (x + 1), nullptr, nullptr};
                moba::Seam S;
                moba_select(bh16, c0.own, AQ, KMP, (LAS unsigned*)(lds + SELT_OFF), (LAS float*)(lds + KML_OFF), tid_o);
                moba::moba_prime(H, c0, (char*)lds_raw, S);
                moba::moba_block<0>(H, c0, c1, (char*)lds_raw, S, (const unsigned*)(lds_raw + SELT_OFF), nullptr);
                asm volatile("" : "+v"(tid_o));
                moba_select(bh16, c1.own, AQ, KMP, (LAS unsigned*)(lds + SELT_OFF), (LAS float*)(lds + KML_OFF), tid_o);
                __syncthreads();
                moba::moba_block<0>(H, c1, c1, (char*)lds_raw, S, (const unsigned*)(lds_raw + SELT_OFF), nullptr);
            }
        } else {
            const int nr = G - natt;
            for (int it = vcu - natt; it < 256 + 512 + 32; it += nr) {
                int tid_o = tid; asm volatile("" : "+v"(tid_o)); const int lane_o = tid_o & 63, wave_o = __builtin_amdgcn_readfirstlane(tid_o >> 6);
                if ((P4_MASK & 2) && it < 256) mlstm_C_unit(it, MQ, MK, MV, MO, GATES, CST, NST, MST, gmn, MIXED, lds, tid_o, wave_o, lane_o);
                else if ((P4_MASK & 4) && it >= 256 && it < 768) sample_attend_unit(it - 256, QS, KSN, VSN, cache_k, cache_v, page_table, SEL, MIXED, lds, tid_o, wave_o, lane_o);
                else if ((P4_MASK & 8) && it >= 768) sample_mlstm_unit(it - 768, QKVO, GATES, st_C, st_n, st_m, gmn, out + O_CS, out + O_NS, out + O_MS, MIXED, lds, tid_o, wave_o, lane_o);
            }
        }
    }
    SEAM(4);
    if (IN(5)) {
        pg8::Gemm g{MIXED, WOUT, MP, DM, DM}; pg8::StaticOrder S; S.init(MP, DM, G, bx);
        EpiRes<true> E{x_p, X1, X1G, g2, SS1};
        pg8::gemm_phase<EpiRes<true>, pg8::StaticOrder, true, true>(lds, g, S, E);
        for (int su = vcu; su < 64; su += G) { const int pn = su >> 3, j = su & 7, ca = pn * 256 + 16 * j;
            skinny_unit(MIXED + (size_t)MP * DM, WOUT, DM, ca, ca + 128, lds, tid, wave, lane);
            skinny_epi_res<true>(su, ca, (const LAS float*)(lds + 65536), x_s, X1 + (size_t)MP * DM, X1G + (size_t)MP * DM, g2, SSS1, tid);
            WG_BAR(); }
    }
    SEAM(5);
    if (IN(6)) {
        pg8::Gemm g{X1G, WUP, MP, NUP, DM}; pg8::StaticOrder S; S.init(MP, NUP, G, bx);
        EpiUp E{lds + XCH_OFF, SS1, conv_w, conv_b, ACT, UB, ctl + CW_UPCNT, out + O_CVP, (void*)(ws + 600 * MiB)};
        pg8::gemm_phase<EpiUp, pg8::StaticOrder, true, true>(lds, g, S, E);
        LAS float* RSTDL = (LAS float*)(lds + 65536 + 8192);
        { const int row = tid >> 3, part = tid & 7; const f32x4 a = ldg4(SSS1 + row * 64 + 8 * part), b4 = ldg4(SSS1 + row * 64 + 8 * part + 4);
          float s = ((a[0] + a[1]) + (a[2] + a[3])) + ((b4[0] + b4[1]) + (b4[2] + b4[3])); s += __shfl_xor(s, 1); s += __shfl_xor(s, 2); s += __shfl_xor(s, 4);
          if (part == 0) RSTDL[row] = 1.0f / sqrtf(s * (1.0f / DM) + EPS); }
        WG_BAR();
        for (int su = vcu; su < 352; su += G) { const int pn = su >> 3, j = su & 7, ca = pn * 256 + 16 * j;
            skinny_unit(X1G + (size_t)MP * DM, WUP, DM, ca, ca + 128, lds, tid, wave, lane);
            skinny_epi_up(pn, j, (LAS float*)(lds + 65536), RSTDL, st_conv, conv_w, conv_b, ACT + (size_t)MP * DFF, out + O_CVS, tid);
            WG_BAR(); }
    }
    SEAM(6);
#ifdef DBG_UFULL
    if (lo == 100) {
        const float* UF = (const float*)(ws + 600 * MiB);
        for (size_t idx = (size_t)bx * NTHREADS + tid; idx < (size_t)MP * DFF; idx += (size_t)G * NTHREADS) {
            const int row = (int)(idx / DFF), j = (int)(idx % DFF), t = row & (TP - 1), pn = j >> 7, tc = j & 127;
            float cv[2];
            for (int h2 = 0; h2 < 2; ++h2) { const int oc = h2 * DFF + j; const size_t ui = (size_t)pn * 256 + h2 * 128 + tc;
                const float u0 = ldgf(UF + (size_t)row * NUP + ui), um1 = t >= 1 ? ldgf(UF + (size_t)(row - 1) * NUP + ui) : 0.f, um2 = t >= 2 ? ldgf(UF + (size_t)(row - 2) * NUP + ui) : 0.f;
                cv[h2] = ldgf(conv_b + oc) + ldgf(conv_w + oc) * um2 + ldgf(conv_w + NUP + oc) * um1 + ldgf(conv_w + 2 * NUP + oc) * u0; }
            const float a = cv[0] / (1.0f + __expf(-cv[0])) * cv[1];
#ifdef DBG_CMP
            { const float mine = bf2f(*(const GAS u16*)(ACT + (size_t)row * DFF + j)); const int cls = DBG_CLS(row, j);
              if (fabsf(mine - a) > 0.02f + 0.02f * fabsf(a) && cls < 14) { gu32* cw_ = ctl + 20000 + cls; if (__hip_atomic_load(cw_, RLX_AGENT) < 4000000u) __hip_atomic_fetch_add(cw_, 1u, RLX_AGENT); } }
#else
            *(GAS u16*)(ACT + (size_t)row * DFF + j) = (u16)f2bf(a);
#endif
        }
    }
#ifdef DBG_CMP
    if (lo == 101 && bx == 0 && tid < 14) {
        const size_t offs[15] = {O_YP, O_YS, O_KP, O_VP, O_KS, O_VS, O_CP, O_NP, O_MP, O_CS, O_NS, O_MS, O_CVP, O_CVS, O_END};
        size_t o0 = 0, o1 = 0;
        for (int k = 0; k < 14; ++k) if (k == tid) { o0 = offs[k]; o1 = offs[k + 1]; }
        const unsigned cnt = __hip_atomic_load(ctl + 20000 + tid, RLX_AGENT);
        for (size_t i = 0; i < cnt && o0 + i < o1; ++i) *(GAS unsigned*)(out + o0 + i) = 0xAAAAAAAAu;
    }
#endif
#endif
    if (IN(7)) {
        pg8::Gemm g{ACT, WDN, MP, DM, DFF}; pg8::StaticOrder S; S.init(MP, DM, G, bx);
        EpiRes<false> E{X1, out + O_YP, nullptr, nullptr, SS2};
        pg8::gemm_phase<EpiRes<false>, pg8::StaticOrder, true, true>(lds, g, S, E);
        for (int su = vcu; su < 64; su += G) { const int pn = su >> 3, j = su & 7, ca = pn * 256 + 16 * j;
            skinny_unit(ACT + (size_t)MP * DFF, WDN, DFF, ca, ca + 128, lds, tid, wave, lane);
            skinny_epi_res<false>(su, ca, (const LAS float*)(lds + 65536), X1 + (size_t)MP * DM, out + O_YS, nullptr, nullptr, SSS2, tid);
            WG_BAR(); }
    }
    SEAM(7);
    if (IN(8)) {
        for (int m = gw; m < MT; m += NGW) {
            float s; float* p;
            if (m < MP) { s = lane < 32 ? ldgf(SS2 + (size_t)m * 32 + lane) : 0.f; p = out + O_YP + (size_t)m * DM; }
            else { s = ldgf(SSS2 + (m - MP) * 64 + lane); p = out + O_YS + (size_t)(m - MP) * DM; }
            const float rstd = 1.0f / sqrtf(wave_sum(s) * (1.0f / DM) + EPS);
#pragma unroll
            for (int i = 0; i < 8; ++i) { const f32x4 v = ldg4(p + 256 * i + 4 * lane), g = ldg4(gf + 256 * i + 4 * lane); stg4(p + 256 * i + 4 * lane, v * rstd * g * DBG_YS(m)); }
        }
#ifdef DBG_SCALE_MASK
        { const size_t offs[15] = {O_YP, O_YS, O_KP, O_VP, O_KS, O_VS, O_CP, O_NP, O_MP, O_CS, O_NS, O_MS, O_CVP, O_CVS, O_END};
#pragma unroll
          for (int j = 2; j < 14; ++j) if ((DBG_SCALE_MASK >> j) & 1)
              for (size_t i = offs[j] + (size_t)bx * NTHREADS + tid; i < offs[j + 1]; i += (size_t)G * NTHREADS) stgf(out + i, 2.0f * ldgf(out + i)); }
#endif
    }
#undef IN
#undef SEAM
}

extern "C" void kernel_launch(void* const* d_in, const int* in_sizes, int n_in, void* d_out, int out_size, void* d_ws, size_t ws_size, hipStream_t stream) {
    static int grid = 0;
    if (grid == 0) {
        if (n_in != 20 || (size_t)out_size != O_END || ws_size < WS_END) { fprintf(stderr, "kernel_launch: unexpected shapes (n_in %d, out %d, ws %zu)\n", n_in, out_size, ws_size); grid = -1; return; }
        int dev = 0, cus = 0, per_cu = 0;
        if (hipGetDevice(&dev) != hipSuccess || hipDeviceGetAttribute(&cus, hipDeviceAttributeMultiprocessorCount, dev) != hipSuccess) { grid = -1; return; }
        if (hipFuncSetAttribute((const void*)hymba_fwd, hipFuncAttributeMaxDynamicSharedMemorySize, LDS_BYTES) != hipSuccess) { fprintf(stderr, "kernel_launch: hipFuncSetAttribute failed\n"); grid = -1; return; }
        if (hipOccupancyMaxActiveBlocksPerMultiprocessor(&per_cu, (const void*)hymba_fwd, NTHREADS, LDS_BYTES) != hipSuccess || per_cu < 1) { fprintf(stderr, "kernel_launch: occupancy query says %d\n", per_cu); }
        (void)hipGetLastError();
        grid = cus;
    }
    if (grid < 0) return;
    (void)hipMemsetAsync((char*)d_ws + WS_CTL, 0, CTL_ZERO_BYTES, stream);
    Args a{};
    for (int i = 0; i < 20; ++i) a.in[i] = d_in[i];
    a.out = (float*)d_out; a.ws = (unsigned char*)d_ws;
    for (int li = 0; li < MK_N_LAUNCHES; ++li) {
        if (MK_N_LAUNCHES == 1) { a.ph_lo = 0; a.ph_hi = N_PHASES; } else { a.ph_lo = li; a.ph_hi = li + 1; }
        a.li = (MK_N_LAUNCHES == N_PHASES) ? 0 : li; a.pad = 0;
#ifdef DBG_UFULL
        if (li == 7) { Args a2 = a; a2.ph_lo = 100; a2.ph_hi = 101; hipLaunchKernelGGL(hymba_fwd, dim3(grid), dim3(NTHREADS), LDS_BYTES, stream, a2); }
#endif
        hipLaunchKernelGGL(hymba_fwd, dim3(grid), dim3(NTHREADS), LDS_BYTES, stream, a);
    }
#ifdef DBG_CMP
    { Args a3 = a; a3.ph_lo = 101; a3.ph_hi = 102; hipLaunchKernelGGL(hymba_fwd, dim3(grid), dim3(NTHREADS), LDS_BYTES, stream, a3); }
#endif
}
```

```cpp
#include <hip/hip_runtime.h>
#include <cstdio>
#include <cstdint>

#define GAS __attribute__((address_space(1)))
#define LAS __attribute__((address_space(3)))
typedef unsigned short u16;
typedef short bf16x8 __attribute__((ext_vector_type(8)));
typedef short s16x4 __attribute__((ext_vector_type(4)));
typedef float f32x4 __attribute__((ext_vector_type(4)));
typedef float f32x2 __attribute__((ext_vector_type(2)));
typedef float f32x16 __attribute__((ext_vector_type(16)));
typedef unsigned u32x4 __attribute__((ext_vector_type(4)));
typedef unsigned u32x2 __attribute__((ext_vector_type(2)));
typedef GAS unsigned gu32;

constexpr int DM = 2048, BP = 2, TP = 4096, MP = BP * TP, BS = 8, TS = 8, MS = BS * TS, MT = MP + MS;
constexpr int MW = 1024, AW = 1024, MH = 4, MD = 256, AH = 8, AD = 128, CH = 128, NCH = TP / CH;
constexpr int DFF = 5632, NUP = 2 * DFF, NIN = 7176, NING = 7168;
constexpr int PAST = 16384, PAGE = 128, NPAGES = PAST / PAGE, NBS = PAST / 256;
constexpr float EPS = 1e-6f;
constexpr float ATT_SCALE = 0.08838834764831845f;

constexpr size_t O_YP = 0, O_YS = O_YP + (size_t)MP * DM, O_KP = O_YS + (size_t)MS * DM, O_VP = O_KP + (size_t)MP * AW, O_KS = O_VP + (size_t)MP * AW,
                 O_VS = O_KS + (size_t)MS * AW, O_CP = O_VS + (size_t)MS * AW, O_NP = O_CP + (size_t)BP * MH * MD * MD, O_MP = O_NP + (size_t)BP * MH * MD,
                 O_CS = O_MP + (size_t)BP * MH, O_NS = O_CS + (size_t)BS * MH * MD * MD, O_MS = O_NS + (size_t)BS * MH * MD, O_CVP = O_MS + (size_t)BS * MH,
                 O_CVS = O_CVP + (size_t)BP * 2 * NUP, O_END = O_CVS + (size_t)BS * 2 * NUP;

__device__ __forceinline__ unsigned f2bf(float f) { unsigned u = __builtin_bit_cast(unsigned, f); return (u + 0x7fffu + ((u >> 16) & 1u)) >> 16; }
__device__ __forceinline__ float bf2f(unsigned h) { return __builtin_bit_cast(float, h << 16); }
__device__ __forceinline__ float bflo(unsigned w) { return __builtin_bit_cast(float, w << 16); }
__device__ __forceinline__ float bfhi(unsigned w) { return __builtin_bit_cast(float, w & 0xffff0000u); }
typedef __bf16 bf16x2_t __attribute__((ext_vector_type(2)));
__device__ __forceinline__ unsigned cvtpk(float lo, float hi) { f32x2 v = {lo, hi}; bf16x2_t b = __builtin_convertvector(v, bf16x2_t); return __builtin_bit_cast(unsigned, b); }
__device__ __forceinline__ unsigned cvtpk_asm(float lo, float hi) { unsigned r; asm volatile("v_cvt_pk_bf16_f32 %0, %1, %2" : "=v"(r) : "v"(lo), "v"(hi)); return r; }
__device__ __forceinline__ u32x4 pack8f(f32x4 a, f32x4 b) { u32x4 w; w.x = cvtpk(a[0], a[1]); w.y = cvtpk(a[2], a[3]); w.z = cvtpk(b[0], b[1]); w.w = cvtpk(b[2], b[3]); return w; }
__device__ __forceinline__ f32x4 ldg4(const float* p) { return *(const GAS f32x4*)p; }
__device__ __forceinline__ void stg4(float* p, f32x4 v) { *(GAS f32x4*)p = v; }
__device__ __forceinline__ u32x4 ldgu4(const void* p) { return *(const GAS u32x4*)p; }
__device__ __forceinline__ void stgu4(void* p, u32x4 v) { *(GAS u32x4*)p = v; }
__device__ __forceinline__ u32x2 ldgu2(const void* p) { return *(const GAS u32x2*)p; }
__device__ __forceinline__ void stgu2(void* p, u32x2 v) { *(GAS u32x2*)p = v; }
__device__ __forceinline__ float ldgf(const float* p) { return *(const GAS float*)p; }
__device__ __forceinline__ void stgf(float* p, float v) { *(GAS float*)p = v; }
__device__ __forceinline__ void stg4_sc1(float* p, f32x4 v) { asm volatile("global_store_dwordx4 %0, %1, off sc1" :: "v"((GAS float*)p), "v"(v) : "memory"); }
__device__ __forceinline__ float wave_sum(float v) {
#pragma unroll
    for (int o = 1; o < 64; o <<= 1) v += __shfl_xor(v, o);
    return v;
}
__device__ __forceinline__ float wave_max(float v) {
#pragma unroll
    for (int o = 1; o < 64; o <<= 1) v = fmaxf(v, __shfl_xor(v, o));
    return v;
}
__device__ __forceinline__ float dot4(f32x4 a, f32x4 b) { return (a[0] * b[0] + a[1] * b[1]) + (a[2] * b[2] + a[3] * b[3]); }
__device__ __forceinline__ float sigmoidf_(float x) { return 1.0f / (1.0f + __expf(-x)); }
__device__ __forceinline__ int tid_of(int wave) { unsigned ones = ~0u; asm volatile("" : "+s"(ones));
    return wave * 64 + (int)__builtin_amdgcn_mbcnt_hi(ones, __builtin_amdgcn_mbcnt_lo(ones, 0u)); }
#define LDS_WAIT() asm volatile("s_waitcnt lgkmcnt(0)" ::: "memory")
#define VM_WAIT() asm volatile("s_waitcnt vmcnt(0)" ::: "memory")
#define WG_BAR() do { asm volatile("s_waitcnt lgkmcnt(0)" ::: "memory"); __builtin_amdgcn_s_barrier(); asm volatile("" ::: "memory"); } while (0)
namespace pg8 {
#define PG8_LAS __attribute__((address_space(3)))
typedef unsigned short bf16_t;
typedef short bf16x8 __attribute__((ext_vector_type(8)));
typedef float f32x4 __attribute__((ext_vector_type(4)));
typedef unsigned u32x4 __attribute__((ext_vector_type(4)));
constexpr int BM = 256, BK = 64, HALF = 128, HTB = HALF * BK * 2  , STAGE_BYTES = 8 * HTB, NXCD = 8, WGM = 8;

__host__ __device__ __forceinline__ int lds_byte(int r, int c) { const int st = (r >> 4) * 2 + (c >> 5), rr = r & 15, cc = c & 31, ob = rr * 64 + cc * 2; return st * 1024 + (ob ^ (((ob >> 9) & 1) << 5)); }
__host__ __device__ __forceinline__ void stage_rc(int b, int& R, int& C) { const int st = b / 1024, sb = b % 1024, swz = sb ^ (((sb >> 9) & 1) << 5); R = (st >> 1) * 16 + swz / 64; C = (st & 1) * 32 + (swz % 64) / 2; }
__host__ __device__ __forceinline__ int perm32(int rho) { const int n = rho >> 4, i = rho & 15; return 8 * (i >> 2) + 4 * n + (i & 3); }

struct Unit { int pm, pn; };
struct Gemm { const bf16_t* A; const bf16_t* Bt; int M, N, K; };

struct StaticOrder {
    int nM, nN, nwg, G, c;
    __host__ __device__ void init(int M, int N, int G_, int c_) { nM = M / BM; nN = N / BM; nwg = nM * nN; G = G_; c = c_; }
    __host__ __device__ bool next(int i, Unit& u) const {
        const long L = (long)i * G + c; if (L >= nwg) return false;
        int wgid = (int)L; { const int q = nwg / NXCD, r = nwg % NXCD, xcd = wgid % NXCD, off = wgid / NXCD; wgid = (xcd < r ? xcd * (q + 1) : r * (q + 1) + (xcd - r) * q) + off; }
        const int nig = WGM * nN, gid = wgid / nig, fm = gid * WGM, gsz = (nM - fm) < WGM ? (nM - fm) : WGM;
        u.pm = fm + ((wgid % nig) % gsz); u.pn = (wgid % nig) / gsz; return true;
    }
    __device__ __forceinline__ void a_ready(const Unit&) const {}
    __device__ __forceinline__ void done(const Unit&) const {}
};

__device__ __forceinline__ unsigned cvt_pk_bf16(float lo, float hi) { unsigned r; asm volatile("v_cvt_pk_bf16_f32 %0, %1, %2" : "=v"(r) : "v"(lo), "v"(hi)); return r; }
template <class Epi, class Sched, bool ALIGN_EPI = false, bool SP2 = false>
__device__ __forceinline__ void gemm_phase(PG8_LAS unsigned char* lds, const Gemm g, const Sched& S, const Epi& E, const int tid) {
    const int wid = __builtin_amdgcn_readfirstlane(tid >> 6), lane = tid & 63, wr = wid >> 2, wc = wid & 3, fr = lane & 15, fq = lane >> 4;
    const int K = g.K, nt = K / BK;
    unsigned voffA[2], voffB[2];
#pragma unroll
    for (int i = 0; i < 2; ++i) { int R, C; stage_rc(tid * 16 + i * 8192, R, C); const int Rb = Epi::PERM ? ((R & ~31) + perm32(R & 31)) : R;
        voffA[i] = (unsigned)(R * K + C) * 2u; voffB[i] = (unsigned)(Rb * K + C) * 2u; }
    const size_t kstep = (size_t)(BK * 2);
    const size_t hstep = (size_t)HALF * K * 2;
    const size_t tstep = 2 * hstep;
    const unsigned ldsw = (unsigned)wid * 1024u;
    const int aoff = lds_byte(wr * 64 + fr, fq * 8), boff = lds_byte(wc * 32 + fr, fq * 8);
#define PG8_SA(b, h) (((b) * 2 + (h)) * HTB)
#define PG8_SB(b, h) ((4 + (b) * 2 + (h)) * HTB)
#define PG8_STAGE(bufoff, gbase, voff) do { _Pragma("unroll") for (int _i = 0; _i < 2; ++_i) \
        __builtin_amdgcn_global_load_lds((const unsigned*)((const char*)(gbase) + (voff)[_i]), (PG8_LAS unsigned*)(lds + (bufoff) + ldsw + _i * 8192), 16, 0, 0); } while (0)
#define PG8_LDA(dst, b, h) do { _Pragma("unroll") for (int m = 0; m < 4; ++m) _Pragma("unroll") for (int k = 0; k < 2; ++k) dst[m][k] = *(const PG8_LAS bf16x8*)(lds + PG8_SA(b, h) + aoff + m * 2048 + k * 1024); } while (0)
#define PG8_LDB(dst, b, h) do { _Pragma("unroll") for (int n = 0; n < 2; ++n) _Pragma("unroll") for (int k = 0; k < 2; ++k) dst[n][k] = *(const PG8_LAS bf16x8*)(lds + PG8_SB(b, h) + boff + n * 2048 + k * 1024); } while (0)
#define PG8_MMA(ai, bj, At, Bt) do { __builtin_amdgcn_s_setprio(1); _Pragma("unroll") for (int m = 0; m < 4; ++m) _Pragma("unroll") for (int n = 0; n < 2; ++n) _Pragma("unroll") for (int k = 0; k < 2; ++k) \
        acc[ai][bj][m][n] = __builtin_amdgcn_mfma_f32_16x16x32_bf16(Bt[n][k], At[m][k], acc[ai][bj][m][n], 0, 0, 0); __builtin_amdgcn_s_setprio(0); } while (0)
#define PG8_WAIT_V(n) asm volatile("s_waitcnt vmcnt(" #n ")" ::: "memory")
#define PG8_WAIT_L(n) asm volatile("s_waitcnt lgkmcnt(" #n ")" ::: "memory")
#define PG8_BAR __builtin_amdgcn_s_barrier()
#define PG8_SCHED __builtin_amdgcn_sched_barrier(0)
    Unit cur, nxt; int ui = 0;
    if (!S.next(0, cur)) return;
    f32x4 acc[2][2][4][2];
#pragma unroll
    for (int a = 0; a < 2; ++a)
#pragma unroll
        for (int b = 0; b < 2; ++b)
#pragma unroll
            for (int m = 0; m < 4; ++m)
#pragma unroll
                for (int n = 0; n < 2; ++n) acc[a][b][m][n] = (f32x4){0.f, 0.f, 0.f, 0.f};
    bf16x8 At[4][2], B0[2][2], B1[2][2];
    const char* cA = (const char*)g.A + (size_t)cur.pm * tstep; const char* cB = (const char*)g.Bt + (size_t)cur.pn * tstep;
    S.a_ready(cur);
    if constexpr (SP2) {
        PG8_STAGE(PG8_SB(0, 0), cB, voffB); PG8_STAGE(PG8_SB(0, 1), cB + hstep, voffB); PG8_STAGE(PG8_SA(0, 0), cA, voffA); PG8_STAGE(PG8_SA(0, 1), cA + hstep, voffA);
        if (wr == 1) PG8_BAR;
        PG8_WAIT_V(2); PG8_BAR;
        PG8_STAGE(PG8_SB(1, 0), cB + kstep, voffB); PG8_STAGE(PG8_SA(1, 0), cA + kstep, voffA); PG8_STAGE(PG8_SB(1, 1), cB + hstep + kstep, voffB);
        PG8_WAIT_V(6); PG8_BAR;
    } else {
        PG8_STAGE(PG8_SB(0, 0), cB, voffB); PG8_STAGE(PG8_SA(0, 0), cA, voffA); PG8_STAGE(PG8_SB(0, 1), cB + hstep, voffB); PG8_STAGE(PG8_SA(0, 1), cA + hstep, voffA);
        if (wr == 1) PG8_BAR;
        PG8_WAIT_V(4); PG8_BAR;
        PG8_STAGE(PG8_SB(1, 0), cB + kstep, voffB); PG8_STAGE(PG8_SA(1, 0), cA + kstep, voffA); PG8_STAGE(PG8_SB(1, 1), cB + hstep + kstep, voffB);
        PG8_WAIT_V(6); PG8_BAR;
    }
    for (;;) {
        const bool has_next = S.next(ui + 1, nxt);
        const char* nA = has_next ? (const char*)g.A + (size_t)nxt.pm * tstep : cA; const char* nB = has_next ? (const char*)g.Bt + (size_t)nxt.pn * tstep : cB;
        for (int t = 0; t < nt; t += 2) {
            const bool last = (t == nt - 2);
            const char* a1 = cA + (size_t)(t + 1) * kstep;
            const char* a2 = last ? nA : cA + (size_t)(t + 2) * kstep; const char* b2 = last ? nB : cB + (size_t)(t + 2) * kstep;
            const char* a3 = a2 + kstep; const char* b3 = b2 + kstep;
            if (last && has_next) S.a_ready(nxt);
            if constexpr (SP2) {
            PG8_LDB(B0, 0, 0); PG8_LDB(B1, 0, 1); PG8_SCHED; PG8_LDA(At, 0, 0); PG8_STAGE(PG8_SA(1, 1), a1 + hstep, voffA);
            PG8_WAIT_V(8); PG8_WAIT_L(0); PG8_BAR; PG8_MMA(0, 0, At, B0); PG8_MMA(0, 1, At, B1); PG8_BAR; PG8_SCHED;
            PG8_LDA(At, 0, 1); PG8_STAGE(PG8_SB(0, 0), b2, voffB); PG8_STAGE(PG8_SB(0, 1), b2 + hstep, voffB); PG8_STAGE(PG8_SA(0, 0), a2, voffA);
            PG8_WAIT_V(8); PG8_WAIT_L(0); PG8_BAR; PG8_MMA(1, 0, At, B0); PG8_MMA(1, 1, At, B1); PG8_BAR; PG8_SCHED;
            PG8_LDB(B0, 1, 0); PG8_LDB(B1, 1, 1); PG8_SCHED; PG8_LDA(At, 1, 0); PG8_STAGE(PG8_SA(0, 1), a2 + hstep, voffA);
            PG8_WAIT_V(8); PG8_WAIT_L(0); PG8_BAR; PG8_MMA(0, 0, At, B0); PG8_MMA(0, 1, At, B1); PG8_BAR; PG8_SCHED;
            PG8_LDA(At, 1, 1); PG8_STAGE(PG8_SB(1, 0), b3, voffB); PG8_STAGE(PG8_SB(1, 1), b3 + hstep, voffB); PG8_STAGE(PG8_SA(1, 0), a3, voffA);
            PG8_WAIT_V(8); PG8_WAIT_L(0); PG8_BAR; PG8_MMA(1, 0, At, B0); PG8_MMA(1, 1, At, B1); PG8_BAR; PG8_SCHED;
            } else {
            PG8_LDB(B0, 0, 0); PG8_SCHED; PG8_LDA(At, 0, 0); PG8_STAGE(PG8_SA(1, 1), a1 + hstep, voffA);
            PG8_WAIT_L(8); PG8_BAR; PG8_WAIT_L(0); PG8_MMA(0, 0, At, B0); PG8_BAR; PG8_SCHED;
            PG8_LDB(B1, 0, 1); PG8_STAGE(PG8_SB(0, 0), b2, voffB);
            PG8_BAR; PG8_WAIT_L(0); PG8_MMA(0, 1, At, B1); PG8_BAR;
            PG8_LDA(At, 0, 1); PG8_STAGE(PG8_SA(0, 0), a2, voffA);
            PG8_BAR; PG8_WAIT_L(0); PG8_MMA(1, 0, At, B0); PG8_BAR; PG8_SCHED;
            PG8_STAGE(PG8_SB(0, 1), b2 + hstep, voffB);
            PG8_WAIT_V(6); PG8_BAR; PG8_MMA(1, 1, At, B1); PG8_BAR;
            PG8_LDB(B0, 1, 0); PG8_SCHED; PG8_LDA(At, 1, 0); PG8_STAGE(PG8_SA(0, 1), a2 + hstep, voffA);
            PG8_WAIT_L(8); PG8_BAR; PG8_WAIT_L(0); PG8_MMA(0, 0, At, B0); PG8_BAR; PG8_SCHED;
            PG8_LDB(B1, 1, 1); PG8_STAGE(PG8_SB(1, 0), b3, voffB);
            PG8_BAR; PG8_WAIT_L(0); PG8_MMA(0, 1, At, B1); PG8_BAR;
            PG8_LDA(At, 1, 1); PG8_STAGE(PG8_SA(1, 0), a3, voffA);
            PG8_BAR; PG8_WAIT_L(0); PG8_MMA(1, 0, At, B0); PG8_BAR; PG8_SCHED;
            PG8_STAGE(PG8_SB(1, 1), b3 + hstep, voffB);
            PG8_WAIT_V(6); PG8_BAR; PG8_MMA(1, 1, At, B1); PG8_BAR;
            }
        }
        if constexpr (ALIGN_EPI) { if (wr == 0) PG8_BAR; }
        if constexpr (!Epi::AFTER_DRAIN) { E(acc, cur, wr, wc, fr, fq); S.done(cur); }
        if (!has_next) break;
#pragma unroll
        for (int a = 0; a < 2; ++a)
#pragma unroll
            for (int b = 0; b < 2; ++b)
#pragma unroll
                for (int m = 0; m < 4; ++m)
#pragma unroll
                    for (int n = 0; n < 2; ++n) acc[a][b][m][n] = (f32x4){0.f, 0.f, 0.f, 0.f};
        cur = nxt; cA = nA; cB = nB; ++ui;
        if constexpr (ALIGN_EPI) { if (wr == 1) PG8_BAR; }
    }
    PG8_WAIT_V(0);
    if constexpr (!ALIGN_EPI) { if (wr == 0) PG8_BAR; }
    PG8_BAR;
    if constexpr (Epi::AFTER_DRAIN) { E.fused(acc, cur, wr, wc, fr, fq, lds, wid, lane); S.done(cur); }
#undef PG8_SA
#undef PG8_SB
#undef PG8_STAGE
#undef PG8_LDA
#undef PG8_LDB
#undef PG8_MMA
#undef PG8_WAIT_V
#undef PG8_WAIT_L
#undef PG8_BAR
#undef PG8_SCHED
}
}

using pg8::Unit;

struct EpiIn {
    static constexpr bool PERM = true, AFTER_DRAIN = false;
    u16 *MQ, *AQ; float *kout; const float *rcos, *rsin;
    __device__ __forceinline__ void operator()(f32x4 (&acc)[2][2][4][2], const Unit& u, int wr, int wc, int fr, int fq) const {
        const int row0 = u.pm * 256 + wr * 64 + fr;
        if (u.pn < 16) {
            const int sec = u.pn >> 2; u16* base = MQ + (size_t)sec * (8u << 20); const float sc = (sec == 1) ? 0.0625f : 1.0f;
            const int col0 = (u.pn & 3) * 256 + wc * 32 + 8 * fq;
#pragma unroll
            for (int ai = 0; ai < 2; ++ai)
#pragma unroll
                for (int m = 0; m < 4; ++m) { u16* rowp = base + (size_t)(row0 + ai * 128 + m * 16) * MW + col0;
#pragma unroll
                    for (int bj = 0; bj < 2; ++bj) stgu4(rowp + bj * 128, pack8f(acc[ai][bj][m][0] * sc, acc[ai][bj][m][1] * sc)); }
        } else {
            const int a = u.pn - 16, sec = a >> 2, pt = a & 3, head = 2 * pt + (wc >> 1), dl0 = 32 * (wc & 1) + 8 * fq, b = u.pm >> 4;
            u16* dbase = AQ + (size_t)sec * (8u << 20) + (size_t)(b * AH + head) * TP * AD;
            float* fbase = kout + (size_t)(sec == 2 ? 1 : 0) * ((size_t)MP * AW) + (size_t)b * TP * AW + head * AD;
#pragma unroll
            for (int ai = 0; ai < 2; ++ai)
#pragma unroll
                for (int m = 0; m < 4; ++m) {
                    const int t = (row0 + ai * 128 + m * 16) & (TP - 1);
                    f32x4 x1a = acc[ai][0][m][0], x1b = acc[ai][0][m][1], x2a = acc[ai][1][m][0], x2b = acc[ai][1][m][1];
                    if (sec < 2) {
                        const f32x4 c0 = ldg4(rcos + t * 64 + dl0), c1 = ldg4(rcos + t * 64 + dl0 + 4), s0 = ldg4(rsin + t * 64 + dl0), s1 = ldg4(rsin + t * 64 + dl0 + 4);
                        const f32x4 o1a = x1a * c0 - x2a * s0, o2a = x2a * c0 + x1a * s0, o1b = x1b * c1 - x2b * s1, o2b = x2b * c1 + x1b * s1;
                        x1a = o1a; x2a = o2a; x1b = o1b; x2b = o2b;
                    }
                    u16* dst = dbase + (size_t)t * AD + dl0;
                    stgu4(dst, pack8f(x1a, x1b)); stgu4(dst + 64, pack8f(x2a, x2b));
                    if (sec >= 1) { float* fo = fbase + (size_t)t * AW + dl0; stg4(fo, x1a); stg4(fo + 4, x1b); stg4(fo + 64, x2a); stg4(fo + 68, x2b); }
                }
        }
    }
};

template <bool WITH_G> struct EpiRes {
    static constexpr bool PERM = true, AFTER_DRAIN = false;
    const float* res; float* out; u16* outg; const float* g; float* SS;
    __device__ __forceinline__ void operator()(f32x4 (&acc)[2][2][4][2], const Unit& u, int wr, int wc, int fr, int fq) const {
        const int row0 = u.pm * 256 + wr * 64 + fr, col0 = u.pn * 256 + wc * 32 + 8 * fq;
        f32x4 gv[2][2];
        if (WITH_G) {
#pragma unroll
            for (int bj = 0; bj < 2; ++bj)
#pragma unroll
                for (int n = 0; n < 2; ++n) gv[bj][n] = ldg4(g + col0 + bj * 128 + 4 * n);
        }
#pragma unroll
        for (int ai = 0; ai < 2; ++ai)
#pragma unroll
            for (int m = 0; m < 4; ++m) {
                const int row = row0 + ai * 128 + m * 16; const size_t off = (size_t)row * DM + col0; float ss = 0.f;
#pragma unroll
                for (int bj = 0; bj < 2; ++bj) {
                    const f32x4 v0 = acc[ai][bj][m][0] + ldg4(res + off + bj * 128), v1 = acc[ai][bj][m][1] + ldg4(res + off + bj * 128 + 4);
                    stg4(out + off + bj * 128, v0); stg4(out + off + bj * 128 + 4, v1);
                    ss += dot4(v0, v0) + dot4(v1, v1);
                    if (WITH_G) stgu4(outg + off + bj * 128, pack8f(v0 * gv[bj][0], v1 * gv[bj][1]));
                }
                ss += __shfl_xor(ss, 16); ss += __shfl_xor(ss, 32);
                if (fq == 0) stgf(SS + (size_t)row * 32 + u.pn * 4 + wc, ss);
            }
    }
};

__device__ __forceinline__ float dpp_ror1f(float x) { return __int_as_float(__builtin_amdgcn_mov_dpp(__float_as_int(x), 0x121, 0xf, 0xf, false)); }
__device__ __forceinline__ float dpp_ror2f(float x) { return __int_as_float(__builtin_amdgcn_mov_dpp(__float_as_int(x), 0x122, 0xf, 0xf, false)); }
__device__ __forceinline__ f32x4 dpp_ror1(f32x4 v) { f32x4 r; r.x = dpp_ror1f(v.x); r.y = dpp_ror1f(v.y); r.z = dpp_ror1f(v.z); r.w = dpp_ror1f(v.w); return r; }
__device__ __forceinline__ f32x4 dpp_ror2(f32x4 v) { f32x4 r; r.x = dpp_ror2f(v.x); r.y = dpp_ror2f(v.y); r.z = dpp_ror2f(v.z); r.w = dpp_ror2f(v.w); return r; }
__device__ __forceinline__ f32x4 silu_mul(f32x4 g, f32x4 up) { f32x4 r;
#pragma unroll
    for (int i = 0; i < 4; ++i) r[i] = g[i] * __builtin_amdgcn_rcpf(1.0f + __builtin_amdgcn_exp2f(-1.4426950408889634f * g[i])) * up[i]; return r; }

__device__ __forceinline__ void up_fixup(int P, int pn, const float* UB, const float* conv_w, const float* conv_b, u16* ACT, int tid) {
    if (tid < 128) {
        const int j = tid;
        const float* ua = UB + ((size_t)(P - 1) * 4 + 2) * NUP + pn * 256;
        const float* ub = UB + ((size_t)P * 4 + 0) * NUP + pn * 256;
        float cv[2][2];
#pragma unroll
        for (int h = 0; h < 2; ++h) {
            const int tc = h * 128 + j, oc = h * DFF + pn * 128 + j;
            const float um2 = ldgf(ua + tc), um1 = ldgf(ua + NUP + tc), u0 = ldgf(ub + tc), u1 = ldgf(ub + NUP + tc);
            const float w0 = ldgf(conv_w + oc), w1 = ldgf(conv_w + NUP + oc), w2 = ldgf(conv_w + 2 * NUP + oc), cb = ldgf(conv_b + oc);
            cv[h][0] = cb + w0 * um2 + w1 * um1 + w2 * u0; cv[h][1] = cb + w0 * um1 + w1 * u0 + w2 * u1;
        }
#pragma unroll
        for (int r = 0; r < 2; ++r) { const float g = cv[0][r]; const float a = g / (1.0f + __expf(-g)) * cv[1][r];
            *(GAS u16*)(ACT + (size_t)(P * 256 + r) * DFF + pn * 128 + j) = (u16)f2bf(a); }
    }
}

struct EpiUp {
    static constexpr bool PERM = true, AFTER_DRAIN = false;
    LAS unsigned char* xl;
    const float* SS1; const float *conv_w, *conv_b; u16* ACT; float* UB; gu32* cnt; float* conv_out; void* dbg_ufull;
    __device__ __forceinline__ void operator()(f32x4 (&acc)[2][2][4][2], const Unit& u, int wr, int wc, int fr, int fq) const {
        const int tid = (wr * 4 + wc) * 64 + fq * 16 + fr;
        LAS float* XCH = (LAS float*)xl; LAS float* RS = (LAS float*)(xl + 8192); volatile LAS unsigned* FL = (volatile LAS unsigned*)(xl + 8192 + 1024);
        { const int row = tid >> 1, half = tid & 1; const float* p = SS1 + (size_t)(u.pm * 256 + row) * 32 + half * 16;
          const f32x4 a = ldg4(p), b = ldg4(p + 4), c = ldg4(p + 8), d = ldg4(p + 12);
          float s = ((a[0] + a[1]) + (a[2] + a[3])) + ((b[0] + b[1]) + (b[2] + b[3])) + ((c[0] + c[1]) + (c[2] + c[3])) + ((d[0] + d[1]) + (d[2] + d[3]));
          s += __shfl_xor(s, 1);
          if (half == 0) RS[row] = 1.0f / sqrtf(s * (1.0f / DM) + EPS); }
        WG_BAR();
#pragma unroll
        for (int ai = 0; ai < 2; ++ai)
#pragma unroll
            for (int m = 0; m < 4; ++m) { const float rs = RS[ai * 128 + wr * 64 + m * 16 + fr];
#pragma unroll
                for (int bj = 0; bj < 2; ++bj)
#pragma unroll
                    for (int n = 0; n < 2; ++n) acc[ai][bj][m][n] = acc[ai][bj][m][n] * rs; }
#ifdef DBG_UFULL
        { float* UF = (float*)dbg_ufull;
#pragma unroll
          for (int ai = 0; ai < 2; ++ai)
#pragma unroll
            for (int m = 0; m < 4; ++m)
#pragma unroll
              for (int bj = 0; bj < 2; ++bj)
#pragma unroll
                for (int n = 0; n < 2; ++n) stg4(UF + (size_t)(u.pm * 256 + ai * 128 + wr * 64 + m * 16 + fr) * NUP + u.pn * 256 + bj * 128 + 32 * wc + 8 * fq + 4 * n, acc[ai][bj][m][n]); }
#endif
        const bool bstart = (u.pm & 15) == 0, bend = (u.pm & 15) == 15;
        const int tcl = 32 * wc + 8 * fq;
#pragma unroll
        for (int ai = 0; ai < 2; ++ai) {
            const int g = ai * 2 + wr;
            if (fr >= 14) {
#pragma unroll
                for (int bj = 0; bj < 2; ++bj)
#pragma unroll
                    for (int n = 0; n < 2; ++n) *(LAS f32x4*)(XCH + (g * 2 + (fr - 14)) * 256 + bj * 128 + tcl + 4 * n) = acc[ai][bj][3][n];
                if (g == 3) {
#pragma unroll
                    for (int bj = 0; bj < 2; ++bj)
#pragma unroll
                        for (int n = 0; n < 2; ++n) {
                            if (!bend) stg4_sc1(UB + ((size_t)u.pm * 4 + 2 + (fr - 14)) * NUP + u.pn * 256 + bj * 128 + tcl + 4 * n, acc[ai][bj][3][n]);
                            else stg4(conv_out + ((size_t)(u.pm >> 4) * 2 + (fr - 14)) * NUP + bj * DFF + u.pn * 128 + tcl + 4 * n, acc[ai][bj][3][n]);
                        }
                }
            }
            if (g == 0 && fr < 2 && !bstart) {
#pragma unroll
                for (int bj = 0; bj < 2; ++bj)
#pragma unroll
                    for (int n = 0; n < 2; ++n) stg4_sc1(UB + ((size_t)u.pm * 4 + fr) * NUP + u.pn * 256 + bj * 128 + tcl + 4 * n, acc[ai][bj][0][n]);
            }
        }
        asm volatile("s_waitcnt vmcnt(0)" ::: "memory");
        WG_BAR();
        if (tid == 0) {
            unsigned f0 = 0u, f1 = 0u;
            if (!bstart) f0 = (__hip_atomic_fetch_add(cnt + u.pm * 44 + u.pn, 1u, __ATOMIC_RELAXED, __HIP_MEMORY_SCOPE_AGENT) == 1u) ? 1u : 0u;
            if (!bend) f1 = (__hip_atomic_fetch_add(cnt + (u.pm + 1) * 44 + u.pn, 1u, __ATOMIC_RELAXED, __HIP_MEMORY_SCOPE_AGENT) == 1u) ? 1u : 0u;
            if (f0 | f1) { __builtin_amdgcn_fence(__ATOMIC_ACQUIRE, "agent"); asm volatile("s_waitcnt vmcnt(0)" ::: "memory"); }
            FL[0] = f0; FL[1] = f1;
        }
#pragma unroll
        for (int n = 0; n < 2; ++n) {
            f32x4 cw[2][3], cbv[2];
#pragma unroll
            for (int bj = 0; bj < 2; ++bj) { const int oc = bj * DFF + u.pn * 128 + tcl + 4 * n;
                cw[bj][0] = ldg4(conv_w + oc); cw[bj][1] = ldg4(conv_w + NUP + oc); cw[bj][2] = ldg4(conv_w + 2 * NUP + oc); cbv[bj] = ldg4(conv_b + oc); }
#pragma unroll
            for (int ai = 0; ai < 2; ++ai) {
                const int g = ai * 2 + wr;
#pragma unroll
                for (int m = 0; m < 4; ++m) {
                    f32x4 cv[2];
#pragma unroll
                    for (int bj = 0; bj < 2; ++bj) {
                        const f32x4 cur = acc[ai][bj][m][n]; const f32x4 a1 = dpp_ror1(cur), a2 = dpp_ror2(cur); f32x4 p1, p2;
                        if (m > 0) { const f32x4 b1 = dpp_ror1(acc[ai][bj][m - 1][n]), b2 = dpp_ror2(acc[ai][bj][m - 1][n]);
#pragma unroll
                            for (int i = 0; i < 4; ++i) { p1[i] = fr == 0 ? b1[i] : a1[i]; p2[i] = fr < 2 ? b2[i] : a2[i]; } }
                        else { f32x4 X0 = (f32x4){0.f, 0.f, 0.f, 0.f}, X1 = X0;
                            if (g > 0) { X0 = *(LAS f32x4*)(XCH + ((g - 1) * 2 + 0) * 256 + bj * 128 + tcl + 4 * n); X1 = *(LAS f32x4*)(XCH + ((g - 1) * 2 + 1) * 256 + bj * 128 + tcl + 4 * n); }
#pragma unroll
                            for (int i = 0; i < 4; ++i) { p1[i] = fr == 0 ? X1[i] : a1[i]; p2[i] = fr == 0 ? X0[i] : (fr == 1 ? X1[i] : a2[i]); } }
                        cv[bj] = cbv[bj] + cw[bj][0] * p2 + cw[bj][1] * p1 + cw[bj][2] * cur;
                    }
                    const f32x4 a = silu_mul(cv[0], cv[1]);
                    const bool skip = (g == 0 && m == 0 && fr < 2 && !bstart);
                    if (!skip) { u32x2 w; w.x = cvtpk(a[0], a[1]); w.y = cvtpk(a[2], a[3]);
                        stgu2(ACT + (size_t)(u.pm * 256 + g * 64 + m * 16 + fr) * DFF + u.pn * 128 + tcl + 4 * n, w); }
                }
            }
        }
        WG_BAR();
        const unsigned f0 = FL[0], f1 = FL[1];
        if (f0) up_fixup(u.pm, u.pn, UB, conv_w, conv_b, ACT, tid);
        if (f1) up_fixup(u.pm + 1, u.pn, UB, conv_w, conv_b, ACT, tid);
        WG_BAR();
    }
};

namespace moba {
constexpr int D = 128, NW = 8, QBLK = 32, KVBLK = 64, QB = NW * QBLK;
constexpr int SHM_V = KVBLK * D * 2, SHM_K = KVBLK * D * 2;
constexpr int ATT_LDS = 2 * SHM_V + 2 * SHM_K + NW * 64 * 4;
constexpr float SCALE = 0.08838834764831845f, THR = 8.f;
constexpr int OSTRIDE = 2048;
constexpr int QLDS_OFF = 81920;
#define KSWZ(row, colB) ((row) * 256 + ((colB) ^ (((row) & 7) << 4)))
#define SBAR() __builtin_amdgcn_sched_barrier(0)
__device__ __forceinline__ int v_st(int k, int c) { const int kk = (k & ~0xC) | ((k & 4) << 1) | ((k & 8) >> 1); return ((kk >> 3) * 4 + (c >> 5)) * 512 + ((kk & 7) * 32 + (c & 31)) * 2; }
__device__ __forceinline__ int v_rd_base(int lane) { return ((lane & 3) << 3) | (((lane >> 2) & 3) << 6) | (((lane >> 4) & 1) << 5) | (((lane >> 5) & 1) << 8); }
constexpr int v_rd_off(int d0, int ks, int half) { return d0 * 512 + ks * 4096 + half * 2048; }
__device__ __forceinline__ int crow(int r, int hi) { return (r & 3) + 8 * (r >> 2) + 4 * hi; }
__device__ __forceinline__ bf16x8 load8(const u16* p) { return *(const GAS bf16x8*)p; }
__device__ __forceinline__ void mask_tile(f32x16& p0, f32x16& p1, int dq) {
    const float NEG = -__builtin_inff();
#pragma unroll
    for (int r = 0; r < 16; ++r) {
        const int c = (r & 3) + 8 * (r >> 2);
        if (dq - c < 0) p0[r] = NEG;
        if (dq - c - 32 < 0) p1[r] = NEG;
    }
}
__device__ __forceinline__ void mask_all(f32x16& p0, f32x16& p1, bool keep) {
    const float NEG = -__builtin_inff();
#pragma unroll
    for (int r = 0; r < 16; ++r) { p0[r] = keep ? p0[r] : NEG; p1[r] = keep ? p1[r] : NEG; }
}
__device__ __forceinline__ void partialSM(f32x16& p0, f32x16& p1, float& m_reg, float& mn, float& alpha, bool keep) {
    float pmax = p0[0];
#pragma unroll
    for (int r = 1; r < 16; ++r) pmax = fmaxf(pmax, p0[r]);
#pragma unroll
    for (int r = 0; r < 16; ++r) pmax = fmaxf(pmax, p1[r]);
    { auto rr = __builtin_amdgcn_permlane32_swap(__float_as_uint(pmax), __float_as_uint(pmax), false, false);
      pmax = fmaxf(__uint_as_float(rr[0]), __uint_as_float(rr[1])); }
    pmax = keep ? pmax : -__builtin_inff();
    constexpr float C2 = 1.4426950408889634f * SCALE;
    if (__builtin_expect(__all((pmax - m_reg) * SCALE <= THR), 1)) { mn = m_reg; alpha = 1.f; }
    else { mn = fmaxf(m_reg, pmax); alpha = __builtin_amdgcn_exp2f((m_reg - mn) * C2); m_reg = mn; }
    const float mnL = keep ? -mn * C2 : -__builtin_inff();
#pragma unroll
    for (int r = 0; r < 16; ++r) p0[r] = fmaf(p0[r], C2, mnL);
#pragma unroll
    for (int r = 0; r < 16; ++r) p1[r] = fmaf(p1[r], C2, mnL);
#pragma unroll
    for (int r = 0; r < 16; ++r) p0[r] = __builtin_amdgcn_exp2f(p0[r]);
}
__device__ __forceinline__ void finishSM(f32x16& p0, f32x16& p1, float alpha, float& l_reg, bf16x8& pa0, bf16x8& pa1, bf16x8& pa2, bf16x8& pa3) {
#pragma unroll
    for (int r = 0; r < 16; ++r) p1[r] = __builtin_amdgcn_exp2f(p1[r]);
    float ps = 0;
#pragma unroll
    for (int r = 0; r < 16; ++r) ps += p0[r];
#pragma unroll
    for (int r = 0; r < 16; ++r) ps += p1[r];
    { auto rr = __builtin_amdgcn_permlane32_swap(__float_as_uint(ps), __float_as_uint(ps), false, false);
      ps = __uint_as_float(rr[0]) + __uint_as_float(rr[1]); }
    l_reg = l_reg * alpha + ps;
#define PK4(P, B_, OUT) do { unsigned a0 = cvtpk_asm(P[B_+0], P[B_+1]), a1 = cvtpk_asm(P[B_+2], P[B_+3]);                          \
        unsigned b0 = cvtpk_asm(P[B_+4], P[B_+5]), b1 = cvtpk_asm(P[B_+6], P[B_+7]);                                             \
        auto r0 = __builtin_amdgcn_permlane32_swap(a0, b0, false, false); auto r1 = __builtin_amdgcn_permlane32_swap(a1, b1, false, false); \
        u32x4 w = {r0[0], r1[0], r0[1], r1[1]}; OUT = *reinterpret_cast<bf16x8*>(&w); } while (0)
    PK4(p0, 0, pa0); PK4(p0, 8, pa1); PK4(p1, 0, pa2); PK4(p1, 8, pa3);
#undef PK4
}
template <int KB>
__device__ __forceinline__ void qkt(f32x16& p0, f32x16& p1, const char* K_lds, int r32, int hi, const char* qr) {
    p0 = f32x16{}; p1 = f32x16{};
    const char* kb[4];
#pragma unroll
    for (int dd = 0; dd < 4; ++dd) kb[dd] = K_lds + KB * SHM_K + KSWZ(r32, (dd * 16 + hi * 8) * 2);
#pragma unroll
    for (int d0 = 0; d0 < 8; ++d0) { const char* a = kb[d0 & 3] + (d0 >> 2) * 128;
        bf16x8 b0 = *reinterpret_cast<const bf16x8*>(a);
        bf16x8 b1 = *reinterpret_cast<const bf16x8*>(a + 32 * 256);
        const bf16x8 q = *reinterpret_cast<const bf16x8*>(qr + d0 * 1024);
        p0 = __builtin_amdgcn_mfma_f32_32x32x16_bf16(b0, q, p0, 0, 0, 0);
        p1 = __builtin_amdgcn_mfma_f32_32x32x16_bf16(b1, q, p1, 0, 0, 0); }
}
template <int VB>
__device__ __forceinline__ void pv_tile(f32x16* o, int vb0, bf16x8 pa0, bf16x8 pa1, bf16x8 pa2, bf16x8 pa3) {
#define TRRD(dst, off) asm volatile("ds_read_b64_tr_b16 %0, %1 offset:%2" : "=&v"(dst) : "v"(vb0), "i"(off) : "memory")
#define PV_D0(d0) do { s16x4 l0, l1, l2, l3, h0, h1, h2, h3; constexpr int b_ = VB * SHM_V + v_rd_off(d0, 0, 0); \
        TRRD(l0, b_); TRRD(h0, b_ + 2048); TRRD(l1, b_ + 4096); TRRD(h1, b_ + 6144); TRRD(l2, b_ + 8192); TRRD(h2, b_ + 10240); TRRD(l3, b_ + 12288); TRRD(h3, b_ + 14336); \
        asm volatile("s_waitcnt lgkmcnt(0)" ::: "memory"); SBAR();   \
        o[d0] = __builtin_amdgcn_mfma_f32_32x32x16_bf16(pa0, (bf16x8){l0[0], l0[1], l0[2], l0[3], h0[0], h0[1], h0[2], h0[3]}, o[d0], 0, 0, 0);   \
        o[d0] = __builtin_amdgcn_mfma_f32_32x32x16_bf16(pa1, (bf16x8){l1[0], l1[1], l1[2], l1[3], h1[0], h1[1], h1[2], h1[3]}, o[d0], 0, 0, 0);   \
        o[d0] = __builtin_amdgcn_mfma_f32_32x32x16_bf16(pa2, (bf16x8){l2[0], l2[1], l2[2], l2[3], h2[0], h2[1], h2[2], h2[3]}, o[d0], 0, 0, 0);   \
        o[d0] = __builtin_amdgcn_mfma_f32_32x32x16_bf16(pa3, (bf16x8){l3[0], l3[1], l3[2], l3[3], h3[0], h3[1], h3[2], h3[3]}, o[d0], 0, 0, 0); } while (0)
    PV_D0(0); PV_D0(1); PV_D0(2); PV_D0(3);
#undef PV_D0
#undef TRRD
}

struct HeadRef { const u16* Q; const u16* K; const u16* V; };
typedef __amdgpu_buffer_rsrc_t rsrc_t;
__device__ __forceinline__ rsrc_t mkrsrc(const u16* p) { return __builtin_amdgcn_make_buffer_rsrc((void*)p, 0, 4096 * 128 * 2, 0x00020000); }
__device__ __forceinline__ bf16x8 bload8(rsrc_t r, int voff, int soff) { return __builtin_bit_cast(bf16x8, __builtin_amdgcn_raw_buffer_load_b128(r, voff, soff, 0)); }
struct BlockRef { u16* O; int own, j_lo, j_hi; float* part; gu32* flag; };
struct Seam { bf16x8 qr[8]; bf16x8 st_v0, st_v1, st_k0, st_k1; };
#define ROW(p, k0, rr) ((p) + (size_t)((k0) + (rr)) * D + sc)
#define VMW() asm volatile("s_waitcnt vmcnt(0)" ::: "memory")
#define VMWN(n) asm volatile("s_waitcnt vmcnt(%0)" :: "i"(n) : "memory")
#define SLOAD_H(Kp, Vp, k0) do { const int so_ = (k0) * (D * 2); S.st_v0 = bload8(rV, voff, so_); S.st_v1 = bload8(rV, voff, so_ + 32 * D * 2);              \
                         S.st_k0 = bload8(rK, voff, so_); S.st_k1 = bload8(rK, voff, so_ + 32 * D * 2); } while (0)
#define SWRITE_HK(bf) do { *(bf16x8*)(K_lds + (bf) * SHM_K + kws) = S.st_k0; *(bf16x8*)(K_lds + (bf) * SHM_K + kws + 32 * 256) = S.st_k1; } while (0)
#define SWRITE_HV(bf) do { *(bf16x8*)(V_lds + (bf) * SHM_V + vst0) = S.st_v0; *(bf16x8*)(V_lds + (bf) * SHM_V + vst1) = S.st_v1; } while (0)
#define SWRITE_H(bf) do { SWRITE_HV(bf); SWRITE_HK(bf); } while (0)
__device__ __forceinline__ void moba_prime(const HeadRef& H, const BlockRef& cur, char* lds, Seam& S, const int tid) {
    const int wid = __builtin_amdgcn_readfirstlane(tid >> 6), lane = tid & 63, r32 = lane & 31, hi = lane >> 5;
    const int sr = tid >> 4, sc = (tid & 15) * 8, kws = KSWZ(sr, sc * 2); char* K_lds = lds + 2 * SHM_V;
    const int kb0 = cur.j_lo * KVBLK;
    const rsrc_t rK = mkrsrc(H.K), rV = mkrsrc(H.V), rQ = mkrsrc(H.Q); const int voff = (sr * D + sc) * 2, qoff = ((wid * QBLK + r32) * D + hi * 8) * 2;
#pragma unroll
    for (int d0 = 0; d0 < 8; ++d0) S.qr[d0] = bload8(rQ, qoff, cur.own * (QB * D * 2) + d0 * 32);
    SLOAD_H(H.K, H.V, kb0); VMW(); SWRITE_HK(0);
    __syncthreads();
}
template <int MODE>
__device__ __forceinline__ void moba_block(const HeadRef& H, const BlockRef& cur, const BlockRef& nxt, char* lds, Seam& S, const unsigned* sel, gu32* tmo, int tid_) {
    asm volatile("" : "+v"(tid_));
    const int tid = tid_, wid = __builtin_amdgcn_readfirstlane(tid >> 6), lane = tid & 63, r32 = lane & 31, hi = lane >> 5;
    const int j_lo = cur.j_lo, NT = cur.j_hi - cur.j_lo;
    const int kbn = nxt.j_lo * KVBLK;
    const int P0 = cur.own * QB;
    const int qlo = P0 + wid * QBLK, qm = qlo + r32 - 4 * hi;
    const unsigned mysel = sel[wid * QBLK + r32];
    char* V_lds = lds; char* K_lds = lds + 2 * SHM_V;
    float* ws = (float*)(lds + 2 * SHM_V + 2 * SHM_K) + wid * 64; float* li_l = ws, * al_l = ws + 32;
    float m_reg = -1e30f, l_reg = 0; f32x16 o[4] = {};
    const int sr = tid >> 4, sc = (tid & 15) * 8, vst0 = v_st(sr, sc), vst1 = v_st(32 + sr, sc), kws = KSWZ(sr, sc * 2);
    const int vb0 = (int)(uintptr_t)V_lds + v_rd_base(lane);
    const u16* Kh = H.K; const u16* Vh = H.V; (void)Kh; (void)Vh;
    const rsrc_t rK = mkrsrc(H.K), rV = mkrsrc(H.V), rQ = mkrsrc(H.Q); const int voff = (sr * D + sc) * 2, qoff = ((wid * QBLK + r32) * D + hi * 8) * 2;
#define RESC(a) do { if (__any((a) < 1.f)) { if (hi == 0) al_l[r32] = (a); asm volatile("s_waitcnt lgkmcnt(0)" ::: "memory");              \
                     for (int d_ = 0; d_ < 4; ++d_) for (int r = 0; r < 16; ++r) o[d_][r] *= al_l[crow(r, hi)]; } } while (0)
#define KBASE(t) ((j_lo + (t)) * KVBLK)
#define MASKT(P0_, P1_, t) const int kb_ = KBASE(t); const int nb_ = kb_ >> 8; bool keep_ = true;                                   \
        if (nb_ < cur.own) { keep_ = ((mysel >> nb_) & 1u) != 0u; }                                                                     \
        else if (kb_ + KVBLK - 1 > qlo) { mask_tile(P0_, P1_, qm - kb_); }
#define MSM(P0_, P1_, mnX_, alX_, t) do { MASKT(P0_, P1_, t) partialSM(P0_, P1_, m_reg, mnX_, alX_, keep_); } while (0)
    constexpr int NQL = 8;
#define SEAM_K0() do { VMWN(NQL); SWRITE_HK(0); SBAR(); } while (0)
    f32x16 pA0, pA1, pB0, pB1; float mnA, mnB, alA, alB; bf16x8 pa0, pa1, pa2, pa3;
    char* const qlds = lds + QLDS_OFF + wid * 8192 + lane * 16;
#pragma unroll
    for (int d0 = 0; d0 < 8; ++d0) *reinterpret_cast<bf16x8*>(qlds + d0 * 1024) = S.qr[d0];
    asm volatile("s_waitcnt lgkmcnt(0)" ::: "memory");
    SWRITE_HV(0); SBAR();
    if (NT > 1) { SLOAD_H(Kh, Vh, KBASE(1)); }
    SBAR(); qkt<0>(pA0, pA1, K_lds, r32, hi, qlds);
    MSM(pA0, pA1, mnA, alA, 0);
    if (NT > 1) { VMW(); SWRITE_H(1); }
    __syncthreads();
#define HALF_STEP(PX0, PX1, mnX, alX, PY0, PY1, alY, t, KB, VB, SB) do {                                                      \
        SBAR(); qkt<KB>(PX0, PX1, K_lds, r32, hi, qlds);                                             \
        finishSM(PY0, PY1, alY, l_reg, pa0, pa1, pa2, pa3); SBAR();                                                           \
        if ((t) + 1 < NT) { SLOAD_H(Kh, Vh, KBASE((t) + 1)); SBAR(); }                                               \
        pv_tile<VB>(o, vb0, pa0, pa1, pa2, pa3); MSM(PX0, PX1, mnX, alX, (t));                                        \
        __syncthreads();                                                                                                      \
        if ((t) + 1 < NT) { VMW(); SWRITE_H(SB); }                                                                          \
        RESC(alX); __syncthreads(); } while (0)
    for (int t = 1; t + 1 < NT; t += 2) {
        HALF_STEP(pB0, pB1, mnB, alB, pA0, pA1, alA, t, 1, 0, 0);
        HALF_STEP(pA0, pA1, mnA, alA, pB0, pB1, alB, t + 1, 0, 1, 1);
    }
    const bool even = (NT & 1) == 0;
    if (even) { SBAR(); qkt<1>(pB0, pB1, K_lds, r32, hi, qlds); SBAR(); }
    SLOAD_H(H.K, H.V, kbn); SBAR();
#pragma unroll
    for (int d0 = 0; d0 < 8; ++d0) S.qr[d0] = bload8(rQ, qoff, nxt.own * (QB * D * 2) + d0 * 32);
    SBAR();
    finishSM(pA0, pA1, alA, l_reg, pa0, pa1, pa2, pa3); SBAR();
    pv_tile<0>(o, vb0, pa0, pa1, pa2, pa3);
    if (even) { MSM(pB0, pB1, mnB, alB, NT - 1); __syncthreads(); RESC(alB);
        finishSM(pB0, pB1, alB, l_reg, pa0, pa1, pa2, pa3); SBAR(); pv_tile<1>(o, vb0, pa0, pa1, pa2, pa3); }
    SBAR(); SEAM_K0();
    constexpr float C2 = 1.4426950408889634f * SCALE;
    if (MODE == 1) {
        float* Pw = cur.part + (size_t)(wid * QBLK) * D;
#pragma unroll
        for (int r = 0; r < 16; ++r) { const int orow = crow(r, hi);
#pragma unroll
            for (int d0 = 0; d0 < 4; ++d0) { float* p = Pw + (size_t)orow * D + d0 * 32 + r32; const float v = o[d0][r];
                asm volatile("global_store_dword %0, %1, off sc1" :: "v"((GAS float*)p), "v"(v) : "memory"); } }
        if (hi == 0) { float* p = cur.part + (size_t)QB * D + (size_t)(wid * QBLK + r32) * 2; f32x2 ml = {m_reg, l_reg};
            asm volatile("global_store_dwordx2 %0, %1, off sc1" :: "v"((GAS float*)p), "v"(ml) : "memory"); }
        asm volatile("s_waitcnt vmcnt(0)" ::: "memory");
        __syncthreads();
        if (tid == 0) __hip_atomic_store(cur.flag, 1u, __ATOMIC_RELAXED, __HIP_MEMORY_SCOPE_AGENT);
    } else {
        float f1 = 1.0f, f2 = 0.0f;
        if (MODE == 2) {
            if (wid == 0) { unsigned sp = 0;
                while (__builtin_amdgcn_readfirstlane(__hip_atomic_load(cur.flag, __ATOMIC_RELAXED, __HIP_MEMORY_SCOPE_AGENT)) == 0u) {
                    __builtin_amdgcn_s_sleep(2);
                    if (++sp > (1u << 22)) { if (lane == 0) __hip_atomic_store(tmo, 1u, __ATOMIC_RELAXED, __HIP_MEMORY_SCOPE_AGENT); break; } }
                __builtin_amdgcn_fence(__ATOMIC_ACQUIRE, "agent"); }
            asm volatile("s_waitcnt vmcnt(0)" ::: "memory");
            __syncthreads();
            const float* pml = cur.part + (size_t)QB * D + (size_t)(wid * QBLK + r32) * 2;
            const float m2 = ldgf(pml), l2 = ldgf(pml + 1);
            const float mN = fmaxf(m_reg, m2), a1 = __builtin_amdgcn_exp2f((m_reg - mN) * C2), a2 = __builtin_amdgcn_exp2f((m2 - mN) * C2);
            const float lt = a1 * l_reg + a2 * l2; const float il = 1.0f / lt; f1 = a1 * il; f2 = a2 * il;
        } else { f1 = 1.0f / l_reg; }
        if (hi == 0) { li_l[r32] = f1; al_l[r32] = f2; } asm volatile("s_waitcnt lgkmcnt(0)" ::: "memory");
        u16* op = cur.O + (size_t)(wid * QBLK + 4 * hi) * OSTRIDE + r32;
        const float* pp = cur.part + (size_t)(wid * QBLK + 4 * hi) * D + r32;
#pragma unroll
        for (int r = 0; r < 16; ++r) { const int orow = crow(r, hi); const float g1 = li_l[orow], g2 = al_l[orow];
#pragma unroll
            for (int d0 = 0; d0 < 4; ++d0) { float v = o[d0][r] * g1;
                if (MODE == 2) v += g2 * ldgf(pp + d0 * 32);
                const float vn = __shfl_xor(v, 1);
                if ((r32 & 1) == 0) *(GAS unsigned*)(op + d0 * 32) = cvtpk_asm(v, vn); }
            const int step = ((r & 3) == 3) ? 5 : 1; op += (size_t)step * OSTRIDE; pp += (size_t)step * D;
            asm volatile("" : "+v"(op), "+v"(pp)); }
    }
    __syncthreads();
#undef RESC
#undef KBASE
#undef MASKT
#undef MSM
#undef SEAM_K0
#undef HALF_STEP
}
#undef ROW
#undef VMW
#undef VMWN
#undef SLOAD_H
#undef SWRITE_HK
#undef SWRITE_HV
#undef SWRITE_H
#undef KSWZ
#undef SBAR
}

__device__ __forceinline__ f32x4 mfma16(bf16x8 a, bf16x8 b, f32x4 c) { return __builtin_amdgcn_mfma_f32_16x16x32_bf16(a, b, c, 0, 0, 0); }
constexpr int VT_LD = 136;
constexpr int KL_LD = 264;

__device__ __forceinline__ void chunk_gates(const float* GATES, int row0, int h, int lane, float& b0, float& b1, float& a0, float& a1) {
    const float i0 = ldgf(GATES + (size_t)(row0 + 2 * lane) * 8 + h), i1 = ldgf(GATES + (size_t)(row0 + 2 * lane + 1) * 8 + h);
    const float f0 = ldgf(GATES + (size_t)(row0 + 2 * lane) * 8 + 4 + h), f1 = ldgf(GATES + (size_t)(row0 + 2 * lane + 1) * 8 + 4 + h);
    float s = f0 + f1;
#pragma unroll
    for (int o = 1; o < 64; o <<= 1) { const float t = __shfl_up(s, o); if (lane >= o) s += t; }
    b1 = s; b0 = s - f1; a0 = i0 - b0; a1 = i1 - b1;
}

template <bool SCALE_W>
__device__ __forceinline__ void stage_T(const u16* src, LAS u16* T, const LAS float* w, int tid) {
    const int sp = tid & 63, s = 2 * sp;
#pragma unroll
    for (int i = 0; i < 4; ++i) {
        const int cc = (tid >> 6) + 8 * i;
        const u32x4 r0 = ldgu4(src + (size_t)s * MW + 8 * cc), r1 = ldgu4(src + (size_t)(s + 1) * MW + 8 * cc);
        float w0 = 1.f, w1 = 1.f; if (SCALE_W) { w0 = w[s]; w1 = w[s + 1]; }
#pragma unroll
        for (int e = 0; e < 4; ++e) {
            const unsigned x0 = r0[e], x1 = r1[e];
            unsigned lo, hi;
            if (SCALE_W) { lo = cvtpk(bflo(x0) * w0, bflo(x1) * w1); hi = cvtpk(bfhi(x0) * w0, bfhi(x1) * w1); }
            else { lo = (x0 & 0xffffu) | (x1 << 16); hi = (x0 >> 16) | (x1 & 0xffff0000u); }
            *(LAS unsigned*)(T + (size_t)(8 * cc + 2 * e) * VT_LD + s) = lo;
            *(LAS unsigned*)(T + (size_t)(8 * cc + 2 * e + 1) * VT_LD + s) = hi;
        }
    }
}

__device__ __forceinline__ void mlstm_A_unit(int unit, const u16* MK, const u16* MV, const float* GATES, u16* U, float* UN, float* CHS, LAS unsigned char* lds, int tid, int wave, int lane) {
    const int bh = unit >> 5, c = unit & 31, b = bh >> 2, h = bh & 3, row0 = b * TP + c * CH;
    LAS u16* VT = (LAS u16*)lds; LAS u16* KT = (LAS u16*)(lds + 256 * VT_LD * 2); LAS float* W = (LAS float*)(lds + 2 * 256 * VT_LD * 2);
    if (wave == 0) {
        float b0, b1, a0, a1; chunk_gates(GATES, row0, h, lane, b0, b1, a0, a1);
        const float G = wave_max(fmaxf(a0, a1)); const float A = __shfl(b1, 63);
        W[2 * lane] = __expf(a0 - G); W[2 * lane + 1] = __expf(a1 - G);
        if (lane == 0) { stgf(CHS + (size_t)(bh * NCH + c) * 2, A); stgf(CHS + (size_t)(bh * NCH + c) * 2 + 1, G); }
    }
    WG_BAR();
    stage_T<false>(MV + (size_t)row0 * MW + h * MD, VT, W, tid);
    stage_T<true>(MK + (size_t)row0 * MW + h * MD, KT, W, tid);
    WG_BAR();
    const int fr = lane & 15, fq = lane >> 4;
    u16* Uo = U + (size_t)(bh * NCH + c) * MD * MD;
#pragma unroll 1
    for (int vh = 0; vh < 2; ++vh) {
        f32x4 acc[2][8];
#pragma unroll
        for (int i = 0; i < 2; ++i)
#pragma unroll
            for (int j = 0; j < 8; ++j) acc[i][j] = (f32x4){0.f, 0.f, 0.f, 0.f};
#pragma unroll
        for (int ks = 0; ks < 4; ++ks) {
            bf16x8 af[2];
#pragma unroll
            for (int i = 0; i < 2; ++i) af[i] = *(const LAS bf16x8*)(KT + (size_t)(32 * wave + 16 * i + fr) * VT_LD + 32 * ks + 8 * fq);
#pragma unroll
            for (int j = 0; j < 8; ++j) { const bf16x8 bfr = *(const LAS bf16x8*)(VT + (size_t)(16 * (8 * vh + j) + fr) * VT_LD + 32 * ks + 8 * fq);
#pragma unroll
                for (int i = 0; i < 2; ++i) acc[i][j] = mfma16(af[i], bfr, acc[i][j]); }
        }
#pragma unroll
        for (int i = 0; i < 2; ++i)
#pragma unroll
            for (int j = 0; j < 8; ++j) { u32x2 w; w.x = cvtpk(acc[i][j][0], acc[i][j][1]); w.y = cvtpk(acc[i][j][2], acc[i][j][3]);
                stgu2(Uo + (size_t)(16 * (8 * vh + j) + fr) * MD + 32 * wave + 16 * i + 4 * fq, w); }
    }
    if (tid < 256) { float s = 0.f;
#pragma unroll
        for (int i = 0; i < 16; ++i) { const u32x4 x = *(const LAS u32x4*)(KT + (size_t)tid * VT_LD + 8 * i);
#pragma unroll
            for (int e = 0; e < 4; ++e) s += bflo(x[e]) + bfhi(x[e]); }
        stgf(UN + (size_t)(bh * NCH + c) * MD + tid, s); }
    WG_BAR();
}

__device__ __forceinline__ void mlstm_B(int gid, int gstride, const u16* U, const float* UN, const float* CHS, u16* CST, float* NST, float* MST, float* Cout, float* nout, float* mout) {
    for (int g = gid; g < 8 * 16384 + 8 * 64; g += gstride) {
        if (g < 8 * 16384) {
            const int bh = g >> 14, e = (g & 16383) * 4;
            float m = 0.f; f32x4 C = (f32x4){0.f, 0.f, 0.f, 0.f};
#pragma unroll 8
            for (int c = 0; c < NCH; ++c) {
                const float A = ldgf(CHS + (size_t)(bh * NCH + c) * 2), G = ldgf(CHS + (size_t)(bh * NCH + c) * 2 + 1);
                const float M = fmaxf(m, G), sC = __expf(m - M), sU = __expf(G - M);
                const size_t off = (size_t)(bh * NCH + c) * MD * MD + e;
                u32x2 w; w.x = cvtpk(C[0], C[1]); w.y = cvtpk(C[2], C[3]); stgu2(CST + off, w);
                if (e == 0) stgf(MST + bh * 33 + c, m);
                const u32x2 u = ldgu2(U + off);
                C[0] = sC * C[0] + sU * bflo(u.x); C[1] = sC * C[1] + sU * bfhi(u.x); C[2] = sC * C[2] + sU * bflo(u.y); C[3] = sC * C[3] + sU * bfhi(u.y);
                m = A + M;
            }
            stg4(Cout + (size_t)bh * MD * MD + e, C);
            if (e == 0) { stgf(mout + bh, m); stgf(MST + bh * 33 + 32, m); }
        } else {
            const int g2 = g - 8 * 16384, bh = g2 >> 6, e = (g2 & 63) * 4;
            float m = 0.f; f32x4 N = (f32x4){0.f, 0.f, 0.f, 0.f};
            for (int c = 0; c < NCH; ++c) {
                const float A = ldgf(CHS + (size_t)(bh * NCH + c) * 2), G = ldgf(CHS + (size_t)(bh * NCH + c) * 2 + 1);
                const float M = fmaxf(m, G), sC = __expf(m - M), sU = __expf(G - M);
                const size_t off = (size_t)(bh * NCH + c) * MD + e;
                stg4(NST + off, N);
                const f32x4 u = ldg4(UN + off);
                N = sC * N + sU * u; m = A + M;
            }
            stg4(nout + (size_t)bh * MD + e, N);
        }
    }
}

constexpr int CL_LD = 264;
__device__ __forceinline__ void mlstm_C_unit(int unit, const u16* MQ, const u16* MK, const u16* MV, const u16* MO, const float* GATES, const u16* CST, const float* NST, const float* MST,
                                             const float* gm, u16* MIX, LAS unsigned char* lds, int tid, int wave, int lane) {
    const int bh = unit >> 5, c = unit & 31, b = bh >> 2, h = bh & 3, row0 = b * TP + c * CH;
    LAS u16* CL = (LAS u16*)lds; LAS u16* KL = (LAS u16*)lds; LAS u16* VT = (LAS u16*)(lds + 128 * KL_LD * 2);
    LAS float* AS = (LAS float*)(lds + 128 * KL_LD * 2 + 256 * VT_LD * 2); LAS float* MTt = AS + 128; LAS float* INTER = AS + 256; LAS float* EMT = AS + 384;
    static_assert(256 * CL_LD * 2 <= 128 * KL_LD * 2 + 256 * VT_LD * 2, "state image below the gate tables");
    if (wave == 0) {
        float b0, b1, a0, a1; chunk_gates(GATES, row0, h, lane, b0, b1, a0, a1);
        const float mc = ldgf(MST + bh * 33 + c);
        float pm = fmaxf(a0, a1);
#pragma unroll
        for (int o = 1; o < 64; o <<= 1) { const float t = __shfl_up(pm, o); if (lane >= o) pm = fmaxf(pm, t); }
        float pprev = __shfl_up(pm, 1); if (lane == 0) pprev = -__builtin_inff();
        const float p0 = fmaxf(pprev, a0), p1 = pm;
        const float M0 = fmaxf(mc, p0), M1 = fmaxf(mc, p1);
        AS[2 * lane] = a0; AS[2 * lane + 1] = a1; MTt[2 * lane] = M0; MTt[2 * lane + 1] = M1;
        INTER[2 * lane] = __expf(mc - M0); INTER[2 * lane + 1] = __expf(mc - M1);
        EMT[2 * lane] = __expf(-(b0 + M0)); EMT[2 * lane + 1] = __expf(-(b1 + M1));
    }
    { const u16* csrc = CST + (size_t)(bh * NCH + c) * MD * MD;
#pragma unroll
      for (int i = 0; i < 16; ++i) { const int q = tid + 512 * i, v = q >> 5, cc = q & 31;
          *(LAS u32x4*)(CL + (size_t)v * CL_LD + 8 * cc) = ldgu4(csrc + (size_t)v * MD + 8 * cc); } }
    const int fr = lane & 15, fq = lane >> 4, t = 16 * wave + fr;
    bf16x8 qf[8];
    { const u16* qrow = MQ + (size_t)(row0 + t) * MW + h * MD + 8 * fq;
#pragma unroll
      for (int ks = 0; ks < 8; ++ks) qf[ks] = __builtin_bit_cast(bf16x8, ldgu4(qrow + 32 * ks)); }
    float nq = 0.f;
    { const float* np = NST + (size_t)(bh * NCH + c) * MD + 8 * fq;
#pragma unroll
      for (int ks = 0; ks < 8; ++ks) { const f32x4 n0 = ldg4(np + 32 * ks), n1 = ldg4(np + 32 * ks + 4); const u32x4 qw = __builtin_bit_cast(u32x4, qf[ks]);
          nq += n0[0] * bflo(qw.x) + n0[1] * bfhi(qw.x) + n0[2] * bflo(qw.y) + n0[3] * bfhi(qw.y) + n1[0] * bflo(qw.z) + n1[1] * bfhi(qw.z) + n1[2] * bflo(qw.w) + n1[3] * bfhi(qw.w); }
      nq += __shfl_xor(nq, 16); nq += __shfl_xor(nq, 32); }
    WG_BAR();
    f32x4 acc[16];
#pragma unroll
    for (int j = 0; j < 16; ++j) acc[j] = (f32x4){0.f, 0.f, 0.f, 0.f};
#pragma unroll
    for (int j = 0; j < 16; ++j)
#pragma unroll
        for (int ks = 0; ks < 8; ++ks) acc[j] = mfma16(*(const LAS bf16x8*)(CL + (size_t)(16 * j + fr) * CL_LD + 32 * ks + 8 * fq), qf[ks], acc[j]);
    const float inter = INTER[t], Mt = MTt[t];
#pragma unroll
    for (int j = 0; j < 16; ++j) acc[j] = acc[j] * inter;
    WG_BAR();
    { const u16* ksrc = MK + (size_t)row0 * MW + h * MD;
#pragma unroll
      for (int i = 0; i < 8; ++i) { const int q = tid + 512 * i, s = q >> 5, cc = q & 31;
          *(LAS u32x4*)(KL + (size_t)s * KL_LD + 8 * cc) = ldgu4(ksrc + (size_t)s * MW + 8 * cc); } }
    stage_T<false>(MV + (size_t)row0 * MW + h * MD, VT, nullptr, tid);
    WG_BAR();
    float den = 0.f;
    for (int kk = 0; 2 * kk <= wave; ++kk) {
        f32x4 st[2];
#pragma unroll
        for (int i = 0; i < 2; ++i) { st[i] = (f32x4){0.f, 0.f, 0.f, 0.f}; const int sb = 2 * kk + i;
            if (sb <= wave) {
#pragma unroll
                for (int ks = 0; ks < 8; ++ks) st[i] = mfma16(*(const LAS bf16x8*)(KL + (size_t)(16 * sb + fr) * KL_LD + 32 * ks + 8 * fq), qf[ks], st[i]);
#pragma unroll
                for (int r = 0; r < 4; ++r) { const int s = 16 * sb + 4 * fq + r; const float wgt = (s <= t) ? __expf(AS[s] - Mt) : 0.f; st[i][r] *= wgt; den += st[i][r]; }
            } }
        u32x4 pw; pw.x = cvtpk(st[0][0], st[0][1]); pw.y = cvtpk(st[0][2], st[0][3]); pw.z = cvtpk(st[1][0], st[1][1]); pw.w = cvtpk(st[1][2], st[1][3]);
        const bf16x8 pf = __builtin_bit_cast(bf16x8, pw);
#pragma unroll
        for (int j = 0; j < 16; ++j) { const LAS u16* vp = VT + (size_t)(16 * j + fr) * VT_LD + 32 * kk + 4 * fq;
            const u32x2 lo = *(const LAS u32x2*)vp, hi = *(const LAS u32x2*)(vp + 16); u32x4 aw; aw.x = lo.x; aw.y = lo.y; aw.z = hi.x; aw.w = hi.y;
            acc[j] = mfma16(__builtin_bit_cast(bf16x8, aw), pf, acc[j]); }
    }
    den += __shfl_xor(den, 16); den += __shfl_xor(den, 32);
    den += inter * nq;
    const float idn = 1.0f / fmaxf(fabsf(den), EMT[t]);
    float ss = 0.f;
#pragma unroll
    for (int j = 0; j < 16; ++j) { acc[j] = acc[j] * idn; ss += dot4(acc[j], acc[j]); }
    ss += __shfl_xor(ss, 16); ss += __shfl_xor(ss, 32);
    const float rs = 1.0f / sqrtf(ss * (1.0f / MD) + EPS);
    const u16* op = MO + (size_t)(row0 + t) * MW + h * MD + 4 * fq; u16* mp = MIX + (size_t)(row0 + t) * DM + h * MD + 4 * fq; const float* gp = gm + h * MD + 4 * fq;
#pragma unroll
    for (int j = 0; j < 16; ++j) { const u32x2 ow = ldgu2(op + 16 * j); const f32x4 gv = ldg4(gp + 16 * j);
        const float o0 = sigmoidf_(bflo(ow.x)), o1 = sigmoidf_(bfhi(ow.x)), o2 = sigmoidf_(bflo(ow.y)), o3 = sigmoidf_(bfhi(ow.y));
        u32x2 w; w.x = cvtpk(acc[j][0] * rs * gv[0] * o0, acc[j][1] * rs * gv[1] * o1); w.y = cvtpk(acc[j][2] * rs * gv[2] * o2, acc[j][3] * rs * gv[3] * o3);
        stgu2(mp + 16 * j, w); }
    WG_BAR();
}

__device__ __forceinline__ void transpose_item(const float* W, int K, int Nsrc, u16* WT, int k0, int n0, int sc0, LAS float* scr, int lane) {
#pragma unroll 8
    for (int i = 0; i < 32; ++i) { const int kk = 2 * i + (lane >> 5); scr[kk * 33 + (lane & 31)] = ldgf(W + (size_t)(k0 + kk) * Nsrc + sc0 + (lane & 31)); }
    LDS_WAIT(); asm volatile("" ::: "memory");
    const int c = lane & 7;
#pragma unroll
    for (int j = 0; j < 4; ++j) { const int n = (lane >> 3) + 8 * j; const LAS float* s = scr + (8 * c) * 33 + n;
        u32x4 o; o.x = cvtpk(s[0 * 33], s[1 * 33]); o.y = cvtpk(s[2 * 33], s[3 * 33]); o.z = cvtpk(s[4 * 33], s[5 * 33]); o.w = cvtpk(s[6 * 33], s[7 * 33]);
        stgu4(WT + (size_t)(n0 + n) * K + k0 + 8 * c, o); }
    LDS_WAIT(); asm volatile("" ::: "memory");
}
__device__ __forceinline__ int win_src_col(int n) {
    if (n < 4096) return n;
    const int a = n - 4096, sec = a >> 10, r = a & 1023, pt = r >> 8, tc = r & 255;
    return 4104 + sec * 1024 + (pt * 2 + ((tc >> 6) & 1)) * 128 + (tc >> 7) * 64 + (tc & 63);
}
__device__ __forceinline__ int wup_src_col(int n) { const int pn = n >> 8, tc = n & 255; return tc < 128 ? pn * 128 + tc : DFF + pn * 128 + (tc - 128); }

__device__ __forceinline__ void sincos_d(double a, float& s, float& c) {
    const double n = __builtin_rint(a * 0.15915494309189535);
    double r = __builtin_fma(-n, 6.283185307179586, a); r = __builtin_fma(-n, 2.4492935982947064e-16, r);
    const double r2 = r * r; double ts = 1.0, ss = 1.0, tc = 1.0, cs = 1.0;
#pragma unroll
    for (int k = 1; k <= 14; ++k) { tc *= -r2 * (1.0 / ((2.0 * k - 1.0) * (2.0 * k))); cs += tc; ts *= -r2 * (1.0 / ((2.0 * k) * (2.0 * k + 1.0))); ss += ts; }
    s = (float)(r * ss); c = (float)cs;
}

__device__ __forceinline__ void norm1_row(const float* xrow, u16* orow, float* grow, const LAS float* GW, const LAS float* G1, const float* bg, int lane) {
    f32x4 v[8]; float s = 0.f, ga[8];
#pragma unroll
    for (int j = 0; j < 8; ++j) ga[j] = 0.f;
#pragma unroll
    for (int i = 0; i < 8; ++i) { v[i] = ldg4(xrow + 256 * i + 4 * lane); s += dot4(v[i], v[i]);
#pragma unroll
        for (int j = 0; j < 8; ++j) ga[j] += dot4(v[i], *(const LAS f32x4*)(GW + j * DM + 256 * i + 4 * lane));
        asm volatile("" ::: "memory"); }
    s = wave_sum(s); const float rstd = 1.0f / sqrtf(s * (1.0f / DM) + EPS);
#pragma unroll
    for (int j = 0; j < 8; ++j) ga[j] = wave_sum(ga[j]) * rstd;
#pragma unroll
    for (int i = 0; i < 8; ++i) { const f32x4 g = *(const LAS f32x4*)(G1 + 256 * i + 4 * lane); u32x2 w; w.x = cvtpk(v[i][0] * rstd * g[0], v[i][1] * rstd * g[1]); w.y = cvtpk(v[i][2] * rstd * g[2], v[i][3] * rstd * g[3]);
        stgu2(orow + 256 * i + 4 * lane, w); }
    if (lane < 8) { float z = 0.f;
#pragma unroll
        for (int j = 0; j < 8; ++j) z = (lane == j) ? ga[j] : z;
        z += ldgf(bg + lane);
        if (lane >= 4) z = fminf(z, 0.f) - log1pf(__expf(-fabsf(z)));
        stgf(grow + lane, z); }
}

__device__ __forceinline__ void kmean_prompt_unit(int unit, const u16* AK, float* KM, LAS unsigned char* lds, int tid) {
    const u16* src = AK + (size_t)unit * 256 * AD;
    const int cc = tid & 15, rg = tid >> 4; f32x4 s0 = {0.f, 0.f, 0.f, 0.f}, s1 = s0;
#pragma unroll
    for (int i = 0; i < 8; ++i) { const u32x4 x = ldgu4(src + (size_t)(rg * 8 + i) * AD + 8 * cc);
        s0[0] += bflo(x.x); s0[1] += bfhi(x.x); s0[2] += bflo(x.y); s0[3] += bfhi(x.y); s1[0] += bflo(x.z); s1[1] += bfhi(x.z); s1[2] += bflo(x.w); s1[3] += bfhi(x.w); }
    LAS float* R = (LAS float*)lds;
    *(LAS f32x4*)(R + (rg * 16 + cc) * 8) = s0; *(LAS f32x4*)(R + (rg * 16 + cc) * 8 + 4) = s1;
    WG_BAR();
    if (tid < 128) { float s = 0.f;
#pragma unroll
        for (int g = 0; g < 32; ++g) s += R[(g * 16 + (tid >> 3)) * 8 + (tid & 7)];
        stgf(KM + (size_t)unit * AD + tid, s * (1.0f / 256.0f)); }
    WG_BAR();
}

__device__ __forceinline__ void kmean_sample_unit(int unit, const float* cache_k, const int* page_table, float* KMS, LAS unsigned char* lds, int tid) {
    const int b = unit >> 6, n = unit & 63, c4 = tid & 255, rh = tid >> 8;
    f32x4 s = {0.f, 0.f, 0.f, 0.f};
#pragma unroll
    for (int pg = 0; pg < 2; ++pg) {
        const int page = *(const GAS int*)(page_table + b * NPAGES + 2 * n + pg);
        const float* base = cache_k + (size_t)page * PAGE * AW + (size_t)rh * AW + 4 * c4;
#pragma unroll 16
        for (int r = 0; r < 64; ++r) s = s + ldg4(base + (size_t)(2 * r) * AW);
    }
    LAS float* R = (LAS float*)lds;
    if (rh == 1) *(LAS f32x4*)(R + 4 * c4) = s;
    WG_BAR();
    if (rh == 0) { s = s + *(LAS f32x4*)(R + 4 * c4); s = s * (1.0f / 256.0f); const int h = c4 >> 5, d = (c4 & 31) * 4;
        stg4(KMS + ((size_t)(b * AH + h) * NBS + n) * AD + d, s); }
    WG_BAR();
}

__device__ __forceinline__ void skinny_unit(const u16* A, const u16* Bt, int K, int ca, int cb, LAS unsigned char* lds, int tid, int wave, int lane) {
    const int fr = lane & 15, fq = lane >> 4, kw = K >> 3, k0 = wave * kw;
    f32x4 acc[4][2];
#pragma unroll
    for (int i = 0; i < 4; ++i) { acc[i][0] = (f32x4){0.f, 0.f, 0.f, 0.f}; acc[i][1] = acc[i][0]; }
    const u16* ap = A + (size_t)fr * K + k0 + 8 * fq; const u16* bpa = Bt + (size_t)(ca + fr) * K + k0 + 8 * fq; const u16* bpb = Bt + (size_t)(cb + fr) * K + k0 + 8 * fq;
#pragma unroll 2
    for (int ks = 0; ks < kw; ks += 32) {
        const bf16x8 b0 = __builtin_bit_cast(bf16x8, ldgu4(bpa + ks)), b1 = __builtin_bit_cast(bf16x8, ldgu4(bpb + ks));
#pragma unroll
        for (int mb = 0; mb < 4; ++mb) { const bf16x8 a = __builtin_bit_cast(bf16x8, ldgu4(ap + (size_t)(16 * mb) * K + ks));
            acc[mb][0] = mfma16(a, b0, acc[mb][0]); acc[mb][1] = mfma16(a, b1, acc[mb][1]); }
    }
    LAS float* red = (LAS float*)lds + wave * 2048;
#pragma unroll
    for (int mb = 0; mb < 4; ++mb)
#pragma unroll
        for (int cbk = 0; cbk < 2; ++cbk)
#pragma unroll
            for (int r = 0; r < 4; ++r) red[(16 * mb + 4 * fq + r) * 32 + 16 * cbk + fr] = acc[mb][cbk][r];
    WG_BAR();
    f32x4 s = {0.f, 0.f, 0.f, 0.f};
#pragma unroll
    for (int w = 0; w < 8; ++w) s = s + *(const LAS f32x4*)((LAS float*)lds + w * 2048 + 4 * tid);
    *(LAS f32x4*)((LAS float*)(lds + 65536) + 4 * tid) = s;
    WG_BAR();
}

__device__ __forceinline__ void sample_select_unit(int unit, const float* QS, const float* KMS, int* SEL, LAS unsigned char* lds, int tid) {
    const int b = unit >> 3, h = unit & 7, q = tid >> 6, n = tid & 63;
    const float* qp = QS + ((size_t)(b * TS + q) * AH + h) * AD; const float* kp = KMS + ((size_t)(b * AH + h) * NBS + n) * AD;
    float s = 0.f;
#pragma unroll 8
    for (int d = 0; d < AD; d += 4) s += dot4(ldg4(qp + d), ldg4(kp + d));
    LAS float* SC = (LAS float*)lds; SC[q * 64 + n] = s;
    WG_BAR();
    if (tid < 8) { float b0 = -__builtin_inff(), b1 = b0, b2 = b0; int i0 = 0, i1 = 0, i2 = 0;
        for (int j = 0; j < 64; ++j) { const float v = SC[tid * 64 + j];
            if (v > b0) { b2 = b1; i2 = i1; b1 = b0; i1 = i0; b0 = v; i0 = j; } else if (v > b1) { b2 = b1; i2 = i1; b1 = v; i1 = j; } else if (v > b2) { b2 = v; i2 = j; } }
        int* o = SEL + ((size_t)(b * TS + tid) * AH + h) * 4; *(GAS int*)o = i0; *(GAS int*)(o + 1) = i1; *(GAS int*)(o + 2) = i2; }
    WG_BAR();
}
__device__ __forceinline__ void sample_attend_unit(int unit, const float* QS, const float* KSN, const float* VSN, const float* cache_k, const float* cache_v, const int* page_table, const int* SEL,
                                                   u16* MIX, LAS unsigned char* lds, int tid, int wave, int lane) {
    const int b = unit >> 6, q = (unit >> 3) & 7, h = unit & 7, row = b * TS + q;
    LAS float* SC = (LAS float*)lds;
    LAS float* RED = SC + 800;
    LAS float* WR = RED + 2048;
    const int* sp = SEL + ((size_t)row * AH + h) * 4;
    int pages[6];
#pragma unroll
    for (int s = 0; s < 3; ++s) { const int blk = *(const GAS int*)(sp + s); pages[2 * s] = *(const GAS int*)(page_table + b * NPAGES + 2 * blk); pages[2 * s + 1] = *(const GAS int*)(page_table + b * NPAGES + 2 * blk + 1); }
    const float* qp = QS + ((size_t)row * AH + h) * AD;
    const int sub = lane & 15, kq = lane >> 4;
    const f32x4 q0 = ldg4(qp + 8 * sub), q1 = ldg4(qp + 8 * sub + 4);
#pragma unroll 12
    for (int it = 0; it < 24; ++it) {
        const int k = it * 32 + wave * 4 + kq, pg = k >> 7, pp = k & 127;
        int page = pages[0];
#pragma unroll
        for (int s = 1; s < 6; ++s) page = (pg == s) ? pages[s] : page;
        const float* kp = cache_k + ((size_t)page * PAGE + pp) * AW + h * AD + 8 * sub;
        float d = dot4(ldg4(kp), q0) + dot4(ldg4(kp + 4), q1);
        d += __shfl_xor(d, 1); d += __shfl_xor(d, 2); d += __shfl_xor(d, 4); d += __shfl_xor(d, 8);
        if (sub == 0) SC[k] = d * ATT_SCALE;
    }
    if (wave == 0 && kq <= q && kq < 4) { const float* kp = KSN + ((size_t)(b * TS + kq) * AH + h) * AD + 8 * sub; float d = dot4(ldg4(kp), q0) + dot4(ldg4(kp + 4), q1);
        d += __shfl_xor(d, 1); d += __shfl_xor(d, 2); d += __shfl_xor(d, 4); d += __shfl_xor(d, 8); if (sub == 0) SC[768 + kq] = d * ATT_SCALE; }
    if (wave == 1 && kq + 4 <= q) { const float* kp = KSN + ((size_t)(b * TS + kq + 4) * AH + h) * AD + 8 * sub; float d = dot4(ldg4(kp), q0) + dot4(ldg4(kp + 4), q1);
        d += __shfl_xor(d, 1); d += __shfl_xor(d, 2); d += __shfl_xor(d, 4); d += __shfl_xor(d, 8); if (sub == 0) SC[768 + kq + 4] = d * ATT_SCALE; }
    WG_BAR();
    const int nk = 768 + q + 1;
    float mx = -__builtin_inff();
    for (int k = tid; k < nk; k += 512) mx = fmaxf(mx, SC[k]);
    mx = wave_max(mx); if (lane == 0) WR[wave] = mx;
    WG_BAR();
    mx = WR[0];
#pragma unroll
    for (int w = 1; w < 8; ++w) mx = fmaxf(mx, WR[w]);
    float sm = 0.f;
    for (int k = tid; k < nk; k += 512) { const float p = __expf(SC[k] - mx); SC[k] = p; sm += p; }
    sm = wave_sum(sm); if (lane == 0) WR[8 + wave] = sm;
    WG_BAR();
    sm = 0.f;
#pragma unroll
    for (int w = 0; w < 8; ++w) sm += WR[8 + w];
    const float isum = 1.0f / sm;
    const int d4 = tid & 31, g = tid >> 5; f32x4 o = {0.f, 0.f, 0.f, 0.f};
#pragma unroll 16
    for (int it = 0; it < 48; ++it) { const int k = it * 16 + g, pg = k >> 7, pp = k & 127;
        int page = pages[0];
#pragma unroll
        for (int s = 1; s < 6; ++s) page = (pg == s) ? pages[s] : page;
        o = o + ldg4(cache_v + ((size_t)page * PAGE + pp) * AW + h * AD + 4 * d4) * SC[k]; }
    if (g <= q && g < 8) o = o + ldg4(VSN + ((size_t)(b * TS + g) * AH + h) * AD + 4 * d4) * SC[768 + g];
    *(LAS f32x4*)(RED + g * 128 + 4 * d4) = o;
    WG_BAR();
    if (tid < 128) { float s = 0.f;
#pragma unroll
        for (int gg = 0; gg < 16; ++gg) s += RED[gg * 128 + tid];
        *(GAS u16*)(MIX + (size_t)(MP + row) * DM + MW + h * AD + tid) = (u16)f2bf(s * isum); }
    WG_BAR();
}

__device__ __forceinline__ void sample_mlstm_unit(int unit, const float* QKVO  , const float* GATES, const float* C0, const float* n0, const float* m0, const float* gm,
                                                  float* Cout, float* nout, float* mout, u16* MIX, LAS unsigned char* lds, int tid, int wave, int lane) {
    const int b = unit >> 2, h = unit & 3, r0 = b * TS;
    LAS float* QL = (LAS float*)lds; LAS float* KL = QL + 2048; LAS float* VL = KL + 2048; LAS float* CQ = VL + 2048; LAS float* HS = CQ + 2048;
    LAS float* SP = HS + 2048;
    LAS float* SCL = SP + 64;
    for (int i = tid; i < 2048; i += 512) { const int t = i >> 8, d = i & 255; const float* rp = QKVO + (size_t)(r0 + t) * 4096 + h * MD + d;
        QL[i] = ldgf(rp); KL[i] = ldgf(rp + 1024) * 0.0625f; VL[i] = ldgf(rp + 2048); }
    if (tid < 8) {
        const float mp = ldgf(m0 + b * MH + h); float bc = 0.f, pm = -__builtin_inff(); float a_[8], M_[8], b_[8];
#pragma unroll
        for (int t = 0; t < 8; ++t) { const float ig = ldgf(GATES + (size_t)(MP + r0 + t) * 8 + h), lf = ldgf(GATES + (size_t)(MP + r0 + t) * 8 + 4 + h);
            bc += lf; b_[t] = bc; a_[t] = ig - bc; pm = fmaxf(pm, a_[t]); M_[t] = fmaxf(mp, pm); }
        const int t = tid;
        float at = 0.f, Mt = 0.f, bt = 0.f;
#pragma unroll
        for (int j = 0; j < 8; ++j) { at = (j == t) ? a_[j] : at; Mt = (j == t) ? M_[j] : Mt; bt = (j == t) ? b_[j] : bt; }
        SCL[t] = at; SCL[8 + t] = Mt; SCL[16 + t] = __expf(mp - Mt); SCL[24 + t] = __expf(-(bt + Mt)); SCL[32 + t] = __expf(at - M_[7]);
        if (t == 0) { SCL[64] = __expf(mp - M_[7]); SCL[65] = b_[7] + M_[7]; }
    }
    WG_BAR();
    if (tid < 64) { const int t = tid >> 3, s = tid & 7; float d = 0.f;
        for (int i = 0; i < 256; ++i) d += QL[t * 256 + i] * KL[s * 256 + i];
        SP[tid] = (s <= t) ? d * __expf(SCL[s] - SCL[8 + t]) : 0.f; }
    else if (tid < 72) { const int t = tid - 64; float d = 0.f;
        for (int i = 0; i < 256; ++i) d += QL[t * 256 + i] * ldgf(n0 + (size_t)(b * MH + h) * MD + i);
        SCL[48 + t] = d; }
    WG_BAR();
    { f32x4 qv[8], kv[8];
#pragma unroll
      for (int t = 0; t < 8; ++t) { qv[t] = *(const LAS f32x4*)(QL + t * 256 + 4 * lane); kv[t] = *(const LAS f32x4*)(KL + t * 256 + 4 * lane); }
      const float decay = SCL[64];
      const float* Cb = C0 + (size_t)(b * MH + h) * MD * MD; float* Co = Cout + (size_t)(b * MH + h) * MD * MD;
      for (int i0 = 0; i0 < 32; i0 += 4) { f32x4 cr[4];
#pragma unroll
        for (int u = 0; u < 4; ++u) cr[u] = ldg4(Cb + (size_t)(wave + 8 * (i0 + u)) * MD + 4 * lane);
#pragma unroll
        for (int u = 0; u < 4; ++u) { const int v = wave + 8 * (i0 + u);
          const f32x4 c4 = cr[u]; f32x4 nc = c4 * decay; float part[8];
#pragma unroll
          for (int t = 0; t < 8; ++t) { part[t] = dot4(c4, qv[t]); nc = nc + kv[t] * (SCL[32 + t] * VL[t * 256 + v]); }
          stg4(Co + (size_t)v * MD + 4 * lane, nc);
          float p4[4], p2[2], p1;
          { const bool up = (lane & 32) != 0;
#pragma unroll
            for (int t = 0; t < 4; ++t) { const float keep = up ? part[4 + t] : part[t], send = up ? part[t] : part[4 + t]; p4[t] = keep + __shfl_xor(send, 32); } }
          { const bool up = (lane & 16) != 0;
#pragma unroll
            for (int t = 0; t < 2; ++t) { const float keep = up ? p4[2 + t] : p4[t], send = up ? p4[t] : p4[2 + t]; p2[t] = keep + __shfl_xor(send, 16); } }
          { const bool up = (lane & 8) != 0; const float keep = up ? p2[1] : p2[0], send = up ? p2[0] : p2[1]; p1 = keep + __shfl_xor(send, 8); }
          p1 += __shfl_xor(p1, 4); p1 += __shfl_xor(p1, 2); p1 += __shfl_xor(p1, 1);
          if ((lane & 7) == 0) CQ[(lane >> 3) * 256 + v] = p1; } } }
    if (tid < 256) { const int d = tid; float nn = SCL[64] * ldgf(n0 + (size_t)(b * MH + h) * MD + d);
        for (int s = 0; s < 8; ++s) nn += SCL[32 + s] * KL[s * 256 + d];
        stgf(nout + (size_t)(b * MH + h) * MD + d, nn); }
    if (tid == 0) stgf(mout + b * MH + h, SCL[65]);
    WG_BAR();
    { const int v = tid & 255, th = tid >> 8;
#pragma unroll
      for (int i = 0; i < 4; ++i) { const int t = th + 2 * i; float num = SCL[16 + t] * CQ[t * 256 + v], den = SCL[16 + t] * SCL[48 + t];
          for (int s = 0; s <= t; ++s) { num += SP[t * 8 + s] * VL[s * 256 + v]; den += SP[t * 8 + s]; }
          HS[t * 256 + v] = num / fmaxf(fabsf(den), SCL[24 + t]); } }
    WG_BAR();
    { float ss = 0.f;
#pragma unroll
      for (int i = 0; i < 4; ++i) { const float x = HS[wave * 256 + lane + 64 * i]; ss += x * x; }
      ss = wave_sum(ss); if (lane == 0) SCL[56 + wave] = 1.0f / sqrtf(ss * (1.0f / MD) + EPS); }
    WG_BAR();
    { const int v = tid & 255, th = tid >> 8;
#pragma unroll
      for (int i = 0; i < 4; ++i) { const int t = th + 2 * i; const float o = ldgf(QKVO + (size_t)(r0 + t) * 4096 + 3072 + h * MD + v);
          const float y = HS[t * 256 + v] * SCL[56 + t] * ldgf(gm + h * MD + v) * sigmoidf_(o);
          *(GAS u16*)(MIX + (size_t)(MP + r0 + t) * DM + h * MD + v) = (u16)f2bf(y); } }
    WG_BAR();
}

constexpr int NWAVES = 8, NTHREADS = 512;
#ifndef MK_N_LAUNCHES
#define MK_N_LAUNCHES 1
#endif
constexpr int N_PHASES = 9;
constexpr size_t MiB = 1u << 20;
constexpr size_t WS_CTL = 0, CTL_ZERO_BYTES = 1 * MiB;
constexpr size_t WS_WIN = 2 * MiB, WS_WOUT = 30 * MiB, WS_WUP = 38 * MiB, WS_WDN = 82 * MiB, WS_ROPE = 104 * MiB, WS_GATES = 108 * MiB, WS_XN = 109 * MiB;
constexpr size_t WS_MQ = 142 * MiB, WS_MK = 158 * MiB, WS_MV = 174 * MiB, WS_MO = 190 * MiB, WS_AQ = 206 * MiB, WS_AK = 222 * MiB, WS_AV = 238 * MiB;
constexpr size_t WS_U = 254 * MiB, WS_CST = 286 * MiB, WS_SMALL = 318 * MiB, WS_MIXED = 334 * MiB, WS_X1 = 367 * MiB, WS_X1G = 433 * MiB, WS_SS = 466 * MiB;
constexpr size_t WS_ACT = 470 * MiB, WS_UB = 561 * MiB, WS_PART = 567 * MiB, WS_END = 585 * MiB;
constexpr size_t SM_CHS = 0, SM_MST = 64 * 1024, SM_KMP = 128 * 1024, SM_UN = 256 * 1024, SM_NST = 512 * 1024, SM_QKVO = 1 * MiB, SM_KMS = 2 * MiB, SM_QS = 4 * MiB,
                 SM_KSN = 4 * MiB + 256 * 1024, SM_VSN = 4 * MiB + 512 * 1024, SM_SEL = 4 * MiB + 768 * 1024, SM_SSS1 = 4 * MiB + 800 * 1024, SM_SSS2 = 4 * MiB + 832 * 1024;
constexpr int CW_TMO = 0, CW_BAR = 4096, CW_UPCNT = 8192, CW_AFLAG = 16384;
constexpr int RING_BYTES = 131072, XCH_OFF = 131072, MISC_OFF = 163840 - 256, LDS_BYTES = 163840;
constexpr int SELT_OFF = 67584, KML_OFF = 69632;

#define RLX_AGENT __ATOMIC_RELAXED, __HIP_MEMORY_SCOPE_AGENT
static_assert(WS_MK - WS_MQ == 16 * MiB && WS_MV - WS_MK == 16 * MiB && WS_MO - WS_MV == 16 * MiB && WS_AK - WS_AQ == 16 * MiB && WS_AV - WS_AK == 16 * MiB, "EpiIn's section strides");
static_assert(SM_KSN - SM_QS == 256 * 1024 && SM_VSN - SM_KSN == 256 * 1024 && O_VP - O_KP == (size_t)MP * AW && O_VS - O_KS == (size_t)MS * AW, "skinny_epi_in's section strides");
#define XB_TMO      128
#define XB_XCNT(j)  (256  + 64 * (j))
#define XB_XSUB(j)  (1280 + 64 * (j))
#define XB_XGEN(j)  (2304 + 64 * (j))
#define XB_TOP      3328
#define XB_TOPGEN   3392
#define XCD_BAR_WORDS 3456
#define XB_SPIN_CAP (1u << 18)

__device__ __forceinline__ unsigned xb_ld(unsigned* p)              { return __hip_atomic_load(p, __ATOMIC_RELAXED, __HIP_MEMORY_SCOPE_AGENT); }
__device__ __forceinline__ unsigned xb_add(unsigned* p, unsigned v) { return __hip_atomic_fetch_add(p, v, __ATOMIC_RELAXED, __HIP_MEMORY_SCOPE_AGENT); }
__device__ __forceinline__ unsigned xb_xcc_id() { return (unsigned)__builtin_amdgcn_s_getreg((3 << 11) | 20) & 0xFu; }
#define XB_SPIN(cond, bar) do { unsigned _sp = 0; while (cond) { __builtin_amdgcn_s_sleep(1); \
    if ((++_sp & 255u) == 0u) { if (xb_ld(&(bar)[XB_TMO])) break; if (_sp > XB_SPIN_CAP) { atomicAdd(&(bar)[XB_TMO], 1u); break; } } } } while (0)

struct XcdBarrier {
    unsigned* bar; unsigned x;
    volatile LAS unsigned* st;
};

__device__ __forceinline__ XcdBarrier xcd_barrier_post(unsigned* bar, volatile LAS unsigned* st, int xb_tid) {
    XcdBarrier b; b.bar = bar; b.x = xb_xcc_id(); b.st = st;
    if (xb_tid == 0) (void)xb_add(&bar[XB_XCNT(b.x)], 1u);
    return b;
}
__device__ __forceinline__ void xcd_barrier_complete(unsigned* bar, unsigned x, unsigned& nloc, unsigned& nx) {
    const unsigned G = gridDim.x * gridDim.y * gridDim.z;
    unsigned sum, cnt, mine, sp = 0u;
    for (;;) {
        sum = 0u; cnt = 0u; mine = 0u;
#pragma unroll
        for (unsigned j = 0; j < 16; ++j) { const unsigned c = xb_ld(&bar[XB_XCNT(j)]); sum += c; cnt += (c > 0u) ? 1u : 0u; mine = (j == x) ? c : mine; }
        if (sum == G) break;
        __builtin_amdgcn_s_sleep(1);
        if ((++sp & 255u) == 0u) { if (xb_ld(&bar[XB_TMO])) break; if (sp > XB_SPIN_CAP) { atomicAdd(&bar[XB_TMO], 1u); break; } }
    }
    nloc = mine > 0u ? mine : 1u; nx = cnt > 0u ? cnt : 1u;
}

__device__ __forceinline__ void xcd_barrier(const XcdBarrier& b, int xb_tid) {
    asm volatile("s_waitcnt vmcnt(0)" ::: "memory");
    __syncthreads();
    if (xb_tid == 0) {
        unsigned* bar = b.bar;
        __builtin_amdgcn_s_waitcnt(0);
        unsigned nloc = b.st[0], nx = b.st[1];
        if (nloc == 0u) { xcd_barrier_complete(bar, b.x, nloc, nx); b.st[0] = nloc; b.st[1] = nx; }
        const unsigned old = xb_add(&bar[XB_XSUB(b.x)], 1u);
        const unsigned gen = old / nloc;
        if (old + 1u == (gen + 1u) * nloc) {
            __builtin_amdgcn_fence(__ATOMIC_RELEASE, "agent");
            asm volatile("s_waitcnt vmcnt(0)" ::: "memory");
            const unsigned og = xb_add(&bar[XB_TOP], 1u);
            const unsigned tg = og / nx;
            if (og + 1u == (tg + 1u) * nx) xb_add(&bar[XB_TOPGEN], 1u);
            else XB_SPIN(xb_ld(&bar[XB_TOPGEN]) == tg, bar);
            __builtin_amdgcn_fence(__ATOMIC_ACQUIRE, "agent");
            xb_add(&bar[XB_XGEN(b.x)], 1u);
            asm volatile("s_waitcnt vmcnt(0)" ::: "memory");
        } else {
            XB_SPIN(xb_ld(&bar[XB_XGEN(b.x)]) == gen, bar);
            __builtin_amdgcn_fence(__ATOMIC_ACQUIRE, "agent");
            asm volatile("s_waitcnt vmcnt(0)" ::: "memory");
        }
    }
    __syncthreads();
}

#ifdef DBG_CHECK
__device__ __forceinline__ float dbg_bf(const u16* p) { return bf2f(*(const GAS u16*)p); }
__device__ __forceinline__ void dbg_count(gu32* ctl, int cls) { if (cls >= 0 && cls < 14) { gu32* c = ctl + 20000 + cls; if (__hip_atomic_load(c, __ATOMIC_RELAXED, __HIP_MEMORY_SCOPE_AGENT) < 4000000u) __hip_atomic_fetch_add(c, 1u, __ATOMIC_RELAXED, __HIP_MEMORY_SCOPE_AGENT); } }
__device__ __forceinline__ void dbg_mlstm_token(int bh, int c, int tl, const u16* MQ, const u16* MK, const u16* MV, const u16* MO, const float* GATES, const u16* CST, const float* NST, const float* MST,
                                const float* gm, const u16* MIX, LAS float* L, gu32* ctl, int tid, int cls) {
    const int b = bh >> 2, h = bh & 3, row0 = b * TP + c * CH, row = row0 + tl;
    LAS float* W = L; LAS float* SC = L + 128; LAS float* RED = L + 160;
    if (tid == 0) { const float mc = ldgf(MST + bh * 33 + c); float bc = 0.f, pm = -__builtin_inff();
        for (int s = 0; s <= tl; ++s) { const float ig = ldgf(GATES + (size_t)(row0 + s) * 8 + h), lf = ldgf(GATES + (size_t)(row0 + s) * 8 + 4 + h); bc += lf; const float a = ig - bc; W[s] = a; pm = fmaxf(pm, a); }
        const float Mt = fmaxf(mc, pm); SC[0] = Mt; SC[1] = __expf(mc - Mt); SC[2] = __expf(-(bc + Mt)); }
    __syncthreads();
    if (tid < 128) { float d = 0.f; if (tid <= tl) { for (int i = 0; i < MD; ++i) d += dbg_bf(MQ + (size_t)row * MW + h * MD + i) * dbg_bf(MK + (size_t)(row0 + tid) * MW + h * MD + i); d *= __expf(W[tid] - SC[0]); }
        __syncthreads(); W[tid] = d; } else __syncthreads();
    __syncthreads();
    float num = 0.f, den = 0.f, cq = 0.f, nq = 0.f;
    if (tid < 256) { const int v = tid;
        for (int s = 0; s <= tl; ++s) { num += W[s] * dbg_bf(MV + (size_t)(row0 + s) * MW + h * MD + v); den += W[s]; }
        for (int d = 0; d < MD; ++d) { const float q = dbg_bf(MQ + (size_t)row * MW + h * MD + d); cq += dbg_bf(CST + (size_t)(bh * NCH + c) * MD * MD + (size_t)v * MD + d) * q; nq += ldgf(NST + (size_t)(bh * NCH + c) * MD + d) * q; }
        num += SC[1] * cq; den += SC[1] * nq; }
    const float hval = num / fmaxf(fabsf(den), SC[2]);
    RED[tid] = (tid < 256) ? hval * hval : 0.f;
    __syncthreads();
    if (tid == 0) { float s = 0.f; for (int i = 0; i < 256; ++i) s += RED[i]; SC[3] = 1.0f / sqrtf(s * (1.0f / MD) + EPS); }
    __syncthreads();
    if (tid < 256) { const int v = tid; const float o = dbg_bf(MO + (size_t)row * MW + h * MD + v); const float y = hval * SC[3] * ldgf(gm + h * MD + v) * sigmoidf_(o);
        const float mine = dbg_bf(MIX + (size_t)row * DM + h * MD + v);
        if (fabsf(mine - y) > 0.02f + 0.03f * fabsf(y)) dbg_count(ctl, cls); }
    __syncthreads();
}
__device__ __forceinline__ void dbg_attn_token(int bh16, int t, const u16* AQ, const u16* AK, const u16* AV, const u16* MIX, LAS float* L, gu32* ctl, int tid, int cls) {
    const int b = bh16 >> 3, h = bh16 & 7, own = t >> 8;
    const u16* Q = AQ + ((size_t)bh16 * TP + t) * AD; const u16* K = AK + (size_t)bh16 * TP * AD; const u16* V = AV + (size_t)bh16 * TP * AD;
    LAS float* QL = L; LAS float* BS = L + 128; LAS float* SCO = L + 160; LAS float* RED = L + 160 + 1024; LAS int* SELB = (LAS int*)(L + 150);
    if (tid < 128) QL[tid] = dbg_bf(Q + tid);
    __syncthreads();
    if (tid < 16) { float s = 0.f; if (tid < own) { for (int d = 0; d < AD; ++d) { float km = 0.f; for (int r = 0; r < 256; ++r) km += dbg_bf(K + (size_t)(tid * 256 + r) * AD + d); s += QL[d] * km * (1.0f / 256.0f); } } BS[tid] = s; }
    __syncthreads();
    if (tid == 0) { int nsel = 0;
        if (own <= 3) { for (int n = 0; n < own; ++n) SELB[nsel++] = n; }
        else { unsigned used = 0u;
            for (int k = 0; k < 3; ++k) { int best = 0; float bv = -__builtin_inff(); for (int n = 0; n < own; ++n) if (!((used >> n) & 1u) && BS[n] > bv) { bv = BS[n]; best = n; } used |= 1u << best; SELB[nsel++] = best; } }
        SELB[3] = nsel; }
    __syncthreads();
    const int nsel = SELB[3];
    for (int e = tid; e < 1024; e += 512) { const int slot = e >> 8, kk = e & 255; float s = -__builtin_inff();
        int blk = -1; if (slot == 0) blk = own; else if (slot - 1 < nsel) blk = (slot == 1) ? SELB[0] : (slot == 2) ? SELB[1] : SELB[2];
        if (blk >= 0) { const int key = blk * 256 + kk; if (key <= t) { float d = 0.f; for (int i = 0; i < AD; ++i) d += QL[i] * dbg_bf(K + (size_t)key * AD + i); s = d * ATT_SCALE; } }
        SCO[e] = s; }
    __syncthreads();
    if (tid == 0) { float mx = -__builtin_inff(); for (int e = 0; e < 1024; ++e) mx = fmaxf(mx, SCO[e]); float sm = 0.f; for (int e = 0; e < 1024; ++e) { const float p = __expf(SCO[e] - mx); SCO[e] = p; sm += p; } BS[0] = 1.0f / sm; }
    __syncthreads();
    if (tid < 128) { float o = 0.f;
        for (int e = 0; e < 1024; ++e) { const float p = SCO[e]; if (p > 0.f) { const int slot = e >> 8, kk = e & 255; const int blk = (slot == 0) ? own : (slot == 1) ? SELB[0] : (slot == 2) ? SELB[1] : SELB[2]; o += p * dbg_bf(V + (size_t)(blk * 256 + kk) * AD + tid); } }
        o *= BS[0];
        const float mine = dbg_bf(MIX + (size_t)(b * TP + t) * DM + MW + h * AD + tid);
        if (fabsf(mine - o) > 0.004f + 0.05f * fabsf(o)) dbg_count(ctl, cls); }
    __syncthreads();
}

__device__ __forceinline__ void dbg_sattn_token(int b, int q, int h, const float* QS, const float* KSN, const float* VSN, const float* cache_k, const float* cache_v, const int* page_table,
                                                const u16* MIX, LAS float* L, gu32* ctl, int tid, int cls) {
    const int row = b * TS + q;
    LAS float* QL = L; LAS float* BS = L + 128; LAS int* SELB = (LAS int*)(L + 200); LAS float* SCO = L + 256; LAS float* AUX = L + 256 + 1024;
    if (tid < 128) QL[tid] = ldgf(QS + ((size_t)row * AH + h) * AD + tid);
    __syncthreads();
    if (tid < 64) { float s = 0.f;
        for (int d = 0; d < AD; ++d) { float km = 0.f;
            for (int r = 0; r < 256; ++r) { const int page = *(const GAS int*)(page_table + b * NPAGES + 2 * tid + (r >> 7)); km += ldgf(cache_k + ((size_t)page * PAGE + (r & 127)) * AW + h * AD + d); }
            s += QL[d] * km * (1.0f / 256.0f); }
        BS[tid] = s; }
    __syncthreads();
    if (tid == 0) { unsigned long long used = 0ull;
        for (int k = 0; k < 3; ++k) { int best = 0; float bv = -__builtin_inff(); for (int n = 0; n < 64; ++n) if (!((used >> n) & 1ull) && BS[n] > bv) { bv = BS[n]; best = n; } used |= 1ull << best; SELB[k] = best; } }
    __syncthreads();
    for (int e = tid; e < 1024; e += 512) { const int slot = e >> 8, kk = e & 255; float s = -__builtin_inff();
        if (slot < 3) { const int blk = (slot == 0) ? SELB[0] : (slot == 1) ? SELB[1] : SELB[2]; const int page = *(const GAS int*)(page_table + b * NPAGES + 2 * blk + (kk >> 7));
            float d = 0.f; for (int i = 0; i < AD; ++i) d += QL[i] * ldgf(cache_k + ((size_t)page * PAGE + (kk & 127)) * AW + h * AD + i); s = d * ATT_SCALE; }
        else if (kk <= q) { float d = 0.f; for (int i = 0; i < AD; ++i) d += QL[i] * ldgf(KSN + ((size_t)(b * TS + kk) * AH + h) * AD + i); s = d * ATT_SCALE; }
        SCO[e] = s; }
    __syncthreads();
    if (tid == 0) { float mx = -__builtin_inff(); for (int e = 0; e < 1024; ++e) mx = fmaxf(mx, SCO[e]); float sm = 0.f; for (int e = 0; e < 1024; ++e) { const float p = __expf(SCO[e] - mx); SCO[e] = p; sm += p; } AUX[0] = 1.0f / sm; }
    __syncthreads();
    if (tid < 128) { float o = 0.f;
        for (int e = 0; e < 1024; ++e) { const float p = SCO[e]; if (p > 0.f) { const int slot = e >> 8, kk = e & 255;
            if (slot < 3) { const int blk = (slot == 0) ? SELB[0] : (slot == 1) ? SELB[1] : SELB[2]; const int page = *(const GAS int*)(page_table + b * NPAGES + 2 * blk + (kk >> 7));
                o += p * ldgf(cache_v + ((size_t)page * PAGE + (kk & 127)) * AW + h * AD + tid); }
            else o += p * ldgf(VSN + ((size_t)(b * TS + kk) * AH + h) * AD + tid); } }
        o *= AUX[0];
        const float mine = dbg_bf(MIX + (size_t)(MP + row) * DM + MW + h * AD + tid);
        if (fabsf(mine - o) > 0.004f + 0.05f * fabsf(o)) dbg_count(ctl, cls); }
    __syncthreads();
}

__device__ __forceinline__ void dbg_qs_token(int row, int head, const float* x_s, const float* g1, const float* w_in, const float* QS, LAS float* L, gu32* ctl, int tid, int cls) {
    LAS float* HN = L; LAS float* QV = L + 2048; LAS float* AUX = L + 2048 + 128;
    float ss = 0.f; for (int k = tid; k < DM; k += 512) { const float v = ldgf(x_s + (size_t)row * DM + k); ss += v * v; }
    ss = wave_sum(ss); if ((tid & 63) == 0) AUX[tid >> 6] = ss;
    __syncthreads();
    float tot = 0.f; for (int w = 0; w < 8; ++w) tot += AUX[w];
    const float rstd = 1.0f / sqrtf(tot * (1.0f / DM) + EPS);
    for (int k = tid; k < DM; k += 512) HN[k] = ldgf(x_s + (size_t)row * DM + k) * rstd * ldgf(g1 + k);
    __syncthreads();
    if (tid < 128) { float a = 0.f; for (int k = 0; k < DM; ++k) a += HN[k] * ldgf(w_in + (size_t)k * NIN + 4104 + head * 128 + tid); QV[tid] = a; }
    __syncthreads();
    if (tid < 128) { const int dl = tid & 63, t = row & 7; const double inv = exp(-(double)dl * (9.210340371976184 / 64.0)); float s, c; sincos_d((double)(PAST + t) * inv, s, c);
        const float x1 = QV[dl], x2 = QV[dl + 64]; const float ref = tid < 64 ? x1 * c - x2 * s : x2 * c + x1 * s;
        const float mine = ldgf(QS + ((size_t)row * AH + head) * AD + tid);
        if (fabsf(mine - ref) > 0.02f + 0.02f * fabsf(ref)) dbg_count(ctl, cls); }
    __syncthreads();
}
#endif

__device__ __forceinline__ void moba_select(int bh16, int own, const u16* AQ, const float* KMP, LAS unsigned* SELT, LAS float* KML, int tid) {
    if (own <= 3) { if (tid < 256) SELT[tid] = (1u << own) - 1u; return; }
    *(LAS f32x4*)(KML + 4 * tid) = ldg4(KMP + (size_t)bh16 * 16 * AD + 4 * tid);
    const int row = tid >> 1, half = tid & 1;
    const u16* qp = AQ + ((size_t)bh16 * TP + own * 256 + row) * AD + 64 * half;
    u32x4 qv[8];
#pragma unroll
    for (int i = 0; i < 8; ++i) qv[i] = ldgu4(qp + 8 * i);
    WG_BAR();
    float b0 = -__builtin_inff(), b1 = b0, b2 = b0; int i0 = 0, i1 = 0, i2 = 0;
    for (int n = 0; n < own; ++n) {
        const LAS float* kp = KML + n * AD + 64 * half; float s = 0.f;
#pragma unroll
        for (int i = 0; i < 8; ++i) { const f32x4 k0 = *(const LAS f32x4*)(kp + 8 * i), k1 = *(const LAS f32x4*)(kp + 8 * i + 4);
            s += bflo(qv[i].x) * k0[0] + bfhi(qv[i].x) * k0[1] + bflo(qv[i].y) * k0[2] + bfhi(qv[i].y) * k0[3] + bflo(qv[i].z) * k1[0] + bfhi(qv[i].z) * k1[1] + bflo(qv[i].w) * k1[2] + bfhi(qv[i].w) * k1[3]; }
        s += __shfl_xor(s, 1);
        if (s > b0) { b2 = b1; i2 = i1; b1 = b0; i1 = i0; b0 = s; i0 = n; } else if (s > b1) { b2 = b1; i2 = i1; b1 = s; i1 = n; } else if (s > b2) { b2 = s; i2 = n; }
    }
    if (half == 0) SELT[row] = (1u << i0) | (1u << i1) | (1u << i2);
}

__device__ __forceinline__ void skinny_epi_in(int pn, int j, const LAS float* RES, float* QKVO, float* QS, float* kout, const float* rcos, const float* rsin, int tid) {
    if (tid >= 256) return;
    const int row = tid >> 2, q = tid & 3; const f32x4 a = *(const LAS f32x4*)(RES + row * 32 + 4 * q), bq = *(const LAS f32x4*)(RES + row * 32 + 16 + 4 * q);
    if (pn < 16) { float* p = QKVO + (size_t)row * 4096 + pn * 256 + 16 * j + 4 * q; stg4(p, a); stg4(p + 128, bq); return; }
    const int aa = pn - 16, sec = aa >> 2, pt = aa & 3, tc = 16 * j + 4 * q, head = 2 * pt + (tc >> 6), dl = tc & 63, t = row & 7;
    f32x4 x1 = a, x2 = bq;
    if (sec < 2) { const f32x4 c = ldg4(rcos + (size_t)(TP + t) * 64 + dl), s = ldg4(rsin + (size_t)(TP + t) * 64 + dl); x1 = a * c - bq * s; x2 = bq * c + a * s; }
    float* dst = QS + (size_t)sec * 65536 + ((size_t)row * AH + head) * AD + dl; stg4(dst, x1); stg4(dst + 64, x2);
    if (sec >= 1) { float* fo = kout + (size_t)(sec - 1) * ((size_t)MS * AW) + (size_t)row * AW + head * AD + dl; stg4(fo, x1); stg4(fo + 64, x2); }
}
template <bool WITH_G>
__device__ __forceinline__ void skinny_epi_res(int su, int ca, const LAS float* RES, const float* res, float* out, u16* outg, const float* g, float* SSS, int tid) {
    if (tid >= 256) return;
    const int row = tid >> 2, q = tid & 3; float ss = 0.f;
#pragma unroll
    for (int h = 0; h < 2; ++h) { const int col = ca + 128 * h + 4 * q; const f32x4 v = *(const LAS f32x4*)(RES + row * 32 + 16 * h + 4 * q) + ldg4(res + (size_t)row * DM + col);
        stg4(out + (size_t)row * DM + col, v); ss += dot4(v, v);
        if (WITH_G) { const f32x4 gv = ldg4(g + col); u32x2 w; w.x = cvtpk(v[0] * gv[0], v[1] * gv[1]); w.y = cvtpk(v[2] * gv[2], v[3] * gv[3]); stgu2(outg + (size_t)row * DM + col, w); } }
    ss += __shfl_xor(ss, 1); ss += __shfl_xor(ss, 2);
    if (q == 0) stgf(SSS + row * 64 + su, ss);
}
__device__ __forceinline__ void skinny_epi_up(int pn, int j, LAS float* RES, const LAS float* RSTDL, const float* stconv, const float* conv_w, const float* conv_b, u16* ACTs, float* conv_out, int tid) {
    { const int row = tid >> 3; f32x4 v = *(LAS f32x4*)(RES + 4 * tid); v = v * RSTDL[row]; *(LAS f32x4*)(RES + 4 * tid) = v; }
    WG_BAR();
    if (tid < 256) {
        const int row = tid >> 2, q = tid & 3, b = row >> 3, t = row & 7;
        float cv[2][4];
#pragma unroll
        for (int h = 0; h < 2; ++h)
#pragma unroll
            for (int e = 0; e < 4; ++e) {
                const int tcol = 16 * h + 4 * q + e, oc = h * DFF + pn * 128 + 16 * j + 4 * q + e;
                const float u0 = RES[row * 32 + tcol];
                const float um1 = (t >= 1) ? RES[(row - 1) * 32 + tcol] : ldgf(stconv + ((size_t)b * 2 + 1) * NUP + oc);
                const float um2 = (t >= 2) ? RES[(row - 2) * 32 + tcol] : ldgf(stconv + ((size_t)b * 2 + t) * NUP + oc);
                cv[h][e] = ldgf(conv_b + oc) + ldgf(conv_w + oc) * um2 + ldgf(conv_w + NUP + oc) * um1 + ldgf(conv_w + 2 * NUP + oc) * u0;
                if (t >= 6) stgf(conv_out + ((size_t)b * 2 + (t - 6)) * NUP + oc, u0);
            }
        u32x2 w; float a[4];
#pragma unroll
        for (int e = 0; e < 4; ++e) a[e] = cv[0][e] / (1.0f + __expf(-cv[0][e])) * cv[1][e];
        w.x = cvtpk(a[0], a[1]); w.y = cvtpk(a[2], a[3]);
        stgu2(ACTs + (size_t)row * DFF + pn * 128 + 16 * j + 4 * q, w);
    }
}

#ifdef DBG_SCALE_MASK
#ifndef DBG_SCALE_F
#define DBG_SCALE_F 2.0f
#endif
#define DBG_YS(m) ((((m) < MP) ? ((DBG_SCALE_MASK >> 0) & 1) : ((DBG_SCALE_MASK >> 1) & 1)) ? DBG_SCALE_F : 1.0f)
#else
#define DBG_YS(m) 1.0f
#endif
#ifndef PH_MASK
#define PH_MASK 0x1ff
#endif
struct Args { const void* in[20]; float* out; unsigned char* ws; int ph_lo, ph_hi, li, pad; };

__global__ void __launch_bounds__(NTHREADS, 2) hymba_fwd(Args args) {
    extern __shared__ __attribute__((aligned(16))) unsigned char lds_raw[];
    LAS unsigned char* lds = (LAS unsigned char*)lds_raw;
    volatile LAS unsigned* MISC = (volatile LAS unsigned*)(lds + MISC_OFF);
    const int wave = __builtin_amdgcn_readfirstlane((int)threadIdx.x >> 6);
#define tid tid_of(wave)
#define lane (tid_of(wave) & 63)
    const int G = gridDim.x; const int bx = blockIdx.x; const int vcu = (G % 8 == 0) ? (bx % 8) * (G / 8) + bx / 8 : bx;
    unsigned char* const ws = args.ws; float* const out = args.out;
#define ctl ((gu32*)(ws + WS_CTL))
#define x_p ((const float*)args.in[0])
#define x_s ((const float*)args.in[1])
#define cache_k ((const float*)args.in[2])
#define cache_v ((const float*)args.in[3])
#define page_table ((const int*)args.in[4])
#define st_C ((const float*)args.in[5])
#define st_n ((const float*)args.in[6])
#define st_m ((const float*)args.in[7])
#define st_conv ((const float*)args.in[8])
#define g1 ((const float*)args.in[9])
#define w_in ((const float*)args.in[10])
#define b_gates ((const float*)args.in[11])
#define gmn ((const float*)args.in[12])
#define w_out ((const float*)args.in[13])
#define g2 ((const float*)args.in[14])
#define w_up ((const float*)args.in[15])
#define conv_w ((const float*)args.in[16])
#define conv_b ((const float*)args.in[17])
#define w_down ((const float*)args.in[18])
#define gf ((const float*)args.in[19])
#define WIN ((u16*)(ws + WS_WIN))
#define WOUT ((u16*)(ws + WS_WOUT))
#define WUP ((u16*)(ws + WS_WUP))
#define WDN ((u16*)(ws + WS_WDN))
#define RCOS ((float*)(ws + WS_ROPE))
#define RSIN ((float*)(ws + WS_ROPE + 2 * MiB))
#define GATES ((float*)(ws + WS_GATES))
#define XN ((u16*)(ws + WS_XN))
#define MQ ((u16*)(ws + WS_MQ))
#define MK ((u16*)(ws + WS_MK))
#define MV ((u16*)(ws + WS_MV))
#define MO ((u16*)(ws + WS_MO))
#define AQ ((u16*)(ws + WS_AQ))
#define AK ((u16*)(ws + WS_AK))
#define AV ((u16*)(ws + WS_AV))
#define UU ((u16*)(ws + WS_U))
#define CST ((u16*)(ws + WS_CST))
#define CHS ((float*)((ws + WS_SMALL) + SM_CHS))
#define MST ((float*)((ws + WS_SMALL) + SM_MST))
#define KMP ((float*)((ws + WS_SMALL) + SM_KMP))
#define UN ((float*)((ws + WS_SMALL) + SM_UN))
#define NST ((float*)((ws + WS_SMALL) + SM_NST))
#define QKVO ((float*)((ws + WS_SMALL) + SM_QKVO))
#define KMS ((float*)((ws + WS_SMALL) + SM_KMS))
#define QS ((float*)((ws + WS_SMALL) + SM_QS))
#define KSN ((float*)((ws + WS_SMALL) + SM_KSN))
#define VSN ((float*)((ws + WS_SMALL) + SM_VSN))
#define SEL ((int*)((ws + WS_SMALL) + SM_SEL))
#define SSS1 ((float*)((ws + WS_SMALL) + SM_SSS1))
#define SSS2 ((float*)((ws + WS_SMALL) + SM_SSS2))
#define MIXED ((u16*)(ws + WS_MIXED))
#define X1 ((float*)(ws + WS_X1))
#define X1G ((u16*)(ws + WS_X1G))
#define SS1 ((float*)(ws + WS_SS))
#define SS2 ((float*)(ws + WS_SS + 2 * MiB))
#define ACT ((u16*)(ws + WS_ACT))
#define UB ((float*)(ws + WS_UB))
#define PART ((float*)(ws + WS_PART))
    for (int u = tid; u < 64; u += NTHREADS) ((LAS unsigned*)(lds + MISC_OFF))[u] = 0u;
    __syncthreads();
    XcdBarrier bar; bar.bar = (unsigned*)(ctl + CW_BAR); bar.x = 0; bar.st = nullptr;
    if (MK_N_LAUNCHES != N_PHASES) bar = xcd_barrier_post((unsigned*)(ctl + CW_BAR) + args.li * XCD_BAR_WORDS, MISC + 8, tid);
    const int lo = args.ph_lo, hi = args.ph_hi;
#define IN(k) (((PH_MASK >> (k)) & 1) && lo <= (k) && (k) < hi)
#if defined(DBG_REPEAT) && DBG_REPEAT == 41
#define DBG_P4A 2
#else
#define DBG_P4A 1
#endif
#if defined(DBG_REPEAT) && DBG_REPEAT == 42
#define DBG_P4B 2
#else
#define DBG_P4B 1
#endif
#if defined(DBG_REPEAT) && DBG_REPEAT == 11
#define DBG_KM 2
#else
#define DBG_KM 1
#endif
#if defined(DBG_REPEAT) && DBG_REPEAT == 421
#define DBG_XN 32
#define DBG_XB 0
#elif defined(DBG_REPEAT) && DBG_REPEAT == 422
#define DBG_XN 256
#define DBG_XB 32
#elif defined(DBG_REPEAT) && DBG_REPEAT == 423
#define DBG_XN 512
#define DBG_XB 288
#else
#define DBG_XN 0
#define DBG_XB 0
#endif
#ifdef DBG_REPEAT
#define REPS(k) (((k) == DBG_REPEAT) ? 2 : 1)
#else
#define REPS(k) 1
#endif
#ifdef DBG_TIMING
#define STAMP(k) do { if (bx == 0 && tid == 0) { ((GAS unsigned long long*)(ctl + 30000))[k] = __builtin_amdgcn_s_memrealtime(); } } while (0)
#else
#define STAMP(k) do {} while (0)
#endif
#define SEAM(k) do { if (IN(k) && IN((k) + 1)) xcd_barrier(bar, tid); STAMP((k) + 1); } while (0)
    const int gw = vcu * NWAVES + wave, NGW = G * NWAVES;
    STAMP(0);

    for (int rep_ = 0; rep_ < REPS(0); ++rep_) { if (rep_) xcd_barrier(bar, tid);
    if (IN(0)) {
#if PH_MASK != 0x1ff
        for (size_t i = (size_t)bx * NTHREADS + tid; i < O_END / 4; i += (size_t)G * NTHREADS) stg4(out + 4 * i, (f32x4){0.f, 0.f, 0.f, 0.f});
#endif
        LAS float* scr = (LAS float*)(lds + wave * 16384);
        constexpr int I_IN = 32 * 224, I_OUT = 32 * 64, I_UP = 32 * 352, I_DN = 88 * 64, NITEMS = I_IN + I_OUT + I_UP + I_DN;
        for (int it = gw; it < NITEMS; it += NGW) {
            int r = it;
            if (r < I_IN) { const int kb = r / 224, n0 = (r % 224) * 32; transpose_item(w_in, DM, NIN, WIN, kb * 64, n0, win_src_col(n0), scr, lane); continue; } r -= I_IN;
            if (r < I_OUT) { const int kb = r / 64, n0 = (r % 64) * 32; transpose_item(w_out, DM, DM, WOUT, kb * 64, n0, n0, scr, lane); continue; } r -= I_OUT;
            if (r < I_UP) { const int kb = r / 352, n0 = (r % 352) * 32; transpose_item(w_up, DM, NUP, WUP, kb * 64, n0, wup_src_col(n0), scr, lane); continue; } r -= I_UP;
            { const int kb = r / 64, n0 = (r % 64) * 32; transpose_item(w_down, DFF, DM, WDN, kb * 64, n0, n0, scr, lane); }
        }
        for (int idx = vcu * NTHREADS + tid; idx < (TP + TS) * 64; idx += G * NTHREADS) {
            const int p = idx >> 6, i = idx & 63; const int pos = p < TP ? p : PAST + (p - TP);
            const double inv = exp(-(double)i * (9.210340371976184 / 64.0));
            float s, c; sincos_d((double)pos * inv, s, c); stgf(RCOS + idx, c); stgf(RSIN + idx, s);
        }
        __syncthreads();
        LAS float* GW = (LAS float*)lds; LAS float* G1L = (LAS float*)(lds + 65536);
        for (int i = tid; i < 8 * DM; i += NTHREADS) { const int k = i >> 3, j = i & 7; GW[j * DM + k] = ldgf(g1 + k) * ldgf(w_in + (size_t)k * NIN + 4096 + j); }
        for (int i = tid; i < DM; i += NTHREADS) G1L[i] = ldgf(g1 + i);
        __syncthreads();
        for (int m = gw; m < MT; m += NGW) norm1_row(m < MP ? x_p + (size_t)m * DM : x_s + (size_t)(m - MP) * DM, XN + (size_t)m * DM, GATES + (size_t)m * 8, GW, G1L, b_gates, lane);
        __syncthreads();
    }
    }
    SEAM(0);
    for (int rep_ = 0; rep_ < REPS(1); ++rep_) { if (rep_) xcd_barrier(bar, tid);
    if (IN(1)) {
        pg8::Gemm g{XN, WIN, MP, NING, DM}; pg8::StaticOrder S; S.init(MP, NING, G, bx);
        EpiIn E{MQ, AQ, out + O_KP, RCOS, RSIN};
        pg8::gemm_phase<EpiIn, pg8::StaticOrder, true, true>(lds, g, S, E, tid);
        if (G == 256 && bx >= 128) { for (int u4 = 0; u4 < 4 * DBG_KM; ++u4) kmean_sample_unit((bx - 128) * 4 + (u4 & 3), cache_k, page_table, KMS, lds, tid); }
        else if (G != 256) { for (int it = vcu; it < 512; it += G) kmean_sample_unit(it, cache_k, page_table, KMS, lds, tid); }
        for (int su = vcu; su < 224; su += G) { const int pn = su >> 3, j = su & 7;
            skinny_unit(XN + (size_t)MP * DM, WIN, DM, pn * 256 + 16 * j, pn * 256 + 16 * j + 128, lds, tid, wave, lane);
            skinny_epi_in(pn, j, (const LAS float*)(lds + 65536), QKVO, QS, out + O_KS, RCOS, RSIN, tid);
            WG_BAR(); }
    }
    }
    SEAM(1);
    for (int rep_ = 0; rep_ < REPS(2); ++rep_) { if (rep_) xcd_barrier(bar, tid);
    if (IN(2)) {
        for (int it = vcu; it < 512; it += G) {
            int tid_o = tid; asm volatile("" : "+v"(tid_o)); const int lane_o = tid_o & 63, wave_o = __builtin_amdgcn_readfirstlane(tid_o >> 6);
            if (it < 256) mlstm_A_unit(it, MK, MV, GATES, UU, UN, CHS, lds, tid_o, wave_o, lane_o);
            else kmean_prompt_unit(it - 256, AK, KMP, lds, tid_o);
        }
    }
    }
    SEAM(2);
    for (int rep_ = 0; rep_ < REPS(3); ++rep_) { if (rep_) xcd_barrier(bar, tid);
    if (IN(3)) {
        mlstm_B(vcu * NTHREADS + tid, G * NTHREADS, UU, UN, CHS, CST, NST, MST, out + O_CP, out + O_NP, out + O_MP);
        for (int su = vcu; su < 64; su += G) sample_select_unit(su, QS, KMS, SEL, lds, tid);
    }
    }
    SEAM(3);
    for (int rep_ = 0; rep_ < REPS(4); ++rep_) { if (rep_) xcd_barrier(bar, tid);
    if (IN(4)) {
#ifndef P4_MASK
#define P4_MASK 0xf
#endif
        const int natt = G >> 1;
        if ((P4_MASK & 1) && vcu < natt) {
            for (int rp4_ = 0; rp4_ < DBG_P4A; ++rp4_)
            for (int item = vcu; item < 128; item += natt) {
                const int bh16 = item >> 3, x = item & 7;
                int tid_o = tid; asm volatile("" : "+v"(tid_o));
                const u16* Qb = AQ + (size_t)bh16 * TP * AD; const u16* Kb = AK + (size_t)bh16 * TP * AD; const u16* Vb = AV + (size_t)bh16 * TP * AD;
                const int b = bh16 >> 3, h = bh16 & 7;
                u16* Ob = MIXED + (size_t)b * TP * DM + MW + h * AD;
                const moba::HeadRef H{Qb, Kb, Vb};
                moba::BlockRef c0{Ob + (size_t)(15 - x) * 256 * DM, 15 - x, 0, 4 * (16 - x), nullptr, nullptr};
                moba::BlockRef c1{Ob + (size_t)x * 256 * DM, x, 0, 4 * (x + 1), nullptr, nullptr};
                moba::Seam S;
                moba_select(bh16, c0.own, AQ, KMP, (LAS unsigned*)(lds + SELT_OFF), (LAS float*)(lds + KML_OFF), tid_o);
                moba::moba_prime(H, c0, (char*)lds_raw, S, tid_o);
                moba::moba_block<0>(H, c0, c1, (char*)lds_raw, S, (const unsigned*)(lds_raw + SELT_OFF), nullptr, tid_o);
                asm volatile("" : "+v"(tid_o));
                moba_select(bh16, c1.own, AQ, KMP, (LAS unsigned*)(lds + SELT_OFF), (LAS float*)(lds + KML_OFF), tid_o);
                __syncthreads();
                moba::moba_block<0>(H, c1, c1, (char*)lds_raw, S, (const unsigned*)(lds_raw + SELT_OFF), nullptr, tid_o);
            }
        } else {
            const int nr = G - natt;
            for (int rp4_ = 0; rp4_ < DBG_P4B; ++rp4_)
            for (int it_ = vcu - natt; it_ < 800 + DBG_XN; it_ += nr) { const int it = it_ < 800 ? it_ : it_ - 800 + DBG_XB;
                int tid_o = tid; asm volatile("" : "+v"(tid_o)); const int lane_o = tid_o & 63, wave_o = __builtin_amdgcn_readfirstlane(tid_o >> 6);
                if ((P4_MASK & 8) && it < 32) sample_mlstm_unit(it, QKVO, GATES, st_C, st_n, st_m, gmn, out + O_CS, out + O_NS, out + O_MS, MIXED, lds, tid_o, wave_o, lane_o);
                else if ((P4_MASK & 2) && it >= 32 && it < 288) mlstm_C_unit(it - 32, MQ, MK, MV, MO, GATES, CST, NST, MST, gmn, MIXED, lds, tid_o, wave_o, lane_o);
                else if ((P4_MASK & 4) && it >= 288) sample_attend_unit(it - 288, QS, KSN, VSN, cache_k, cache_v, page_table, SEL, MIXED, lds, tid_o, wave_o, lane_o);
            }
        }
    }
    }
    SEAM(4);
    for (int rep_ = 0; rep_ < REPS(5); ++rep_) { if (rep_) xcd_barrier(bar, tid);
    if (IN(5)) {
        pg8::Gemm g{MIXED, WOUT, MP, DM, DM}; pg8::StaticOrder S; S.init(MP, DM, G, bx);
        EpiRes<true> E{x_p, X1, X1G, g2, SS1};
        pg8::gemm_phase<EpiRes<true>, pg8::StaticOrder, true, true>(lds, g, S, E, tid);
        for (int su = vcu; su < 64; su += G) { const int pn = su >> 3, j = su & 7, ca = pn * 256 + 16 * j;
            skinny_unit(MIXED + (size_t)MP * DM, WOUT, DM, ca, ca + 128, lds, tid, wave, lane);
            skinny_epi_res<true>(su, ca, (const LAS float*)(lds + 65536), x_s, X1 + (size_t)MP * DM, X1G + (size_t)MP * DM, g2, SSS1, tid);
            WG_BAR(); }
    }
    }
    SEAM(5);
    for (int rep_ = 0; rep_ < REPS(6); ++rep_) { if (rep_) xcd_barrier(bar, tid);
    if (IN(6)) {
        pg8::Gemm g{X1G, WUP, MP, NUP, DM}; pg8::StaticOrder S; S.init(MP, NUP, G, bx);
        EpiUp E{lds + XCH_OFF, SS1, conv_w, conv_b, ACT, UB, ctl + CW_UPCNT, out + O_CVP, (void*)(ws + 600 * MiB)};
        pg8::gemm_phase<EpiUp, pg8::StaticOrder, true, true>(lds, g, S, E, tid);
        LAS float* RSTDL = (LAS float*)(lds + 65536 + 8192);
        { const int row = tid >> 3, part = tid & 7; const f32x4 a = ldg4(SSS1 + row * 64 + 8 * part), b4 = ldg4(SSS1 + row * 64 + 8 * part + 4);
          float s = ((a[0] + a[1]) + (a[2] + a[3])) + ((b4[0] + b4[1]) + (b4[2] + b4[3])); s += __shfl_xor(s, 1); s += __shfl_xor(s, 2); s += __shfl_xor(s, 4);
          if (part == 0) RSTDL[row] = 1.0f / sqrtf(s * (1.0f / DM) + EPS); }
        WG_BAR();
        for (int su = vcu; su < 352; su += G) { const int pn = su >> 3, j = su & 7, ca = pn * 256 + 16 * j;
            skinny_unit(X1G + (size_t)MP * DM, WUP, DM, ca, ca + 128, lds, tid, wave, lane);
            skinny_epi_up(pn, j, (LAS float*)(lds + 65536), RSTDL, st_conv, conv_w, conv_b, ACT + (size_t)MP * DFF, out + O_CVS, tid);
            WG_BAR(); }
    }
    }
    SEAM(6);
#ifdef DBG_CHECK
    if (lo == 102) {
        LAS float* L = (LAS float*)lds;
        for (int s = bx; s < 2048; s += G) {
#if DBG_CHECK == 1
            const int bh = s >> 8, c = (s >> 3) & 31, w = s & 7, tl = 16 * w + ((c + 3 * w) & 15);
            dbg_mlstm_token(bh, c, tl, MQ, MK, MV, MO, GATES, CST, NST, MST, gmn, MIXED, L, ctl, tid, DBG_CLS_M(bh, c, w, tl));
#elif DBG_CHECK == 2
            const int bh16 = s >> 7, own = (s >> 3) & 15, r = s & 7, t = own * 256 + 32 * r + ((own * 5 + r * 3) & 31);
            dbg_attn_token(bh16, t, AQ, AK, AV, MIXED, L, ctl, tid, DBG_CLS_A(bh16, own, r, t));
#elif DBG_CHECK == 4
            if (s < 512) { const int row = s >> 3, head = s & 7; dbg_qs_token(row, head, x_s, g1, w_in, QS, L, ctl, tid, head); }
#else
            if (s < 512) { const int b = s >> 6, q = (s >> 3) & 7, h = s & 7; dbg_sattn_token(b, q, h, QS, KSN, VSN, cache_k, cache_v, page_table, MIXED, L, ctl, tid, DBG_CLS_S(b, q, h)); }
#endif
        }
    }
    if (lo == 101 && bx == 0 && tid < 14) {
        size_t o0 = 0, o1 = 0;
#define DBG_O(k, A, B) if (tid == (k)) { o0 = (A); o1 = (B); }
        DBG_O(0, O_YP, O_YS) DBG_O(1, O_YS, O_KP) DBG_O(2, O_KP, O_VP) DBG_O(3, O_VP, O_KS) DBG_O(4, O_KS, O_VS) DBG_O(5, O_VS, O_CP) DBG_O(6, O_CP, O_NP) DBG_O(7, O_NP, O_MP)
        DBG_O(8, O_MP, O_CS) DBG_O(9, O_CS, O_NS) DBG_O(10, O_NS, O_MS) DBG_O(11, O_MS, O_CVP) DBG_O(12, O_CVP, O_CVS) DBG_O(13, O_CVS, O_END)
#undef DBG_O
        const unsigned cnt = __hip_atomic_load(ctl + 20000 + tid, RLX_AGENT);
        for (size_t i = 0; i < cnt && o0 + i < o1; ++i) *(GAS unsigned*)(out + o0 + i) = 0xAAAAAAAAu;
    }
#endif
#ifdef DBG_UFULL
    if (lo == 100) {
        const float* UF = (const float*)(ws + 600 * MiB);
        for (size_t idx = (size_t)bx * NTHREADS + tid; idx < (size_t)MP * DFF; idx += (size_t)G * NTHREADS) {
            const int row = (int)(idx / DFF), j = (int)(idx % DFF), t = row & (TP - 1), pn = j >> 7, tc = j & 127;
            float cv[2];
            for (int h2 = 0; h2 < 2; ++h2) { const int oc = h2 * DFF + j; const size_t ui = (size_t)pn * 256 + h2 * 128 + tc;
                const float u0 = ldgf(UF + (size_t)row * NUP + ui), um1 = t >= 1 ? ldgf(UF + (size_t)(row - 1) * NUP + ui) : 0.f, um2 = t >= 2 ? ldgf(UF + (size_t)(row - 2) * NUP + ui) : 0.f;
                cv[h2] = ldgf(conv_b + oc) + ldgf(conv_w + oc) * um2 + ldgf(conv_w + NUP + oc) * um1 + ldgf(conv_w + 2 * NUP + oc) * u0; }
            const float a = cv[0] / (1.0f + __expf(-cv[0])) * cv[1];
#ifdef DBG_CMP
            { const float mine = bf2f(*(const GAS u16*)(ACT + (size_t)row * DFF + j)); const int cls = DBG_CLS(row, j);
              if (fabsf(mine - a) > 0.02f + 0.02f * fabsf(a) && cls < 14) { gu32* cw_ = ctl + 20000 + cls; if (__hip_atomic_load(cw_, RLX_AGENT) < 4000000u) __hip_atomic_fetch_add(cw_, 1u, RLX_AGENT); } }
#else
            *(GAS u16*)(ACT + (size_t)row * DFF + j) = (u16)f2bf(a);
#endif
        }
    }
#ifdef DBG_CMP
    if (lo == 101 && bx == 0 && tid < 14) {
        const size_t offs[15] = {O_YP, O_YS, O_KP, O_VP, O_KS, O_VS, O_CP, O_NP, O_MP, O_CS, O_NS, O_MS, O_CVP, O_CVS, O_END};
        size_t o0 = 0, o1 = 0;
        for (int k = 0; k < 14; ++k) if (k == tid) { o0 = offs[k]; o1 = offs[k + 1]; }
        const unsigned cnt = __hip_atomic_load(ctl + 20000 + tid, RLX_AGENT);
        for (size_t i = 0; i < cnt && o0 + i < o1; ++i) *(GAS unsigned*)(out + o0 + i) = 0xAAAAAAAAu;
    }
#endif
#endif
    for (int rep_ = 0; rep_ < REPS(7); ++rep_) { if (rep_) xcd_barrier(bar, tid);
    if (IN(7)) {
        pg8::Gemm g{ACT, WDN, MP, DM, DFF}; pg8::StaticOrder S; S.init(MP, DM, G, bx);
        EpiRes<false> E{X1, out + O_YP, nullptr, nullptr, SS2};
        pg8::gemm_phase<EpiRes<false>, pg8::StaticOrder, true, true>(lds, g, S, E, tid);
        for (int su = vcu; su < 64; su += G) { const int pn = su >> 3, j = su & 7, ca = pn * 256 + 16 * j;
            skinny_unit(ACT + (size_t)MP * DFF, WDN, DFF, ca, ca + 128, lds, tid, wave, lane);
            skinny_epi_res<false>(su, ca, (const LAS float*)(lds + 65536), X1 + (size_t)MP * DM, out + O_YS, nullptr, nullptr, SSS2, tid);
            WG_BAR(); }
    }
    }
    SEAM(7);
    if (IN(8)) {
        for (int m = gw; m < MT; m += NGW) {
            float s; float* p;
            if (m < MP) { s = lane < 32 ? ldgf(SS2 + (size_t)m * 32 + lane) : 0.f; p = out + O_YP + (size_t)m * DM; }
            else { s = ldgf(SSS2 + (m - MP) * 64 + lane); p = out + O_YS + (size_t)(m - MP) * DM; }
            const float rstd = 1.0f / sqrtf(wave_sum(s) * (1.0f / DM) + EPS);
#pragma unroll
            for (int i = 0; i < 8; ++i) { const f32x4 v = ldg4(p + 256 * i + 4 * lane), g = ldg4(gf + 256 * i + 4 * lane); stg4(p + 256 * i + 4 * lane, v * rstd * g * DBG_YS(m)); }
        }
#ifdef DBG_SCALE_MASK
#define DBG_SC(j, A, B) if ((DBG_SCALE_MASK >> (j)) & 1) for (size_t i = (A) + (size_t)bx * NTHREADS + tid; i < (B); i += (size_t)G * NTHREADS) stgf(out + i, DBG_SCALE_F * ldgf(out + i));
        DBG_SC(2, O_KP, O_VP) DBG_SC(3, O_VP, O_KS) DBG_SC(4, O_KS, O_VS) DBG_SC(5, O_VS, O_CP) DBG_SC(6, O_CP, O_NP) DBG_SC(7, O_NP, O_MP)
        DBG_SC(8, O_MP, O_CS) DBG_SC(9, O_CS, O_NS) DBG_SC(10, O_NS, O_MS) DBG_SC(11, O_MS, O_CVP) DBG_SC(12, O_CVP, O_CVS) DBG_SC(13, O_CVS, O_END)
#undef DBG_SC
#endif
    }
#ifdef DBG_TIMING
    STAMP(9);
    if (bx == 0) {
        __syncthreads();
        if (tid < 10) { const unsigned long long* ts = (const unsigned long long*)(ctl + 30000);
            unsigned long long t0 = 0, t1 = 0; size_t o0 = 0;
#define DBG_T(k, A, B, O) if (tid == (k)) { t0 = *(const GAS unsigned long long*)(ts + (A)); t1 = *(const GAS unsigned long long*)(ts + (B)); o0 = (O); }
            DBG_T(0, 0, 1, O_YP) DBG_T(1, 1, 2, O_YS) DBG_T(2, 2, 3, O_KP) DBG_T(3, 3, 4, O_VP) DBG_T(4, 4, 5, O_KS) DBG_T(5, 5, 6, O_VS) DBG_T(6, 6, 7, O_CP) DBG_T(7, 7, 8, O_NP) DBG_T(8, 8, 9, O_CVP) DBG_T(9, 0, 9, O_CVS)
#undef DBG_T
            const unsigned us = (unsigned)((t1 - t0) / 100ull);
            for (unsigned i = 0; i < us && i < 2000; ++i) *(GAS unsigned*)(out + o0 + i) = 0xAAAAAAAAu; }
    }
#endif
#undef IN
#undef SEAM
#undef tid
#undef lane
#undef x_p
#undef x_s
#undef cache_k
#undef cache_v
#undef page_table
#undef st_C
#undef st_n
#undef st_m
#undef st_conv
#undef g1
#undef w_in
#undef b_gates
#undef gmn
#undef w_out
#undef g2
#undef w_up
#undef conv_w
#undef conv_b
#undef w_down
#undef gf
#undef WIN
#undef WOUT
#undef WUP
#undef WDN
#undef RCOS
#undef RSIN
#undef GATES
#undef XN
#undef MQ
#undef MK
#undef MV
#undef MO
#undef AQ
#undef AK
#undef AV
#undef UU
#undef CST
#undef CHS
#undef MST
#undef KMP
#undef UN
#undef NST
#undef QKVO
#undef KMS
#undef QS
#undef KSN
#undef VSN
#undef SEL
#undef SSS1
#undef SSS2
#undef MIXED
#undef X1
#undef X1G
#undef SS1
#undef SS2
#undef ACT
#undef UB
#undef PART
#undef ctl
}

extern "C" void kernel_launch(void* const* d_in, const int* in_sizes, int n_in, void* d_out, int out_size, void* d_ws, size_t ws_size, hipStream_t stream) {
    static int grid = 0;
    if (grid == 0) {
        if (n_in != 20 || (size_t)out_size != O_END || ws_size < WS_END) { fprintf(stderr, "kernel_launch: unexpected shapes (n_in %d, out %d, ws %zu)\n", n_in, out_size, ws_size); grid = -1; return; }
        int dev = 0, cus = 0, per_cu = 0;
        if (hipGetDevice(&dev) != hipSuccess || hipDeviceGetAttribute(&cus, hipDeviceAttributeMultiprocessorCount, dev) != hipSuccess) { grid = -1; return; }
        if (hipFuncSetAttribute((const void*)hymba_fwd, hipFuncAttributeMaxDynamicSharedMemorySize, LDS_BYTES) != hipSuccess) { fprintf(stderr, "kernel_launch: hipFuncSetAttribute failed\n"); grid = -1; return; }
        if (hipOccupancyMaxActiveBlocksPerMultiprocessor(&per_cu, (const void*)hymba_fwd, NTHREADS, LDS_BYTES) != hipSuccess || per_cu < 1) { fprintf(stderr, "kernel_launch: occupancy query says %d\n", per_cu); }
        (void)hipGetLastError();
        grid = cus;
    }
    if (grid < 0) return;
    (void)hipMemsetAsync((char*)d_ws + WS_CTL, 0, CTL_ZERO_BYTES, stream);
    Args a{};
    for (int i = 0; i < 20; ++i) a.in[i] = d_in[i];
    a.out = (float*)d_out; a.ws = (unsigned char*)d_ws;
    for (int li = 0; li < MK_N_LAUNCHES; ++li) {
        if (MK_N_LAUNCHES == 1) { a.ph_lo = 0; a.ph_hi = N_PHASES; } else { a.ph_lo = li; a.ph_hi = li + 1; }
        a.li = (MK_N_LAUNCHES == N_PHASES) ? 0 : li; a.pad = 0;
#ifdef DBG_UFULL
        if (li == 7) { Args a2 = a; a2.ph_lo = 100; a2.ph_hi = 101; hipLaunchKernelGGL(hymba_fwd, dim3(grid), dim3(NTHREADS), LDS_BYTES, stream, a2); }
#endif
        hipLaunchKernelGGL(hymba_fwd, dim3(grid), dim3(NTHREADS), LDS_BYTES, stream, a);
    }
#ifdef DBG_CMP
    { Args a3 = a; a3.ph_lo = 101; a3.ph_hi = 102; hipLaunchKernelGGL(hymba_fwd, dim3(grid), dim3(NTHREADS), LDS_BYTES, stream, a3); }
#endif
#ifdef DBG_CHECK
    { Args a3 = a; a3.ph_lo = 102; a3.ph_hi = 103; hipLaunchKernelGGL(hymba_fwd, dim3(grid), dim3(NTHREADS), LDS_BYTES, stream, a3);
      a3.ph_lo = 101; a3.ph_hi = 102; hipLaunchKernelGGL(hymba_fwd, dim3(grid), dim3(NTHREADS), LDS_BYTES, stream, a3); }
#endif
}
```

```cpp
#include <hip/hip_runtime.h>
#include <cstdio>
#include <cstdint>

#define GAS __attribute__((address_space(1)))
#define LAS __attribute__((address_space(3)))
typedef unsigned short u16;
typedef short bf16x8 __attribute__((ext_vector_type(8)));
typedef short s16x4 __attribute__((ext_vector_type(4)));
typedef float f32x4 __attribute__((ext_vector_type(4)));
typedef float f32x2 __attribute__((ext_vector_type(2)));
typedef float f32x16 __attribute__((ext_vector_type(16)));
typedef unsigned u32x4 __attribute__((ext_vector_type(4)));
typedef unsigned u32x2 __attribute__((ext_vector_type(2)));
typedef GAS unsigned gu32;

constexpr int DM = 2048, BP = 2, TP = 4096, MP = BP * TP, BS = 8, TS = 8, MS = BS * TS, MT = MP + MS;
constexpr int MW = 1024, AW = 1024, MH = 4, MD = 256, AH = 8, AD = 128, CH = 128, NCH = TP / CH;
constexpr int DFF = 5632, NUP = 2 * DFF, NIN = 7176, NING = 7168;
constexpr int PAST = 16384, PAGE = 128, NPAGES = PAST / PAGE, NBS = PAST / 256;
constexpr float EPS = 1e-6f;
constexpr float ATT_SCALE = 0.08838834764831845f;

constexpr size_t O_YP = 0, O_YS = O_YP + (size_t)MP * DM, O_KP = O_YS + (size_t)MS * DM, O_VP = O_KP + (size_t)MP * AW, O_KS = O_VP + (size_t)MP * AW,
                 O_VS = O_KS + (size_t)MS * AW, O_CP = O_VS + (size_t)MS * AW, O_NP = O_CP + (size_t)BP * MH * MD * MD, O_MP = O_NP + (size_t)BP * MH * MD,
                 O_CS = O_MP + (size_t)BP * MH, O_NS = O_CS + (size_t)BS * MH * MD * MD, O_MS = O_NS + (size_t)BS * MH * MD, O_CVP = O_MS + (size_t)BS * MH,
                 O_CVS = O_CVP + (size_t)BP * 2 * NUP, O_END = O_CVS + (size_t)BS * 2 * NUP;

__device__ __forceinline__ unsigned f2bf(float f) { unsigned u = __builtin_bit_cast(unsigned, f); return (u + 0x7fffu + ((u >> 16) & 1u)) >> 16; }
__device__ __forceinline__ float bf2f(unsigned h) { return __builtin_bit_cast(float, h << 16); }
__device__ __forceinline__ float bflo(unsigned w) { return __builtin_bit_cast(float, w << 16); }
__device__ __forceinline__ float bfhi(unsigned w) { return __builtin_bit_cast(float, w & 0xffff0000u); }
typedef __bf16 bf16x2_t __attribute__((ext_vector_type(2)));
__device__ __forceinline__ unsigned cvtpk(float lo, float hi) { f32x2 v = {lo, hi}; bf16x2_t b = __builtin_convertvector(v, bf16x2_t); return __builtin_bit_cast(unsigned, b); }
__device__ __forceinline__ unsigned cvtpk_asm(float lo, float hi) { unsigned r; asm volatile("v_cvt_pk_bf16_f32 %0, %1, %2" : "=v"(r) : "v"(lo), "v"(hi)); return r; }
__device__ __forceinline__ u32x4 pack8f(f32x4 a, f32x4 b) { u32x4 w; w.x = cvtpk(a[0], a[1]); w.y = cvtpk(a[2], a[3]); w.z = cvtpk(b[0], b[1]); w.w = cvtpk(b[2], b[3]); return w; }
__device__ __forceinline__ f32x4 ldg4(const float* p) { return *(const GAS f32x4*)p; }
__device__ __forceinline__ void stg4(float* p, f32x4 v) { *(GAS f32x4*)p = v; }
__device__ __forceinline__ u32x4 ldgu4(const void* p) { return *(const GAS u32x4*)p; }
__device__ __forceinline__ void stgu4(void* p, u32x4 v) { *(GAS u32x4*)p = v; }
__device__ __forceinline__ u32x2 ldgu2(const void* p) { return *(const GAS u32x2*)p; }
__device__ __forceinline__ void stgu2(void* p, u32x2 v) { *(GAS u32x2*)p = v; }
__device__ __forceinline__ float ldgf(const float* p) { return *(const GAS float*)p; }
__device__ __forceinline__ void stgf(float* p, float v) { *(GAS float*)p = v; }
__device__ __forceinline__ void stg4_sc1(float* p, f32x4 v) { asm volatile("global_store_dwordx4 %0, %1, off sc1" :: "v"((GAS float*)p), "v"(v) : "memory"); }
__device__ __forceinline__ float wave_sum(float v) {
#pragma unroll
    for (int o = 1; o < 64; o <<= 1) v += __shfl_xor(v, o);
    return v;
}
__device__ __forceinline__ float wave_max(float v) {
#pragma unroll
    for (int o = 1; o < 64; o <<= 1) v = fmaxf(v, __shfl_xor(v, o));
    return v;
}
__device__ __forceinline__ float dot4(f32x4 a, f32x4 b) { return (a[0] * b[0] + a[1] * b[1]) + (a[2] * b[2] + a[3] * b[3]); }
__device__ __forceinline__ float sigmoidf_(float x) { return 1.0f / (1.0f + __expf(-x)); }
__device__ __forceinline__ int tid_of(int wave) { unsigned ones = ~0u; asm volatile("" : "+s"(ones));
    return wave * 64 + (int)__builtin_amdgcn_mbcnt_hi(ones, __builtin_amdgcn_mbcnt_lo(ones, 0u)); }
#define LDS_WAIT() asm volatile("s_waitcnt lgkmcnt(0)" ::: "memory")
#define VM_WAIT() asm volatile("s_waitcnt vmcnt(0)" ::: "memory")
#define WG_BAR() do { asm volatile("s_waitcnt lgkmcnt(0)" ::: "memory"); __builtin_amdgcn_s_barrier(); asm volatile("" ::: "memory"); } while (0)
namespace pg8 {
#define PG8_LAS __attribute__((address_space(3)))
typedef unsigned short bf16_t;
typedef short bf16x8 __attribute__((ext_vector_type(8)));
typedef float f32x4 __attribute__((ext_vector_type(4)));
typedef unsigned u32x4 __attribute__((ext_vector_type(4)));
constexpr int BM = 256, BK = 64, HALF = 128, HTB = HALF * BK * 2  , STAGE_BYTES = 8 * HTB, NXCD = 8, WGM = 8;

__host__ __device__ __forceinline__ int lds_byte(int r, int c) { const int st = (r >> 4) * 2 + (c >> 5), rr = r & 15, cc = c & 31, ob = rr * 64 + cc * 2; return st * 1024 + (ob ^ (((ob >> 9) & 1) << 5)); }
__host__ __device__ __forceinline__ void stage_rc(int b, int& R, int& C) { const int st = b / 1024, sb = b % 1024, swz = sb ^ (((sb >> 9) & 1) << 5); R = (st >> 1) * 16 + swz / 64; C = (st & 1) * 32 + (swz % 64) / 2; }
__host__ __device__ __forceinline__ int perm32(int rho) { const int n = rho >> 4, i = rho & 15; return 8 * (i >> 2) + 4 * n + (i & 3); }

struct Unit { int pm, pn; };
struct Gemm { const bf16_t* A; const bf16_t* Bt; int M, N, K; };

struct StaticOrder {
    int nM, nN, nwg, G, c;
    __host__ __device__ void init(int M, int N, int G_, int c_) { nM = M / BM; nN = N / BM; nwg = nM * nN; G = G_; c = c_; }
    __host__ __device__ bool next(int i, Unit& u) const {
        const long L = (long)i * G + c; if (L >= nwg) return false;
        int wgid = (int)L; { const int q = nwg / NXCD, r = nwg % NXCD, xcd = wgid % NXCD, off = wgid / NXCD; wgid = (xcd < r ? xcd * (q + 1) : r * (q + 1) + (xcd - r) * q) + off; }
        const int nig = WGM * nN, gid = wgid / nig, fm = gid * WGM, gsz = (nM - fm) < WGM ? (nM - fm) : WGM;
        u.pm = fm + ((wgid % nig) % gsz); u.pn = (wgid % nig) / gsz; return true;
    }
    __device__ __forceinline__ void a_ready(const Unit&) const {}
    __device__ __forceinline__ void done(const Unit&) const {}
};

__device__ __forceinline__ unsigned cvt_pk_bf16(float lo, float hi) { unsigned r; asm volatile("v_cvt_pk_bf16_f32 %0, %1, %2" : "=v"(r) : "v"(lo), "v"(hi)); return r; }
template <class Epi, class Sched, bool ALIGN_EPI = false, bool SP2 = false>
__device__ __forceinline__ void gemm_phase(PG8_LAS unsigned char* lds, const Gemm g, const Sched& S, const Epi& E, const int tid) {
    const int wid = __builtin_amdgcn_readfirstlane(tid >> 6), lane = tid & 63, wr = wid >> 2, wc = wid & 3, fr = lane & 15, fq = lane >> 4;
    const int K = g.K, nt = K / BK;
    unsigned voffA[2], voffB[2];
#pragma unroll
    for (int i = 0; i < 2; ++i) { int R, C; stage_rc(tid * 16 + i * 8192, R, C); const int Rb = Epi::PERM ? ((R & ~31) + perm32(R & 31)) : R;
        voffA[i] = (unsigned)(R * K + C) * 2u; voffB[i] = (unsigned)(Rb * K + C) * 2u; }
    const size_t kstep = (size_t)(BK * 2);
    const size_t hstep = (size_t)HALF * K * 2;
    const size_t tstep = 2 * hstep;
    const unsigned ldsw = (unsigned)wid * 1024u;
    const int aoff = lds_byte(wr * 64 + fr, fq * 8), boff = lds_byte(wc * 32 + fr, fq * 8);
#define PG8_SA(b, h) (((b) * 2 + (h)) * HTB)
#define PG8_SB(b, h) ((4 + (b) * 2 + (h)) * HTB)
#define PG8_STAGE(bufoff, gbase, voff) do { _Pragma("unroll") for (int _i = 0; _i < 2; ++_i) \
        __builtin_amdgcn_global_load_lds((const unsigned*)((const char*)(gbase) + (voff)[_i]), (PG8_LAS unsigned*)(lds + (bufoff) + ldsw + _i * 8192), 16, 0, 0); } while (0)
#define PG8_LDA(dst, b, h) do { _Pragma("unroll") for (int m = 0; m < 4; ++m) _Pragma("unroll") for (int k = 0; k < 2; ++k) dst[m][k] = *(const PG8_LAS bf16x8*)(lds + PG8_SA(b, h) + aoff + m * 2048 + k * 1024); } while (0)
#define PG8_LDB(dst, b, h) do { _Pragma("unroll") for (int n = 0; n < 2; ++n) _Pragma("unroll") for (int k = 0; k < 2; ++k) dst[n][k] = *(const PG8_LAS bf16x8*)(lds + PG8_SB(b, h) + boff + n * 2048 + k * 1024); } while (0)
#define PG8_MMA(ai, bj, At, Bt) do { __builtin_amdgcn_s_setprio(1); _Pragma("unroll") for (int m = 0; m < 4; ++m) _Pragma("unroll") for (int n = 0; n < 2; ++n) _Pragma("unroll") for (int k = 0; k < 2; ++k) \
        acc[ai][bj][m][n] = __builtin_amdgcn_mfma_f32_16x16x32_bf16(Bt[n][k], At[m][k], acc[ai][bj][m][n], 0, 0, 0); __builtin_amdgcn_s_setprio(0); } while (0)
#define PG8_WAIT_V(n) asm volatile("s_waitcnt vmcnt(" #n ")" ::: "memory")
#define PG8_WAIT_L(n) asm volatile("s_waitcnt lgkmcnt(" #n ")" ::: "memory")
#define PG8_BAR __builtin_amdgcn_s_barrier()
#define PG8_SCHED __builtin_amdgcn_sched_barrier(0)
    Unit cur, nxt; int ui = 0;
    if (!S.next(0, cur)) return;
    f32x4 acc[2][2][4][2];
#pragma unroll
    for (int a = 0; a < 2; ++a)
#pragma unroll
        for (int b = 0; b < 2; ++b)
#pragma unroll
            for (int m = 0; m < 4; ++m)
#pragma unroll
                for (int n = 0; n < 2; ++n) acc[a][b][m][n] = (f32x4){0.f, 0.f, 0.f, 0.f};
    bf16x8 At[4][2], B0[2][2], B1[2][2];
    const char* cA = (const char*)g.A + (size_t)cur.pm * tstep; const char* cB = (const char*)g.Bt + (size_t)cur.pn * tstep;
    S.a_ready(cur);
    if constexpr (SP2) {
        PG8_STAGE(PG8_SB(0, 0), cB, voffB); PG8_STAGE(PG8_SB(0, 1), cB + hstep, voffB); PG8_STAGE(PG8_SA(0, 0), cA, voffA); PG8_STAGE(PG8_SA(0, 1), cA + hstep, voffA);
        if (wr == 1) PG8_BAR;
        PG8_WAIT_V(2); PG8_BAR;
        PG8_STAGE(PG8_SB(1, 0), cB + kstep, voffB); PG8_STAGE(PG8_SA(1, 0), cA + kstep, voffA); PG8_STAGE(PG8_SB(1, 1), cB + hstep + kstep, voffB);
        PG8_WAIT_V(6); PG8_BAR;
    } else {
        PG8_STAGE(PG8_SB(0, 0), cB, voffB); PG8_STAGE(PG8_SA(0, 0), cA, voffA); PG8_STAGE(PG8_SB(0, 1), cB + hstep, voffB); PG8_STAGE(PG8_SA(0, 1), cA + hstep, voffA);
        if (wr == 1) PG8_BAR;
        PG8_WAIT_V(4); PG8_BAR;
        PG8_STAGE(PG8_SB(1, 0), cB + kstep, voffB); PG8_STAGE(PG8_SA(1, 0), cA + kstep, voffA); PG8_STAGE(PG8_SB(1, 1), cB + hstep + kstep, voffB);
        PG8_WAIT_V(6); PG8_BAR;
    }
    for (;;) {
        const bool has_next = S.next(ui + 1, nxt);
        const char* nA = has_next ? (const char*)g.A + (size_t)nxt.pm * tstep : cA; const char* nB = has_next ? (const char*)g.Bt + (size_t)nxt.pn * tstep : cB;
        for (int t = 0; t < nt; t += 2) {
            const bool last = (t == nt - 2);
            const char* a1 = cA + (size_t)(t + 1) * kstep;
            const char* a2 = last ? nA : cA + (size_t)(t + 2) * kstep; const char* b2 = last ? nB : cB + (size_t)(t + 2) * kstep;
            const char* a3 = a2 + kstep; const char* b3 = b2 + kstep;
            if (last && has_next) S.a_ready(nxt);
            if constexpr (SP2) {
            PG8_LDB(B0, 0, 0); PG8_LDB(B1, 0, 1); PG8_SCHED; PG8_LDA(At, 0, 0); PG8_STAGE(PG8_SA(1, 1), a1 + hstep, voffA);
            PG8_WAIT_V(8); PG8_WAIT_L(0); PG8_BAR; PG8_MMA(0, 0, At, B0); PG8_MMA(0, 1, At, B1); PG8_BAR; PG8_SCHED;
            PG8_LDA(At, 0, 1); PG8_STAGE(PG8_SB(0, 0), b2, voffB); PG8_STAGE(PG8_SB(0, 1), b2 + hstep, voffB); PG8_STAGE(PG8_SA(0, 0), a2, voffA);
            PG8_WAIT_V(8); PG8_WAIT_L(0); PG8_BAR; PG8_MMA(1, 0, At, B0); PG8_MMA(1, 1, At, B1); PG8_BAR; PG8_SCHED;
            PG8_LDB(B0, 1, 0); PG8_LDB(B1, 1, 1); PG8_SCHED; PG8_LDA(At, 1, 0); PG8_STAGE(PG8_SA(0, 1), a2 + hstep, voffA);
            PG8_WAIT_V(8); PG8_WAIT_L(0); PG8_BAR; PG8_MMA(0, 0, At, B0); PG8_MMA(0, 1, At, B1); PG8_BAR; PG8_SCHED;
            PG8_LDA(At, 1, 1); PG8_STAGE(PG8_SB(1, 0), b3, voffB); PG8_STAGE(PG8_SB(1, 1), b3 + hstep, voffB); PG8_STAGE(PG8_SA(1, 0), a3, voffA);
            PG8_WAIT_V(8); PG8_WAIT_L(0); PG8_BAR; PG8_MMA(1, 0, At, B0); PG8_MMA(1, 1, At, B1); PG8_BAR; PG8_SCHED;
            } else {
            PG8_LDB(B0, 0, 0); PG8_SCHED; PG8_LDA(At, 0, 0); PG8_STAGE(PG8_SA(1, 1), a1 + hstep, voffA);
            PG8_WAIT_L(8); PG8_BAR; PG8_WAIT_L(0); PG8_MMA(0, 0, At, B0); PG8_BAR; PG8_SCHED;
            PG8_LDB(B1, 0, 1); PG8_STAGE(PG8_SB(0, 0), b2, voffB);
            PG8_BAR; PG8_WAIT_L(0); PG8_MMA(0, 1, At, B1); PG8_BAR;
            PG8_LDA(At, 0, 1); PG8_STAGE(PG8_SA(0, 0), a2, voffA);
            PG8_BAR; PG8_WAIT_L(0); PG8_MMA(1, 0, At, B0); PG8_BAR; PG8_SCHED;
            PG8_STAGE(PG8_SB(0, 1), b2 + hstep, voffB);
            PG8_WAIT_V(6); PG8_BAR; PG8_MMA(1, 1, At, B1); PG8_BAR;
            PG8_LDB(B0, 1, 0); PG8_SCHED; PG8_LDA(At, 1, 0); PG8_STAGE(PG8_SA(0, 1), a2 + hstep, voffA);
            PG8_WAIT_L(8); PG8_BAR; PG8_WAIT_L(0); PG8_MMA(0, 0, At, B0); PG8_BAR; PG8_SCHED;
            PG8_LDB(B1, 1, 1); PG8_STAGE(PG8_SB(1, 0), b3, voffB);
            PG8_BAR; PG8_WAIT_L(0); PG8_MMA(0, 1, At, B1); PG8_BAR;
            PG8_LDA(At, 1, 1); PG8_STAGE(PG8_SA(1, 0), a3, voffA);
            PG8_BAR; PG8_WAIT_L(0); PG8_MMA(1, 0, At, B0); PG8_BAR; PG8_SCHED;
            PG8_STAGE(PG8_SB(1, 1), b3 + hstep, voffB);
            PG8_WAIT_V(6); PG8_BAR; PG8_MMA(1, 1, At, B1); PG8_BAR;
            }
        }
        if constexpr (ALIGN_EPI) { if (wr == 0) PG8_BAR; }
        if constexpr (!Epi::AFTER_DRAIN) { E(acc, cur, wr, wc, fr, fq); S.done(cur); }
        if (!has_next) break;
#pragma unroll
        for (int a = 0; a < 2; ++a)
#pragma unroll
            for (int b = 0; b < 2; ++b)
#pragma unroll
                for (int m = 0; m < 4; ++m)
#pragma unroll
                    for (int n = 0; n < 2; ++n) acc[a][b][m][n] = (f32x4){0.f, 0.f, 0.f, 0.f};
        cur = nxt; cA = nA; cB = nB; ++ui;
        if constexpr (ALIGN_EPI) { if (wr == 1) PG8_BAR; }
    }
    PG8_WAIT_V(0);
    if constexpr (!ALIGN_EPI) { if (wr == 0) PG8_BAR; }
    PG8_BAR;
    if constexpr (Epi::AFTER_DRAIN) { E.fused(acc, cur, wr, wc, fr, fq, lds, wid, lane); S.done(cur); }
#undef PG8_SA
#undef PG8_SB
#undef PG8_STAGE
#undef PG8_LDA
#undef PG8_LDB
#undef PG8_MMA
#undef PG8_WAIT_V
#undef PG8_WAIT_L
#undef PG8_BAR
#undef PG8_SCHED
}
}

using pg8::Unit;

struct EpiIn {
    static constexpr bool PERM = true, AFTER_DRAIN = false;
    u16 *MQ, *AQ; float *kout; const float *rcos, *rsin;
    __device__ __forceinline__ void operator()(f32x4 (&acc)[2][2][4][2], const Unit& u, int wr, int wc, int fr, int fq) const {
        const int row0 = u.pm * 256 + wr * 64 + fr;
        if (u.pn < 16) {
            const int sec = u.pn >> 2; u16* base = MQ + (size_t)sec * (8u << 20); const float sc = (sec == 1) ? 0.0625f : 1.0f;
            const int col0 = (u.pn & 3) * 256 + wc * 32 + 8 * fq;
#pragma unroll
            for (int ai = 0; ai < 2; ++ai)
#pragma unroll
                for (int m = 0; m < 4; ++m) { u16* rowp = base + (size_t)(row0 + ai * 128 + m * 16) * MW + col0;
#pragma unroll
                    for (int bj = 0; bj < 2; ++bj) stgu4(rowp + bj * 128, pack8f(acc[ai][bj][m][0] * sc, acc[ai][bj][m][1] * sc)); }
        } else {
            const int a = u.pn - 16, sec = a >> 2, pt = a & 3, head = 2 * pt + (wc >> 1), dl0 = 32 * (wc & 1) + 8 * fq, b = u.pm >> 4;
            u16* dbase = AQ + (size_t)sec * (8u << 20) + (size_t)(b * AH + head) * TP * AD;
            float* fbase = kout + (size_t)(sec == 2 ? 1 : 0) * ((size_t)MP * AW) + (size_t)b * TP * AW + head * AD;
#pragma unroll
            for (int ai = 0; ai < 2; ++ai)
#pragma unroll
                for (int m = 0; m < 4; ++m) {
                    const int t = (row0 + ai * 128 + m * 16) & (TP - 1);
                    f32x4 x1a = acc[ai][0][m][0], x1b = acc[ai][0][m][1], x2a = acc[ai][1][m][0], x2b = acc[ai][1][m][1];
                    if (sec < 2) {
                        const f32x4 c0 = ldg4(rcos + t * 64 + dl0), c1 = ldg4(rcos + t * 64 + dl0 + 4), s0 = ldg4(rsin + t * 64 + dl0), s1 = ldg4(rsin + t * 64 + dl0 + 4);
                        const f32x4 o1a = x1a * c0 - x2a * s0, o2a = x2a * c0 + x1a * s0, o1b = x1b * c1 - x2b * s1, o2b = x2b * c1 + x1b * s1;
                        x1a = o1a; x2a = o2a; x1b = o1b; x2b = o2b;
                    }
                    u16* dst = dbase + (size_t)t * AD + dl0;
                    stgu4(dst, pack8f(x1a, x1b)); stgu4(dst + 64, pack8f(x2a, x2b));
                    if (sec >= 1) { float* fo = fbase + (size_t)t * AW + dl0; stg4(fo, x1a); stg4(fo + 4, x1b); stg4(fo + 64, x2a); stg4(fo + 68, x2b); }
                }
        }
    }
};

template <bool WITH_G> struct EpiRes {
    static constexpr bool PERM = true, AFTER_DRAIN = false;
    const float* res; float* out; u16* outg; const float* g; float* SS;
    __device__ __forceinline__ void operator()(f32x4 (&acc)[2][2][4][2], const Unit& u, int wr, int wc, int fr, int fq) const {
        const int row0 = u.pm * 256 + wr * 64 + fr, col0 = u.pn * 256 + wc * 32 + 8 * fq;
        f32x4 gv[2][2];
        if (WITH_G) {
#pragma unroll
            for (int bj = 0; bj < 2; ++bj)
#pragma unroll
                for (int n = 0; n < 2; ++n) gv[bj][n] = ldg4(g + col0 + bj * 128 + 4 * n);
        }
#pragma unroll
        for (int ai = 0; ai < 2; ++ai)
#pragma unroll
            for (int m = 0; m < 4; ++m) {
                const int row = row0 + ai * 128 + m * 16; const size_t off = (size_t)row * DM + col0; float ss = 0.f;
#pragma unroll
                for (int bj = 0; bj < 2; ++bj) {
                    const f32x4 v0 = acc[ai][bj][m][0] + ldg4(res + off + bj * 128), v1 = acc[ai][bj][m][1] + ldg4(res + off + bj * 128 + 4);
                    stg4(out + off + bj * 128, v0); stg4(out + off + bj * 128 + 4, v1);
                    ss += dot4(v0, v0) + dot4(v1, v1);
                    if (WITH_G) stgu4(outg + off + bj * 128, pack8f(v0 * gv[bj][0], v1 * gv[bj][1]));
                }
                ss += __shfl_xor(ss, 16); ss += __shfl_xor(ss, 32);
                if (fq == 0) stgf(SS + (size_t)row * 32 + u.pn * 4 + wc, ss);
            }
    }
};

__device__ __forceinline__ float dpp_ror1f(float x) { return __int_as_float(__builtin_amdgcn_mov_dpp(__float_as_int(x), 0x121, 0xf, 0xf, false)); }
__device__ __forceinline__ float dpp_ror2f(float x) { return __int_as_float(__builtin_amdgcn_mov_dpp(__float_as_int(x), 0x122, 0xf, 0xf, false)); }
__device__ __forceinline__ f32x4 dpp_ror1(f32x4 v) { f32x4 r; r.x = dpp_ror1f(v.x); r.y = dpp_ror1f(v.y); r.z = dpp_ror1f(v.z); r.w = dpp_ror1f(v.w); return r; }
__device__ __forceinline__ f32x4 dpp_ror2(f32x4 v) { f32x4 r; r.x = dpp_ror2f(v.x); r.y = dpp_ror2f(v.y); r.z = dpp_ror2f(v.z); r.w = dpp_ror2f(v.w); return r; }
__device__ __forceinline__ f32x4 silu_mul(f32x4 g, f32x4 up) { f32x4 r;
#pragma unroll
    for (int i = 0; i < 4; ++i) r[i] = g[i] * __builtin_amdgcn_rcpf(1.0f + __builtin_amdgcn_exp2f(-1.4426950408889634f * g[i])) * up[i]; return r; }

__device__ __forceinline__ void up_fixup(int P, int pn, const float* UB, const float* conv_w, const float* conv_b, u16* ACT, int tid) {
    if (tid < 128) {
        const int j = tid;
        const float* ua = UB + ((size_t)(P - 1) * 4 + 2) * NUP + pn * 256;
        const float* ub = UB + ((size_t)P * 4 + 0) * NUP + pn * 256;
        float cv[2][2];
#pragma unroll
        for (int h = 0; h < 2; ++h) {
            const int tc = h * 128 + j, oc = h * DFF + pn * 128 + j;
            const float um2 = ldgf(ua + tc), um1 = ldgf(ua + NUP + tc), u0 = ldgf(ub + tc), u1 = ldgf(ub + NUP + tc);
            const float w0 = ldgf(conv_w + oc), w1 = ldgf(conv_w + NUP + oc), w2 = ldgf(conv_w + 2 * NUP + oc), cb = ldgf(conv_b + oc);
            cv[h][0] = cb + w0 * um2 + w1 * um1 + w2 * u0; cv[h][1] = cb + w0 * um1 + w1 * u0 + w2 * u1;
        }
#pragma unroll
        for (int r = 0; r < 2; ++r) { const float g = cv[0][r]; const float a = g / (1.0f + __expf(-g)) * cv[1][r];
            *(GAS u16*)(ACT + (size_t)(P * 256 + r) * DFF + pn * 128 + j) = (u16)f2bf(a); }
    }
}

struct EpiUp {
    static constexpr bool PERM = true, AFTER_DRAIN = false;
    LAS unsigned char* xl;
    const float* SS1; const float *conv_w, *conv_b; u16* ACT; float* UB; gu32* cnt; float* conv_out; void* dbg_ufull;
    __device__ __forceinline__ void operator()(f32x4 (&acc)[2][2][4][2], const Unit& u, int wr, int wc, int fr, int fq) const {
        const int tid = (wr * 4 + wc) * 64 + fq * 16 + fr;
        LAS float* XCH = (LAS float*)xl; LAS float* RS = (LAS float*)(xl + 8192); volatile LAS unsigned* FL = (volatile LAS unsigned*)(xl + 8192 + 1024);
        { const int row = tid >> 1, half = tid & 1; const float* p = SS1 + (size_t)(u.pm * 256 + row) * 32 + half * 16;
          const f32x4 a = ldg4(p), b = ldg4(p + 4), c = ldg4(p + 8), d = ldg4(p + 12);
          float s = ((a[0] + a[1]) + (a[2] + a[3])) + ((b[0] + b[1]) + (b[2] + b[3])) + ((c[0] + c[1]) + (c[2] + c[3])) + ((d[0] + d[1]) + (d[2] + d[3]));
          s += __shfl_xor(s, 1);
          if (half == 0) RS[row] = 1.0f / sqrtf(s * (1.0f / DM) + EPS); }
        WG_BAR();
#pragma unroll
        for (int ai = 0; ai < 2; ++ai)
#pragma unroll
            for (int m = 0; m < 4; ++m) { const float rs = RS[ai * 128 + wr * 64 + m * 16 + fr];
#pragma unroll
                for (int bj = 0; bj < 2; ++bj)
#pragma unroll
                    for (int n = 0; n < 2; ++n) acc[ai][bj][m][n] = acc[ai][bj][m][n] * rs; }
#ifdef DBG_UFULL
        { float* UF = (float*)dbg_ufull;
#pragma unroll
          for (int ai = 0; ai < 2; ++ai)
#pragma unroll
            for (int m = 0; m < 4; ++m)
#pragma unroll
              for (int bj = 0; bj < 2; ++bj)
#pragma unroll
                for (int n = 0; n < 2; ++n) stg4(UF + (size_t)(u.pm * 256 + ai * 128 + wr * 64 + m * 16 + fr) * NUP + u.pn * 256 + bj * 128 + 32 * wc + 8 * fq + 4 * n, acc[ai][bj][m][n]); }
#endif
        const bool bstart = (u.pm & 15) == 0, bend = (u.pm & 15) == 15;
        const int tcl = 32 * wc + 8 * fq;
#pragma unroll
        for (int ai = 0; ai < 2; ++ai) {
            const int g = ai * 2 + wr;
            if (fr >= 14) {
#pragma unroll
                for (int bj = 0; bj < 2; ++bj)
#pragma unroll
                    for (int n = 0; n < 2; ++n) *(LAS f32x4*)(XCH + (g * 2 + (fr - 14)) * 256 + bj * 128 + tcl + 4 * n) = acc[ai][bj][3][n];
                if (g == 3) {
#pragma unroll
                    for (int bj = 0; bj < 2; ++bj)
#pragma unroll
                        for (int n = 0; n < 2; ++n) {
                            if (!bend) stg4_sc1(UB + ((size_t)u.pm * 4 + 2 + (fr - 14)) * NUP + u.pn * 256 + bj * 128 + tcl + 4 * n, acc[ai][bj][3][n]);
                            else stg4(conv_out + ((size_t)(u.pm >> 4) * 2 + (fr - 14)) * NUP + bj * DFF + u.pn * 128 + tcl + 4 * n, acc[ai][bj][3][n]);
                        }
                }
            }
            if (g == 0 && fr < 2 && !bstart) {
#pragma unroll
                for (int bj = 0; bj < 2; ++bj)
#pragma unroll
                    for (int n = 0; n < 2; ++n) stg4_sc1(UB + ((size_t)u.pm * 4 + fr) * NUP + u.pn * 256 + bj * 128 + tcl + 4 * n, acc[ai][bj][0][n]);
            }
        }
        asm volatile("s_waitcnt vmcnt(0)" ::: "memory");
        WG_BAR();
        if (tid == 0) {
            unsigned f0 = 0u, f1 = 0u;
            if (!bstart) f0 = (__hip_atomic_fetch_add(cnt + u.pm * 44 + u.pn, 1u, __ATOMIC_RELAXED, __HIP_MEMORY_SCOPE_AGENT) == 1u) ? 1u : 0u;
            if (!bend) f1 = (__hip_atomic_fetch_add(cnt + (u.pm + 1) * 44 + u.pn, 1u, __ATOMIC_RELAXED, __HIP_MEMORY_SCOPE_AGENT) == 1u) ? 1u : 0u;
            if (f0 | f1) { __builtin_amdgcn_fence(__ATOMIC_ACQUIRE, "agent"); asm volatile("s_waitcnt vmcnt(0)" ::: "memory"); }
            FL[0] = f0; FL[1] = f1;
        }
#pragma unroll
        for (int n = 0; n < 2; ++n) {
            f32x4 cw[2][3], cbv[2];
#pragma unroll
            for (int bj = 0; bj < 2; ++bj) { const int oc = bj * DFF + u.pn * 128 + tcl + 4 * n;
                cw[bj][0] = ldg4(conv_w + oc); cw[bj][1] = ldg4(conv_w + NUP + oc); cw[bj][2] = ldg4(conv_w + 2 * NUP + oc); cbv[bj] = ldg4(conv_b + oc); }
#pragma unroll
            for (int ai = 0; ai < 2; ++ai) {
                const int g = ai * 2 + wr;
#pragma unroll
                for (int m = 0; m < 4; ++m) {
                    f32x4 cv[2];
#pragma unroll
                    for (int bj = 0; bj < 2; ++bj) {
                        const f32x4 cur = acc[ai][bj][m][n]; const f32x4 a1 = dpp_ror1(cur), a2 = dpp_ror2(cur); f32x4 p1, p2;
                        if (m > 0) { const f32x4 b1 = dpp_ror1(acc[ai][bj][m - 1][n]), b2 = dpp_ror2(acc[ai][bj][m - 1][n]);
#pragma unroll
                            for (int i = 0; i < 4; ++i) { p1[i] = fr == 0 ? b1[i] : a1[i]; p2[i] = fr < 2 ? b2[i] : a2[i]; } }
                        else { f32x4 X0 = (f32x4){0.f, 0.f, 0.f, 0.f}, X1 = X0;
                            if (g > 0) { X0 = *(LAS f32x4*)(XCH + ((g - 1) * 2 + 0) * 256 + bj * 128 + tcl + 4 * n); X1 = *(LAS f32x4*)(XCH + ((g - 1) * 2 + 1) * 256 + bj * 128 + tcl + 4 * n); }
#pragma unroll
                            for (int i = 0; i < 4; ++i) { p1[i] = fr == 0 ? X1[i] : a1[i]; p2[i] = fr == 0 ? X0[i] : (fr == 1 ? X1[i] : a2[i]); } }
                        cv[bj] = cbv[bj] + cw[bj][0] * p2 + cw[bj][1] * p1 + cw[bj][2] * cur;
                    }
                    const f32x4 a = silu_mul(cv[0], cv[1]);
                    const bool skip = (g == 0 && m == 0 && fr < 2 && !bstart);
                    if (!skip) { u32x2 w; w.x = cvtpk(a[0], a[1]); w.y = cvtpk(a[2], a[3]);
                        stgu2(ACT + (size_t)(u.pm * 256 + g * 64 + m * 16 + fr) * DFF + u.pn * 128 + tcl + 4 * n, w); }
                }
            }
        }
        WG_BAR();
        const unsigned f0 = FL[0], f1 = FL[1];
        if (f0) up_fixup(u.pm, u.pn, UB, conv_w, conv_b, ACT, tid);
        if (f1) up_fixup(u.pm + 1, u.pn, UB, conv_w, conv_b, ACT, tid);
        WG_BAR();
    }
};

namespace moba {
constexpr int D = 128, NW = 8, QBLK = 32, KVBLK = 64, QB = NW * QBLK;
constexpr int SHM_V = KVBLK * D * 2, SHM_K = KVBLK * D * 2;
constexpr int ATT_LDS = 2 * SHM_V + 2 * SHM_K + NW * 64 * 4;
constexpr float SCALE = 0.08838834764831845f, THR = 8.f;
constexpr int OSTRIDE = 2048;
constexpr int QLDS_OFF = 81920;
#define KSWZ(row, colB) ((row) * 256 + ((colB) ^ (((row) & 7) << 4)))
#define SBAR() __builtin_amdgcn_sched_barrier(0)
__device__ __forceinline__ int v_st(int k, int c) { const int kk = (k & ~0xC) | ((k & 4) << 1) | ((k & 8) >> 1); return ((kk >> 3) * 4 + (c >> 5)) * 512 + ((kk & 7) * 32 + (c & 31)) * 2; }
__device__ __forceinline__ int v_rd_base(int lane) { return ((lane & 3) << 3) | (((lane >> 2) & 3) << 6) | (((lane >> 4) & 1) << 5) | (((lane >> 5) & 1) << 8); }
constexpr int v_rd_off(int d0, int ks, int half) { return d0 * 512 + ks * 4096 + half * 2048; }
__device__ __forceinline__ int crow(int r, int hi) { return (r & 3) + 8 * (r >> 2) + 4 * hi; }
__device__ __forceinline__ bf16x8 load8(const u16* p) { return *(const GAS bf16x8*)p; }
__device__ __forceinline__ void mask_tile(f32x16& p0, f32x16& p1, int dq) {
    const float NEG = -__builtin_inff();
#pragma unroll
    for (int r = 0; r < 16; ++r) {
        const int c = (r & 3) + 8 * (r >> 2);
        if (dq - c < 0) p0[r] = NEG;
        if (dq - c - 32 < 0) p1[r] = NEG;
    }
}
__device__ __forceinline__ void mask_all(f32x16& p0, f32x16& p1, bool keep) {
    const float NEG = -__builtin_inff();
#pragma unroll
    for (int r = 0; r < 16; ++r) { p0[r] = keep ? p0[r] : NEG; p1[r] = keep ? p1[r] : NEG; }
}
__device__ __forceinline__ void partialSM(f32x16& p0, f32x16& p1, float& m_reg, float& mn, float& alpha, bool keep) {
    float pmax = p0[0];
#pragma unroll
    for (int r = 1; r < 16; ++r) pmax = fmaxf(pmax, p0[r]);
#pragma unroll
    for (int r = 0; r < 16; ++r) pmax = fmaxf(pmax, p1[r]);
    { auto rr = __builtin_amdgcn_permlane32_swap(__float_as_uint(pmax), __float_as_uint(pmax), false, false);
      pmax = fmaxf(__uint_as_float(rr[0]), __uint_as_float(rr[1])); }
    pmax = keep ? pmax : -__builtin_inff();
    constexpr float C2 = 1.4426950408889634f * SCALE;
    if (__builtin_expect(__all((pmax - m_reg) * SCALE <= THR), 1)) { mn = m_reg; alpha = 1.f; }
    else { mn = fmaxf(m_reg, pmax); alpha = __builtin_amdgcn_exp2f((m_reg - mn) * C2); m_reg = mn; }
    const float mnL = keep ? -mn * C2 : -__builtin_inff();
#pragma unroll
    for (int r = 0; r < 16; ++r) p0[r] = fmaf(p0[r], C2, mnL);
#pragma unroll
    for (int r = 0; r < 16; ++r) p1[r] = fmaf(p1[r], C2, mnL);
#pragma unroll
    for (int r = 0; r < 16; ++r) p0[r] = __builtin_amdgcn_exp2f(p0[r]);
}
__device__ __forceinline__ void finishSM(f32x16& p0, f32x16& p1, float alpha, float& l_reg, bf16x8& pa0, bf16x8& pa1, bf16x8& pa2, bf16x8& pa3) {
#pragma unroll
    for (int r = 0; r < 16; ++r) p1[r] = __builtin_amdgcn_exp2f(p1[r]);
    float ps = 0;
#pragma unroll
    for (int r = 0; r < 16; ++r) ps += p0[r];
#pragma unroll
    for (int r = 0; r < 16; ++r) ps += p1[r];
    { auto rr = __builtin_amdgcn_permlane32_swap(__float_as_uint(ps), __float_as_uint(ps), false, false);
      ps = __uint_as_float(rr[0]) + __uint_as_float(rr[1]); }
    l_reg = l_reg * alpha + ps;
#define PK4(P, B_, OUT) do { unsigned a0 = cvtpk_asm(P[B_+0], P[B_+1]), a1 = cvtpk_asm(P[B_+2], P[B_+3]);                          \
        unsigned b0 = cvtpk_asm(P[B_+4], P[B_+5]), b1 = cvtpk_asm(P[B_+6], P[B_+7]);                                             \
        auto r0 = __builtin_amdgcn_permlane32_swap(a0, b0, false, false); auto r1 = __builtin_amdgcn_permlane32_swap(a1, b1, false, false); \
        u32x4 w = {r0[0], r1[0], r0[1], r1[1]}; OUT = *reinterpret_cast<bf16x8*>(&w); } while (0)
    PK4(p0, 0, pa0); PK4(p0, 8, pa1); PK4(p1, 0, pa2); PK4(p1, 8, pa3);
#undef PK4
}
template <int KB>
__device__ __forceinline__ void qkt(f32x16& p0, f32x16& p1, const char* K_lds, int r32, int hi, const char* qr) {
    p0 = f32x16{}; p1 = f32x16{};
    const char* kb[4];
#pragma unroll
    for (int dd = 0; dd < 4; ++dd) kb[dd] = K_lds + KB * SHM_K + KSWZ(r32, (dd * 16 + hi * 8) * 2);
#pragma unroll
    for (int d0 = 0; d0 < 8; ++d0) { const char* a = kb[d0 & 3] + (d0 >> 2) * 128;
        bf16x8 b0 = *reinterpret_cast<const bf16x8*>(a);
        bf16x8 b1 = *reinterpret_cast<const bf16x8*>(a + 32 * 256);
        const bf16x8 q = *reinterpret_cast<const bf16x8*>(qr + d0 * 1024);
        p0 = __builtin_amdgcn_mfma_f32_32x32x16_bf16(b0, q, p0, 0, 0, 0);
        p1 = __builtin_amdgcn_mfma_f32_32x32x16_bf16(b1, q, p1, 0, 0, 0); }
}
template <int VB>
__device__ __forceinline__ void pv_tile(f32x16* o, int vb0, bf16x8 pa0, bf16x8 pa1, bf16x8 pa2, bf16x8 pa3) {
#define TRRD(dst, off) asm volatile("ds_read_b64_tr_b16 %0, %1 offset:%2" : "=&v"(dst) : "v"(vb0), "i"(off) : "memory")
#define PV_D0(d0) do { s16x4 l0, l1, l2, l3, h0, h1, h2, h3; constexpr int b_ = VB * SHM_V + v_rd_off(d0, 0, 0); \
        TRRD(l0, b_); TRRD(h0, b_ + 2048); TRRD(l1, b_ + 4096); TRRD(h1, b_ + 6144); TRRD(l2, b_ + 8192); TRRD(h2, b_ + 10240); TRRD(l3, b_ + 12288); TRRD(h3, b_ + 14336); \
        asm volatile("s_waitcnt lgkmcnt(0)" ::: "memory"); SBAR();   \
        o[d0] = __builtin_amdgcn_mfma_f32_32x32x16_bf16(pa0, (bf16x8){l0[0], l0[1], l0[2], l0[3], h0[0], h0[1], h0[2], h0[3]}, o[d0], 0, 0, 0);   \
        o[d0] = __builtin_amdgcn_mfma_f32_32x32x16_bf16(pa1, (bf16x8){l1[0], l1[1], l1[2], l1[3], h1[0], h1[1], h1[2], h1[3]}, o[d0], 0, 0, 0);   \
        o[d0] = __builtin_amdgcn_mfma_f32_32x32x16_bf16(pa2, (bf16x8){l2[0], l2[1], l2[2], l2[3], h2[0], h2[1], h2[2], h2[3]}, o[d0], 0, 0, 0);   \
        o[d0] = __builtin_amdgcn_mfma_f32_32x32x16_bf16(pa3, (bf16x8){l3[0], l3[1], l3[2], l3[3], h3[0], h3[1], h3[2], h3[3]}, o[d0], 0, 0, 0); } while (0)
    PV_D0(0); PV_D0(1); PV_D0(2); PV_D0(3);
#undef PV_D0
#undef TRRD
}

struct HeadRef { const u16* Q; const u16* K; const u16* V; };
typedef __amdgpu_buffer_rsrc_t rsrc_t;
__device__ __forceinline__ rsrc_t mkrsrc(const u16* p) { return __builtin_amdgcn_make_buffer_rsrc((void*)p, 0, 4096 * 128 * 2, 0x00020000); }
__device__ __forceinline__ bf16x8 bload8(rsrc_t r, int voff, int soff) { return __builtin_bit_cast(bf16x8, __builtin_amdgcn_raw_buffer_load_b128(r, voff, soff, 0)); }
struct BlockRef { u16* O; int own, j_lo, j_hi; float* part; gu32* flag; };
struct Seam { bf16x8 qr[8]; bf16x8 st_v0, st_v1, st_k0, st_k1; };
#define ROW(p, k0, rr) ((p) + (size_t)((k0) + (rr)) * D + sc)
#define VMW() asm volatile("s_waitcnt vmcnt(0)" ::: "memory")
#define VMWN(n) asm volatile("s_waitcnt vmcnt(%0)" :: "i"(n) : "memory")
#define SLOAD_H(Kp, Vp, k0) do { const int so_ = (k0) * (D * 2); S.st_v0 = bload8(rV, voff, so_); S.st_v1 = bload8(rV, voff, so_ + 32 * D * 2);              \
                         S.st_k0 = bload8(rK, voff, so_); S.st_k1 = bload8(rK, voff, so_ + 32 * D * 2); } while (0)
#define SWRITE_HK(bf) do { *(bf16x8*)(K_lds + (bf) * SHM_K + kws) = S.st_k0; *(bf16x8*)(K_lds + (bf) * SHM_K + kws + 32 * 256) = S.st_k1; } while (0)
#define SWRITE_HV(bf) do { *(bf16x8*)(V_lds + (bf) * SHM_V + vst0) = S.st_v0; *(bf16x8*)(V_lds + (bf) * SHM_V + vst1) = S.st_v1; } while (0)
#define SWRITE_H(bf) do { SWRITE_HV(bf); SWRITE_HK(bf); } while (0)
__device__ __forceinline__ void moba_prime(const HeadRef& H, const BlockRef& cur, char* lds, Seam& S, const int tid) {
    const int wid = __builtin_amdgcn_readfirstlane(tid >> 6), lane = tid & 63, r32 = lane & 31, hi = lane >> 5;
    const int sr = tid >> 4, sc = (tid & 15) * 8, kws = KSWZ(sr, sc * 2); char* K_lds = lds + 2 * SHM_V;
    const int kb0 = cur.j_lo * KVBLK;
    const rsrc_t rK = mkrsrc(H.K), rV = mkrsrc(H.V), rQ = mkrsrc(H.Q); const int voff = (sr * D + sc) * 2, qoff = ((wid * QBLK + r32) * D + hi * 8) * 2;
#pragma unroll
    for (int d0 = 0; d0 < 8; ++d0) S.qr[d0] = bload8(rQ, qoff, cur.own * (QB * D * 2) + d0 * 32);
    SLOAD_H(H.K, H.V, kb0); VMW(); SWRITE_HK(0);
    __syncthreads();
}
template <int MODE>
__device__ __forceinline__ void moba_block(const HeadRef& H, const BlockRef& cur, const BlockRef& nxt, char* lds, Seam& S, const unsigned* sel, gu32* tmo, int tid_) {
    asm volatile("" : "+v"(tid_));
    const int tid = tid_, wid = __builtin_amdgcn_readfirstlane(tid >> 6), lane = tid & 63, r32 = lane & 31, hi = lane >> 5;
    const int j_lo = cur.j_lo, NT = cur.j_hi - cur.j_lo;
    const int kbn = nxt.j_lo * KVBLK;
    const int P0 = cur.own * QB;
    const int qlo = P0 + wid * QBLK, qm = qlo + r32 - 4 * hi;
    const unsigned mysel = sel[wid * QBLK + r32];
    char* V_lds = lds; char* K_lds = lds + 2 * SHM_V;
    float* ws = (float*)(lds + 2 * SHM_V + 2 * SHM_K) + wid * 64; float* li_l = ws, * al_l = ws + 32;
    float m_reg = -1e30f, l_reg = 0; f32x16 o[4] = {};
    const int sr = tid >> 4, sc = (tid & 15) * 8, vst0 = v_st(sr, sc), vst1 = v_st(32 + sr, sc), kws = KSWZ(sr, sc * 2);
    const int vb0 = (int)(uintptr_t)V_lds + v_rd_base(lane);
    const u16* Kh = H.K; const u16* Vh = H.V; (void)Kh; (void)Vh;
    const rsrc_t rK = mkrsrc(H.K), rV = mkrsrc(H.V), rQ = mkrsrc(H.Q); const int voff = (sr * D + sc) * 2, qoff = ((wid * QBLK + r32) * D + hi * 8) * 2;
#define RESC(a) do { if (__any((a) < 1.f)) { if (hi == 0) al_l[r32] = (a); asm volatile("s_waitcnt lgkmcnt(0)" ::: "memory");              \
                     for (int d_ = 0; d_ < 4; ++d_) for (int r = 0; r < 16; ++r) o[d_][r] *= al_l[crow(r, hi)]; } } while (0)
#define KBASE(t) ((j_lo + (t)) * KVBLK)
#define MASKT(P0_, P1_, t) const int kb_ = KBASE(t); const int nb_ = kb_ >> 8; bool keep_ = true;                                   \
        if (nb_ < cur.own) { keep_ = ((mysel >> nb_) & 1u) != 0u; }                                                                     \
        else if (kb_ + KVBLK - 1 > qlo) { mask_tile(P0_, P1_, qm - kb_); }
#define MSM(P0_, P1_, mnX_, alX_, t) do { MASKT(P0_, P1_, t) partialSM(P0_, P1_, m_reg, mnX_, alX_, keep_); } while (0)
    constexpr int NQL = 8;
#define SEAM_K0() do { VMWN(NQL); SWRITE_HK(0); SBAR(); } while (0)
    f32x16 pA0, pA1, pB0, pB1; float mnA, mnB, alA, alB; bf16x8 pa0, pa1, pa2, pa3;
    char* const qlds = lds + QLDS_OFF + wid * 8192 + lane * 16;
#pragma unroll
    for (int d0 = 0; d0 < 8; ++d0) *reinterpret_cast<bf16x8*>(qlds + d0 * 1024) = S.qr[d0];
    asm volatile("s_waitcnt lgkmcnt(0)" ::: "memory");
    SWRITE_HV(0); SBAR();
    if (NT > 1) { SLOAD_H(Kh, Vh, KBASE(1)); }
    SBAR(); qkt<0>(pA0, pA1, K_lds, r32, hi, qlds);
    MSM(pA0, pA1, mnA, alA, 0);
    if (NT > 1) { VMW(); SWRITE_H(1); }
    __syncthreads();
#define HALF_STEP(PX0, PX1, mnX, alX, PY0, PY1, alY, t, KB, VB, SB) do {                                                      \
        SBAR(); qkt<KB>(PX0, PX1, K_lds, r32, hi, qlds);                                             \
        finishSM(PY0, PY1, alY, l_reg, pa0, pa1, pa2, pa3); SBAR();                                                           \
        if ((t) + 1 < NT) { SLOAD_H(Kh, Vh, KBASE((t) + 1)); SBAR(); }                                               \
        pv_tile<VB>(o, vb0, pa0, pa1, pa2, pa3); MSM(PX0, PX1, mnX, alX, (t));                                        \
        __syncthreads();                                                                                                      \
        if ((t) + 1 < NT) { VMW(); SWRITE_H(SB); }                                                                          \
        RESC(alX); __syncthreads(); } while (0)
    for (int t = 1; t + 1 < NT; t += 2) {
        HALF_STEP(pB0, pB1, mnB, alB, pA0, pA1, alA, t, 1, 0, 0);
        HALF_STEP(pA0, pA1, mnA, alA, pB0, pB1, alB, t + 1, 0, 1, 1);
    }
    const bool even = (NT & 1) == 0;
    if (even) { SBAR(); qkt<1>(pB0, pB1, K_lds, r32, hi, qlds); SBAR(); }
    SLOAD_H(H.K, H.V, kbn); SBAR();
#pragma unroll
    for (int d0 = 0; d0 < 8; ++d0) S.qr[d0] = bload8(rQ, qoff, nxt.own * (QB * D * 2) + d0 * 32);
    SBAR();
    finishSM(pA0, pA1, alA, l_reg, pa0, pa1, pa2, pa3); SBAR();
    pv_tile<0>(o, vb0, pa0, pa1, pa2, pa3);
    if (even) { MSM(pB0, pB1, mnB, alB, NT - 1); __syncthreads(); RESC(alB);
        finishSM(pB0, pB1, alB, l_reg, pa0, pa1, pa2, pa3); SBAR(); pv_tile<1>(o, vb0, pa0, pa1, pa2, pa3); }
    SBAR(); SEAM_K0();
    constexpr float C2 = 1.4426950408889634f * SCALE;
    if (MODE == 1) {
        float* Pw = cur.part + (size_t)(wid * QBLK) * D;
#pragma unroll
        for (int r = 0; r < 16; ++r) { const int orow = crow(r, hi);
#pragma unroll
            for (int d0 = 0; d0 < 4; ++d0) { float* p = Pw + (size_t)orow * D + d0 * 32 + r32; const float v = o[d0][r];
                asm volatile("global_store_dword %0, %1, off sc1" :: "v"((GAS float*)p), "v"(v) : "memory"); } }
        if (hi == 0) { float* p = cur.part + (size_t)QB * D + (size_t)(wid * QBLK + r32) * 2; f32x2 ml = {m_reg, l_reg};
            asm volatile("global_store_dwordx2 %0, %1, off sc1" :: "v"((GAS float*)p), "v"(ml) : "memory"); }
        asm volatile("s_waitcnt vmcnt(0)" ::: "memory");
        __syncthreads();
        if (tid == 0) __hip_atomic_store(cur.flag, 1u, __ATOMIC_RELAXED, __HIP_MEMORY_SCOPE_AGENT);
    } else {
        float f1 = 1.0f, f2 = 0.0f;
        if (MODE == 2) {
            if (wid == 0) { unsigned sp = 0;
                while (__builtin_amdgcn_readfirstlane(__hip_atomic_load(cur.flag, __ATOMIC_RELAXED, __HIP_MEMORY_SCOPE_AGENT)) == 0u) {
                    __builtin_amdgcn_s_sleep(2);
                    if (++sp > (1u << 22)) { if (lane == 0) __hip_atomic_store(tmo, 1u, __ATOMIC_RELAXED, __HIP_MEMORY_SCOPE_AGENT); break; } }
                __builtin_amdgcn_fence(__ATOMIC_ACQUIRE, "agent"); }
            asm volatile("s_waitcnt vmcnt(0)" ::: "memory");
            __syncthreads();
            const float* pml = cur.part + (size_t)QB * D + (size_t)(wid * QBLK + r32) * 2;
            const float m2 = ldgf(pml), l2 = ldgf(pml + 1);
            const float mN = fmaxf(m_reg, m2), a1 = __builtin_amdgcn_exp2f((m_reg - mN) * C2), a2 = __builtin_amdgcn_exp2f((m2 - mN) * C2);
            const float lt = a1 * l_reg + a2 * l2; const float il = 1.0f / lt; f1 = a1 * il; f2 = a2 * il;
        } else { f1 = 1.0f / l_reg; }
        if (hi == 0) { li_l[r32] = f1; al_l[r32] = f2; } asm volatile("s_waitcnt lgkmcnt(0)" ::: "memory");
        u16* op = cur.O + (size_t)(wid * QBLK + 4 * hi) * OSTRIDE + r32;
        const float* pp = cur.part + (size_t)(wid * QBLK + 4 * hi) * D + r32;
#pragma unroll
        for (int r = 0; r < 16; ++r) { const int orow = crow(r, hi); const float g1 = li_l[orow], g2 = al_l[orow];
#pragma unroll
            for (int d0 = 0; d0 < 4; ++d0) { float v = o[d0][r] * g1;
                if (MODE == 2) v += g2 * ldgf(pp + d0 * 32);
                const float vn = __shfl_xor(v, 1);
                if ((r32 & 1) == 0) *(GAS unsigned*)(op + d0 * 32) = cvtpk_asm(v, vn); }
            const int step = ((r & 3) == 3) ? 5 : 1; op += (size_t)step * OSTRIDE; pp += (size_t)step * D;
            asm volatile("" : "+v"(op), "+v"(pp)); }
    }
    __syncthreads();
#undef RESC
#undef KBASE
#undef MASKT
#undef MSM
#undef SEAM_K0
#undef HALF_STEP
}
#undef ROW
#undef VMW
#undef VMWN
#undef SLOAD_H
#undef SWRITE_HK
#undef SWRITE_HV
#undef SWRITE_H
#undef KSWZ
#undef SBAR
}

__device__ __forceinline__ f32x4 mfma16(bf16x8 a, bf16x8 b, f32x4 c) { return __builtin_amdgcn_mfma_f32_16x16x32_bf16(a, b, c, 0, 0, 0); }
constexpr int VT_LD = 136;
constexpr int KL_LD = 264;

__device__ __forceinline__ void chunk_gates(const float* GATES, int row0, int h, int lane, float& b0, float& b1, float& a0, float& a1) {
    const float i0 = ldgf(GATES + (size_t)(row0 + 2 * lane) * 8 + h), i1 = ldgf(GATES + (size_t)(row0 + 2 * lane + 1) * 8 + h);
    const float f0 = ldgf(GATES + (size_t)(row0 + 2 * lane) * 8 + 4 + h), f1 = ldgf(GATES + (size_t)(row0 + 2 * lane + 1) * 8 + 4 + h);
    float s = f0 + f1;
#pragma unroll
    for (int o = 1; o < 64; o <<= 1) { const float t = __shfl_up(s, o); if (lane >= o) s += t; }
    b1 = s; b0 = s - f1; a0 = i0 - b0; a1 = i1 - b1;
}

template <bool SCALE_W>
__device__ __forceinline__ void stage_T(const u16* src, LAS u16* T, const LAS float* w, int tid) {
    const int sp = tid & 63, s = 2 * sp;
#pragma unroll
    for (int i = 0; i < 4; ++i) {
        const int cc = (tid >> 6) + 8 * i;
        const u32x4 r0 = ldgu4(src + (size_t)s * MW + 8 * cc), r1 = ldgu4(src + (size_t)(s + 1) * MW + 8 * cc);
        float w0 = 1.f, w1 = 1.f; if (SCALE_W) { w0 = w[s]; w1 = w[s + 1]; }
#pragma unroll
        for (int e = 0; e < 4; ++e) {
            const unsigned x0 = r0[e], x1 = r1[e];
            unsigned lo, hi;
            if (SCALE_W) { lo = cvtpk(bflo(x0) * w0, bflo(x1) * w1); hi = cvtpk(bfhi(x0) * w0, bfhi(x1) * w1); }
            else { lo = (x0 & 0xffffu) | (x1 << 16); hi = (x0 >> 16) | (x1 & 0xffff0000u); }
            *(LAS unsigned*)(T + (size_t)(8 * cc + 2 * e) * VT_LD + s) = lo;
            *(LAS unsigned*)(T + (size_t)(8 * cc + 2 * e + 1) * VT_LD + s) = hi;
        }
    }
}

__device__ __forceinline__ void mlstm_A_unit(int unit, const u16* MK, const u16* MV, const float* GATES, u16* U, float* UN, float* CHS, LAS unsigned char* lds, int tid, int wave, int lane) {
    const int bh = unit >> 5, c = unit & 31, b = bh >> 2, h = bh & 3, row0 = b * TP + c * CH;
    LAS u16* VT = (LAS u16*)lds; LAS u16* KT = (LAS u16*)(lds + 256 * VT_LD * 2); LAS float* W = (LAS float*)(lds + 2 * 256 * VT_LD * 2);
    if (wave == 0) {
        float b0, b1, a0, a1; chunk_gates(GATES, row0, h, lane, b0, b1, a0, a1);
        const float G = wave_max(fmaxf(a0, a1)); const float A = __shfl(b1, 63);
        W[2 * lane] = __expf(a0 - G); W[2 * lane + 1] = __expf(a1 - G);
        if (lane == 0) { stgf(CHS + (size_t)(bh * NCH + c) * 2, A); stgf(CHS + (size_t)(bh * NCH + c) * 2 + 1, G); }
    }
    WG_BAR();
    stage_T<false>(MV + (size_t)row0 * MW + h * MD, VT, W, tid);
    stage_T<true>(MK + (size_t)row0 * MW + h * MD, KT, W, tid);
    WG_BAR();
    const int fr = lane & 15, fq = lane >> 4;
    u16* Uo = U + (size_t)(bh * NCH + c) * MD * MD;
#pragma unroll 1
    for (int vh = 0; vh < 2; ++vh) {
        f32x4 acc[2][8];
#pragma unroll
        for (int i = 0; i < 2; ++i)
#pragma unroll
            for (int j = 0; j < 8; ++j) acc[i][j] = (f32x4){0.f, 0.f, 0.f, 0.f};
#pragma unroll
        for (int ks = 0; ks < 4; ++ks) {
            bf16x8 af[2];
#pragma unroll
            for (int i = 0; i < 2; ++i) af[i] = *(const LAS bf16x8*)(KT + (size_t)(32 * wave + 16 * i + fr) * VT_LD + 32 * ks + 8 * fq);
#pragma unroll
            for (int j = 0; j < 8; ++j) { const bf16x8 bfr = *(const LAS bf16x8*)(VT + (size_t)(16 * (8 * vh + j) + fr) * VT_LD + 32 * ks + 8 * fq);
#pragma unroll
                for (int i = 0; i < 2; ++i) acc[i][j] = mfma16(af[i], bfr, acc[i][j]); }
        }
#pragma unroll
        for (int i = 0; i < 2; ++i)
#pragma unroll
            for (int j = 0; j < 8; ++j) { u32x2 w; w.x = cvtpk(acc[i][j][0], acc[i][j][1]); w.y = cvtpk(acc[i][j][2], acc[i][j][3]);
                stgu2(Uo + (size_t)(16 * (8 * vh + j) + fr) * MD + 32 * wave + 16 * i + 4 * fq, w); }
    }
    if (tid < 256) { float s = 0.f;
#pragma unroll
        for (int i = 0; i < 16; ++i) { const u32x4 x = *(const LAS u32x4*)(KT + (size_t)tid * VT_LD + 8 * i);
#pragma unroll
            for (int e = 0; e < 4; ++e) s += bflo(x[e]) + bfhi(x[e]); }
        stgf(UN + (size_t)(bh * NCH + c) * MD + tid, s); }
    WG_BAR();
}

__device__ __forceinline__ void mlstm_B(int gid, int gstride, const u16* U, const float* UN, const float* CHS, u16* CST, float* NST, float* MST, float* Cout, float* nout, float* mout) {
    for (int g = gid; g < 8 * 16384 + 8 * 64; g += gstride) {
        if (g < 8 * 16384) {
            const int bh = g >> 14, e = (g & 16383) * 4;
            float m = 0.f; f32x4 C = (f32x4){0.f, 0.f, 0.f, 0.f};
#pragma unroll 8
            for (int c = 0; c < NCH; ++c) {
                const float A = ldgf(CHS + (size_t)(bh * NCH + c) * 2), G = ldgf(CHS + (size_t)(bh * NCH + c) * 2 + 1);
                const float M = fmaxf(m, G), sC = __expf(m - M), sU = __expf(G - M);
                const size_t off = (size_t)(bh * NCH + c) * MD * MD + e;
                u32x2 w; w.x = cvtpk(C[0], C[1]); w.y = cvtpk(C[2], C[3]); stgu2(CST + off, w);
                if (e == 0) stgf(MST + bh * 33 + c, m);
                const u32x2 u = ldgu2(U + off);
                C[0] = sC * C[0] + sU * bflo(u.x); C[1] = sC * C[1] + sU * bfhi(u.x); C[2] = sC * C[2] + sU * bflo(u.y); C[3] = sC * C[3] + sU * bfhi(u.y);
                m = A + M;
            }
            stg4(Cout + (size_t)bh * MD * MD + e, C);
            if (e == 0) { stgf(mout + bh, m); stgf(MST + bh * 33 + 32, m); }
        } else {
            const int g2 = g - 8 * 16384, bh = g2 >> 6, e = (g2 & 63) * 4;
            float m = 0.f; f32x4 N = (f32x4){0.f, 0.f, 0.f, 0.f};
            for (int c = 0; c < NCH; ++c) {
                const float A = ldgf(CHS + (size_t)(bh * NCH + c) * 2), G = ldgf(CHS + (size_t)(bh * NCH + c) * 2 + 1);
                const float M = fmaxf(m, G), sC = __expf(m - M), sU = __expf(G - M);
                const size_t off = (size_t)(bh * NCH + c) * MD + e;
                stg4(NST + off, N);
                const f32x4 u = ldg4(UN + off);
                N = sC * N + sU * u; m = A + M;
            }
            stg4(nout + (size_t)bh * MD + e, N);
        }
    }
}

constexpr int CL_LD = 264;
__device__ __forceinline__ void mlstm_C_unit(int unit, const u16* MQ, const u16* MK, const u16* MV, const u16* MO, const float* GATES, const u16* CST, const float* NST, const float* MST,
                                             const float* gm, u16* MIX, LAS unsigned char* lds, int tid, int wave, int lane) {
    const int bh = unit >> 5, c = unit & 31, b = bh >> 2, h = bh & 3, row0 = b * TP + c * CH;
    LAS u16* CL = (LAS u16*)lds; LAS u16* KL = (LAS u16*)lds; LAS u16* VT = (LAS u16*)(lds + 128 * KL_LD * 2);
    LAS float* AS = (LAS float*)(lds + 128 * KL_LD * 2 + 256 * VT_LD * 2); LAS float* MTt = AS + 128; LAS float* INTER = AS + 256; LAS float* EMT = AS + 384;
    static_assert(256 * CL_LD * 2 <= 128 * KL_LD * 2 + 256 * VT_LD * 2, "state image below the gate tables");
    if (wave == 0) {
        float b0, b1, a0, a1; chunk_gates(GATES, row0, h, lane, b0, b1, a0, a1);
        const float mc = ldgf(MST + bh * 33 + c);
        float pm = fmaxf(a0, a1);
#pragma unroll
        for (int o = 1; o < 64; o <<= 1) { const float t = __shfl_up(pm, o); if (lane >= o) pm = fmaxf(pm, t); }
        float pprev = __shfl_up(pm, 1); if (lane == 0) pprev = -__builtin_inff();
        const float p0 = fmaxf(pprev, a0), p1 = pm;
        const float M0 = fmaxf(mc, p0), M1 = fmaxf(mc, p1);
        AS[2 * lane] = a0; AS[2 * lane + 1] = a1; MTt[2 * lane] = M0; MTt[2 * lane + 1] = M1;
        INTER[2 * lane] = __expf(mc - M0); INTER[2 * lane + 1] = __expf(mc - M1);
        EMT[2 * lane] = __expf(-(b0 + M0)); EMT[2 * lane + 1] = __expf(-(b1 + M1));
    }
    { const u16* csrc = CST + (size_t)(bh * NCH + c) * MD * MD;
#pragma unroll
      for (int i = 0; i < 16; ++i) { const int q = tid + 512 * i, v = q >> 5, cc = q & 31;
          *(LAS u32x4*)(CL + (size_t)v * CL_LD + 8 * cc) = ldgu4(csrc + (size_t)v * MD + 8 * cc); } }
    const int fr = lane & 15, fq = lane >> 4, t = 16 * wave + fr;
    bf16x8 qf[8];
    { const u16* qrow = MQ + (size_t)(row0 + t) * MW + h * MD + 8 * fq;
#pragma unroll
      for (int ks = 0; ks < 8; ++ks) qf[ks] = __builtin_bit_cast(bf16x8, ldgu4(qrow + 32 * ks)); }
    float nq = 0.f;
    { const float* np = NST + (size_t)(bh * NCH + c) * MD + 8 * fq;
#pragma unroll
      for (int ks = 0; ks < 8; ++ks) { const f32x4 n0 = ldg4(np + 32 * ks), n1 = ldg4(np + 32 * ks + 4); const u32x4 qw = __builtin_bit_cast(u32x4, qf[ks]);
          nq += n0[0] * bflo(qw.x) + n0[1] * bfhi(qw.x) + n0[2] * bflo(qw.y) + n0[3] * bfhi(qw.y) + n1[0] * bflo(qw.z) + n1[1] * bfhi(qw.z) + n1[2] * bflo(qw.w) + n1[3] * bfhi(qw.w); }
      nq += __shfl_xor(nq, 16); nq += __shfl_xor(nq, 32); }
    WG_BAR();
    f32x4 acc[16];
#pragma unroll
    for (int j = 0; j < 16; ++j) acc[j] = (f32x4){0.f, 0.f, 0.f, 0.f};
#pragma unroll
    for (int j = 0; j < 16; ++j)
#pragma unroll
        for (int ks = 0; ks < 8; ++ks) acc[j] = mfma16(*(const LAS bf16x8*)(CL + (size_t)(16 * j + fr) * CL_LD + 32 * ks + 8 * fq), qf[ks], acc[j]);
    const float inter = INTER[t], Mt = MTt[t];
#pragma unroll
    for (int j = 0; j < 16; ++j) acc[j] = acc[j] * inter;
    WG_BAR();
    { const u16* ksrc = MK + (size_t)row0 * MW + h * MD;
#pragma unroll
      for (int i = 0; i < 8; ++i) { const int q = tid + 512 * i, s = q >> 5, cc = q & 31;
          *(LAS u32x4*)(KL + (size_t)s * KL_LD + 8 * cc) = ldgu4(ksrc + (size_t)s * MW + 8 * cc); } }
    stage_T<false>(MV + (size_t)row0 * MW + h * MD, VT, nullptr, tid);
    WG_BAR();
    float den = 0.f;
    for (int kk = 0; 2 * kk <= wave; ++kk) {
        f32x4 st[2];
#pragma unroll
        for (int i = 0; i < 2; ++i) { st[i] = (f32x4){0.f, 0.f, 0.f, 0.f}; const int sb = 2 * kk + i;
            if (sb <= wave) {
#pragma unroll
                for (int ks = 0; ks < 8; ++ks) st[i] = mfma16(*(const LAS bf16x8*)(KL + (size_t)(16 * sb + fr) * KL_LD + 32 * ks + 8 * fq), qf[ks], st[i]);
#pragma unroll
                for (int r = 0; r < 4; ++r) { const int s = 16 * sb + 4 * fq + r; const float wgt = (s <= t) ? __expf(AS[s] - Mt) : 0.f; st[i][r] *= wgt; den += st[i][r]; }
            } }
        u32x4 pw; pw.x = cvtpk(st[0][0], st[0][1]); pw.y = cvtpk(st[0][2], st[0][3]); pw.z = cvtpk(st[1][0], st[1][1]); pw.w = cvtpk(st[1][2], st[1][3]);
        const bf16x8 pf = __builtin_bit_cast(bf16x8, pw);
#pragma unroll
        for (int j = 0; j < 16; ++j) { const LAS u16* vp = VT + (size_t)(16 * j + fr) * VT_LD + 32 * kk + 4 * fq;
            const u32x2 lo = *(const LAS u32x2*)vp, hi = *(const LAS u32x2*)(vp + 16); u32x4 aw; aw.x = lo.x; aw.y = lo.y; aw.z = hi.x; aw.w = hi.y;
            acc[j] = mfma16(__builtin_bit_cast(bf16x8, aw), pf, acc[j]); }
    }
    den += __shfl_xor(den, 16); den += __shfl_xor(den, 32);
    den += inter * nq;
    const float idn = 1.0f / fmaxf(fabsf(den), EMT[t]);
    float ss = 0.f;
#pragma unroll
    for (int j = 0; j < 16; ++j) { acc[j] = acc[j] * idn; ss += dot4(acc[j], acc[j]); }
    ss += __shfl_xor(ss, 16); ss += __shfl_xor(ss, 32);
    const float rs = 1.0f / sqrtf(ss * (1.0f / MD) + EPS);
    const u16* op = MO + (size_t)(row0 + t) * MW + h * MD + 4 * fq; u16* mp = MIX + (size_t)(row0 + t) * DM + h * MD + 4 * fq; const float* gp = gm + h * MD + 4 * fq;
#pragma unroll
    for (int j = 0; j < 16; ++j) { const u32x2 ow = ldgu2(op + 16 * j); const f32x4 gv = ldg4(gp + 16 * j);
        const float o0 = sigmoidf_(bflo(ow.x)), o1 = sigmoidf_(bfhi(ow.x)), o2 = sigmoidf_(bflo(ow.y)), o3 = sigmoidf_(bfhi(ow.y));
        u32x2 w; w.x = cvtpk(acc[j][0] * rs * gv[0] * o0, acc[j][1] * rs * gv[1] * o1); w.y = cvtpk(acc[j][2] * rs * gv[2] * o2, acc[j][3] * rs * gv[3] * o3);
        stgu2(mp + 16 * j, w); }
    WG_BAR();
}

__device__ __forceinline__ void transpose_item(const float* W, int K, int Nsrc, u16* WT, int k0, int n0, int sc0, LAS float* scr, int lane) {
    const int n4 = lane & 15, kq = lane >> 4;
#pragma unroll 8
    for (int i = 0; i < 16; ++i) { const int kk = 4 * i + kq; const f32x4 v = ldg4(W + (size_t)(k0 + kk) * Nsrc + sc0 + 4 * n4);
        LAS float* p = scr + kk * 65 + 4 * n4; p[0] = v[0]; p[1] = v[1]; p[2] = v[2]; p[3] = v[3]; }
    LDS_WAIT(); asm volatile("" ::: "memory");
    const int c = lane & 7;
#pragma unroll
    for (int j = 0; j < 8; ++j) { const int n = (lane >> 3) + 8 * j; const LAS float* s = scr + (8 * c) * 65 + n;
        u32x4 o; o.x = cvtpk(s[0 * 65], s[1 * 65]); o.y = cvtpk(s[2 * 65], s[3 * 65]); o.z = cvtpk(s[4 * 65], s[5 * 65]); o.w = cvtpk(s[6 * 65], s[7 * 65]);
        stgu4(WT + (size_t)(n0 + n) * K + k0 + 8 * c, o); }
    LDS_WAIT(); asm volatile("" ::: "memory");
}
__device__ __forceinline__ int win_src_col(int n) {
    if (n < 4096) return n;
    const int a = n - 4096, sec = a >> 10, r = a & 1023, pt = r >> 8, tc = r & 255;
    return 4104 + sec * 1024 + (pt * 2 + ((tc >> 6) & 1)) * 128 + (tc >> 7) * 64 + (tc & 63);
}
__device__ __forceinline__ int wup_src_col(int n) { const int pn = n >> 8, tc = n & 255; return tc < 128 ? pn * 128 + tc : DFF + pn * 128 + (tc - 128); }

__device__ __forceinline__ void sincos_d(double a, float& s, float& c) {
    const double n = __builtin_rint(a * 0.15915494309189535);
    double r = __builtin_fma(-n, 6.283185307179586, a); r = __builtin_fma(-n, 2.4492935982947064e-16, r);
    const double r2 = r * r; double ts = 1.0, ss = 1.0, tc = 1.0, cs = 1.0;
#pragma unroll
    for (int k = 1; k <= 14; ++k) { tc *= -r2 * (1.0 / ((2.0 * k - 1.0) * (2.0 * k))); cs += tc; ts *= -r2 * (1.0 / ((2.0 * k) * (2.0 * k + 1.0))); ss += ts; }
    s = (float)(r * ss); c = (float)cs;
}

__device__ __forceinline__ void norm1_row(const float* xrow, u16* orow, float* grow, const LAS float* GW, const LAS float* G1, const float* bg, int lane) {
    f32x4 v[8]; float s = 0.f, ga[8];
#pragma unroll
    for (int j = 0; j < 8; ++j) ga[j] = 0.f;
#pragma unroll
    for (int i = 0; i < 8; ++i) { v[i] = ldg4(xrow + 256 * i + 4 * lane); s += dot4(v[i], v[i]);
#pragma unroll
        for (int j = 0; j < 8; ++j) ga[j] += dot4(v[i], *(const LAS f32x4*)(GW + j * DM + 256 * i + 4 * lane));
        asm volatile("" ::: "memory"); }
    s = wave_sum(s); const float rstd = 1.0f / sqrtf(s * (1.0f / DM) + EPS);
#pragma unroll
    for (int j = 0; j < 8; ++j) ga[j] = wave_sum(ga[j]) * rstd;
#pragma unroll
    for (int i = 0; i < 8; ++i) { const f32x4 g = *(const LAS f32x4*)(G1 + 256 * i + 4 * lane); u32x2 w; w.x = cvtpk(v[i][0] * rstd * g[0], v[i][1] * rstd * g[1]); w.y = cvtpk(v[i][2] * rstd * g[2], v[i][3] * rstd * g[3]);
        stgu2(orow + 256 * i + 4 * lane, w); }
    if (lane < 8) { float z = 0.f;
#pragma unroll
        for (int j = 0; j < 8; ++j) z = (lane == j) ? ga[j] : z;
        z += ldgf(bg + lane);
        if (lane >= 4) z = fminf(z, 0.f) - log1pf(__expf(-fabsf(z)));
        stgf(grow + lane, z); }
}

__device__ __forceinline__ void kmean_prompt_unit(int unit, const u16* AK, float* KM, LAS unsigned char* lds, int tid) {
    const u16* src = AK + (size_t)unit * 256 * AD;
    const int cc = tid & 15, rg = tid >> 4; f32x4 s0 = {0.f, 0.f, 0.f, 0.f}, s1 = s0;
#pragma unroll
    for (int i = 0; i < 8; ++i) { const u32x4 x = ldgu4(src + (size_t)(rg * 8 + i) * AD + 8 * cc);
        s0[0] += bflo(x.x); s0[1] += bfhi(x.x); s0[2] += bflo(x.y); s0[3] += bfhi(x.y); s1[0] += bflo(x.z); s1[1] += bfhi(x.z); s1[2] += bflo(x.w); s1[3] += bfhi(x.w); }
    LAS float* R = (LAS float*)lds;
    *(LAS f32x4*)(R + (rg * 16 + cc) * 8) = s0; *(LAS f32x4*)(R + (rg * 16 + cc) * 8 + 4) = s1;
    WG_BAR();
    if (tid < 128) { float s = 0.f;
#pragma unroll
        for (int g = 0; g < 32; ++g) s += R[(g * 16 + (tid >> 3)) * 8 + (tid & 7)];
        stgf(KM + (size_t)unit * AD + tid, s * (1.0f / 256.0f)); }
    WG_BAR();
}

__device__ __forceinline__ void kmean_sample_unit(int unit, const float* cache_k, const int* page_table, float* KMS, LAS unsigned char* lds, int tid) {
    const int b = unit >> 6, n = unit & 63, c4 = tid & 255, rh = tid >> 8;
    f32x4 s = {0.f, 0.f, 0.f, 0.f};
#pragma unroll
    for (int pg = 0; pg < 2; ++pg) {
        const int page = *(const GAS int*)(page_table + b * NPAGES + 2 * n + pg);
        const float* base = cache_k + (size_t)page * PAGE * AW + (size_t)rh * AW + 4 * c4;
#pragma unroll 16
        for (int r = 0; r < 64; ++r) s = s + ldg4(base + (size_t)(2 * r) * AW);
    }
    LAS float* R = (LAS float*)lds;
    if (rh == 1) *(LAS f32x4*)(R + 4 * c4) = s;
    WG_BAR();
    if (rh == 0) { s = s + *(LAS f32x4*)(R + 4 * c4); s = s * (1.0f / 256.0f); const int h = c4 >> 5, d = (c4 & 31) * 4;
        stg4(KMS + ((size_t)(b * AH + h) * NBS + n) * AD + d, s); }
    WG_BAR();
}

__device__ __forceinline__ void skinny_unit(const u16* A, const u16* Bt, int K, int ca, int cb, LAS unsigned char* lds, int tid, int wave, int lane) {
    const int fr = lane & 15, fq = lane >> 4, kw = K >> 3, k0 = wave * kw;
    f32x4 acc[4][2];
#pragma unroll
    for (int i = 0; i < 4; ++i) { acc[i][0] = (f32x4){0.f, 0.f, 0.f, 0.f}; acc[i][1] = acc[i][0]; }
    const u16* ap = A + (size_t)fr * K + k0 + 8 * fq; const u16* bpa = Bt + (size_t)(ca + fr) * K + k0 + 8 * fq; const u16* bpb = Bt + (size_t)(cb + fr) * K + k0 + 8 * fq;
#pragma unroll 2
    for (int ks = 0; ks < kw; ks += 32) {
        const bf16x8 b0 = __builtin_bit_cast(bf16x8, ldgu4(bpa + ks)), b1 = __builtin_bit_cast(bf16x8, ldgu4(bpb + ks));
#pragma unroll
        for (int mb = 0; mb < 4; ++mb) { const bf16x8 a = __builtin_bit_cast(bf16x8, ldgu4(ap + (size_t)(16 * mb) * K + ks));
            acc[mb][0] = mfma16(a, b0, acc[mb][0]); acc[mb][1] = mfma16(a, b1, acc[mb][1]); }
    }
    LAS float* red = (LAS float*)lds + wave * 2048;
#pragma unroll
    for (int mb = 0; mb < 4; ++mb)
#pragma unroll
        for (int cbk = 0; cbk < 2; ++cbk)
#pragma unroll
            for (int r = 0; r < 4; ++r) red[(16 * mb + 4 * fq + r) * 32 + 16 * cbk + fr] = acc[mb][cbk][r];
    WG_BAR();
    f32x4 s = {0.f, 0.f, 0.f, 0.f};
#pragma unroll
    for (int w = 0; w < 8; ++w) s = s + *(const LAS f32x4*)((LAS float*)lds + w * 2048 + 4 * tid);
    *(LAS f32x4*)((LAS float*)(lds + 65536) + 4 * tid) = s;
    WG_BAR();
}

__device__ __forceinline__ void sample_select_unit(int unit, const float* QS, const float* KMS, int* SEL, LAS unsigned char* lds, int tid) {
    const int b = unit >> 3, h = unit & 7, q = tid >> 6, n = tid & 63;
    const float* qp = QS + ((size_t)(b * TS + q) * AH + h) * AD; const float* kp = KMS + ((size_t)(b * AH + h) * NBS + n) * AD;
    float s = 0.f;
#pragma unroll 8
    for (int d = 0; d < AD; d += 4) s += dot4(ldg4(qp + d), ldg4(kp + d));
    LAS float* SC = (LAS float*)lds; SC[q * 64 + n] = s;
    WG_BAR();
    if (tid < 8) { float b0 = -__builtin_inff(), b1 = b0, b2 = b0; int i0 = 0, i1 = 0, i2 = 0;
        for (int j = 0; j < 64; ++j) { const float v = SC[tid * 64 + j];
            if (v > b0) { b2 = b1; i2 = i1; b1 = b0; i1 = i0; b0 = v; i0 = j; } else if (v > b1) { b2 = b1; i2 = i1; b1 = v; i1 = j; } else if (v > b2) { b2 = v; i2 = j; } }
        int* o = SEL + ((size_t)(b * TS + tid) * AH + h) * 4; *(GAS int*)o = i0; *(GAS int*)(o + 1) = i1; *(GAS int*)(o + 2) = i2; }
    WG_BAR();
}
__device__ __forceinline__ void sample_attend_unit(int unit, const float* QS, const float* KSN, const float* VSN, const float* cache_k, const float* cache_v, const int* page_table, const int* SEL,
                                                   u16* MIX, LAS unsigned char* lds, int tid, int wave, int lane) {
    const int b = unit >> 6, q = (unit >> 3) & 7, h = unit & 7, row = b * TS + q;
    LAS float* OG = (LAS float*)lds;
    LAS float* MG = OG + 4096; LAS float* LG = MG + 32;
    const int* sp = SEL + ((size_t)row * AH + h) * 4;
    int pages[6];
#pragma unroll
    for (int s = 0; s < 3; ++s) { const int blk = *(const GAS int*)(sp + s); pages[2 * s] = *(const GAS int*)(page_table + b * NPAGES + 2 * blk); pages[2 * s + 1] = *(const GAS int*)(page_table + b * NPAGES + 2 * blk + 1); }
    const float* qp = QS + ((size_t)row * AH + h) * AD;
    const int sub = tid & 15, g = tid >> 4;
    constexpr float L2E = 1.4426950408889634f;
    const f32x4 q0 = ldg4(qp + 8 * sub) * (ATT_SCALE * L2E), q1 = ldg4(qp + 8 * sub + 4) * (ATT_SCALE * L2E);
    float m = -1e30f, l = 0.f; f32x4 o0 = {0.f, 0.f, 0.f, 0.f}, o1 = o0;
    const size_t hoff = (size_t)h * AD + 8 * sub;
#define SA_KEY(k0v, k1v, v0v, v1v) do { float s_ = dot4(k0v, q0) + dot4(k1v, q1); s_ += __shfl_xor(s_, 1); s_ += __shfl_xor(s_, 2); s_ += __shfl_xor(s_, 4); s_ += __shfl_xor(s_, 8); \
        const float mn_ = fmaxf(m, s_), sc_ = __builtin_amdgcn_exp2f(m - mn_), p_ = __builtin_amdgcn_exp2f(s_ - mn_); l = l * sc_ + p_; o0 = o0 * sc_ + v0v * p_; o1 = o1 * sc_ + v1v * p_; m = mn_; } while (0)
#pragma unroll
    for (int i0 = 0; i0 < 24; i0 += 4) {
        f32x4 kk[4][2], vv[4][2];
#pragma unroll
        for (int u = 0; u < 4; ++u) { const int i = i0 + u; const size_t off = ((size_t)pages[i >> 2] * PAGE + g + 32 * (i & 3)) * AW + hoff;
            kk[u][0] = ldg4(cache_k + off); kk[u][1] = ldg4(cache_k + off + 4); vv[u][0] = ldg4(cache_v + off); vv[u][1] = ldg4(cache_v + off + 4); }
#pragma unroll
        for (int u = 0; u < 4; ++u) SA_KEY(kk[u][0], kk[u][1], vv[u][0], vv[u][1]);
    }
    if (g <= q && g < 8) { const size_t off = ((size_t)(b * TS + g) * AH + h) * AD + 8 * sub;
        const f32x4 k0 = ldg4(KSN + off), k1 = ldg4(KSN + off + 4), v0 = ldg4(VSN + off), v1 = ldg4(VSN + off + 4); SA_KEY(k0, k1, v0, v1); }
#undef SA_KEY
    *(LAS f32x4*)(OG + g * 128 + 8 * sub) = o0; *(LAS f32x4*)(OG + g * 128 + 8 * sub + 4) = o1;
    if (sub == 0) { MG[g] = m; LG[g] = l; }
    WG_BAR();
    if (tid < 128) { float mx = MG[0];
#pragma unroll
        for (int gg = 1; gg < 32; ++gg) mx = fmaxf(mx, MG[gg]);
        float num = 0.f, den = 0.f;
#pragma unroll
        for (int gg = 0; gg < 32; ++gg) { const float w = __builtin_amdgcn_exp2f(MG[gg] - mx); num += w * OG[gg * 128 + tid]; den += w * LG[gg]; }
        *(GAS u16*)(MIX + (size_t)(MP + row) * DM + MW + h * AD + tid) = (u16)f2bf(num / den); }
    WG_BAR();
}

__device__ __forceinline__ void sample_mlstm_unit(int unit, const float* QKVO  , const float* GATES, const float* C0, const float* n0, const float* m0, const float* gm,
                                                  float* Cout, float* nout, float* mout, u16* MIX, LAS unsigned char* lds, int tid, int wave, int lane) {
    const int b = unit >> 2, h = unit & 3, r0 = b * TS;
    LAS float* QL = (LAS float*)lds; LAS float* KL = QL + 2048; LAS float* VL = KL + 2048; LAS float* CQ = VL + 2048; LAS float* HS = CQ + 2048;
    LAS float* SP = HS + 2048;
    LAS float* SCL = SP + 64;
    for (int i = tid; i < 2048; i += 512) { const int t = i >> 8, d = i & 255; const float* rp = QKVO + (size_t)(r0 + t) * 4096 + h * MD + d;
        QL[i] = ldgf(rp); KL[i] = ldgf(rp + 1024) * 0.0625f; VL[i] = ldgf(rp + 2048); }
    if (tid < 8) {
        const float mp = ldgf(m0 + b * MH + h); float bc = 0.f, pm = -__builtin_inff(); float a_[8], M_[8], b_[8];
#pragma unroll
        for (int t = 0; t < 8; ++t) { const float ig = ldgf(GATES + (size_t)(MP + r0 + t) * 8 + h), lf = ldgf(GATES + (size_t)(MP + r0 + t) * 8 + 4 + h);
            bc += lf; b_[t] = bc; a_[t] = ig - bc; pm = fmaxf(pm, a_[t]); M_[t] = fmaxf(mp, pm); }
        const int t = tid;
        float at = 0.f, Mt = 0.f, bt = 0.f;
#pragma unroll
        for (int j = 0; j < 8; ++j) { at = (j == t) ? a_[j] : at; Mt = (j == t) ? M_[j] : Mt; bt = (j == t) ? b_[j] : bt; }
        SCL[t] = at; SCL[8 + t] = Mt; SCL[16 + t] = __expf(mp - Mt); SCL[24 + t] = __expf(-(bt + Mt)); SCL[32 + t] = __expf(at - M_[7]);
        if (t == 0) { SCL[64] = __expf(mp - M_[7]); SCL[65] = b_[7] + M_[7]; }
    }
    WG_BAR();
    if (tid < 64) { const int t = tid >> 3, s = tid & 7; float d = 0.f;
        for (int i = 0; i < 256; ++i) d += QL[t * 256 + i] * KL[s * 256 + i];
        SP[tid] = (s <= t) ? d * __expf(SCL[s] - SCL[8 + t]) : 0.f; }
    else if (tid < 72) { const int t = tid - 64; float d = 0.f;
        for (int i = 0; i < 256; ++i) d += QL[t * 256 + i] * ldgf(n0 + (size_t)(b * MH + h) * MD + i);
        SCL[48 + t] = d; }
    WG_BAR();
    { f32x4 qv[8], kv[8];
#pragma unroll
      for (int t = 0; t < 8; ++t) { qv[t] = *(const LAS f32x4*)(QL + t * 256 + 4 * lane); kv[t] = *(const LAS f32x4*)(KL + t * 256 + 4 * lane); }
      const float decay = SCL[64];
      const float* Cb = C0 + (size_t)(b * MH + h) * MD * MD; float* Co = Cout + (size_t)(b * MH + h) * MD * MD;
      for (int i0 = 0; i0 < 32; i0 += 4) { f32x4 cr[4];
#pragma unroll
        for (int u = 0; u < 4; ++u) cr[u] = ldg4(Cb + (size_t)(wave + 8 * (i0 + u)) * MD + 4 * lane);
#pragma unroll
        for (int u = 0; u < 4; ++u) { const int v = wave + 8 * (i0 + u);
          const f32x4 c4 = cr[u]; f32x4 nc = c4 * decay; float part[8];
#pragma unroll
          for (int t = 0; t < 8; ++t) { part[t] = dot4(c4, qv[t]); nc = nc + kv[t] * (SCL[32 + t] * VL[t * 256 + v]); }
          stg4(Co + (size_t)v * MD + 4 * lane, nc);
          float p4[4], p2[2], p1;
          { const bool up = (lane & 32) != 0;
#pragma unroll
            for (int t = 0; t < 4; ++t) { const float keep = up ? part[4 + t] : part[t], send = up ? part[t] : part[4 + t]; p4[t] = keep + __shfl_xor(send, 32); } }
          { const bool up = (lane & 16) != 0;
#pragma unroll
            for (int t = 0; t < 2; ++t) { const float keep = up ? p4[2 + t] : p4[t], send = up ? p4[t] : p4[2 + t]; p2[t] = keep + __shfl_xor(send, 16); } }
          { const bool up = (lane & 8) != 0; const float keep = up ? p2[1] : p2[0], send = up ? p2[0] : p2[1]; p1 = keep + __shfl_xor(send, 8); }
          p1 += __shfl_xor(p1, 4); p1 += __shfl_xor(p1, 2); p1 += __shfl_xor(p1, 1);
          if ((lane & 7) == 0) CQ[(lane >> 3) * 256 + v] = p1; } } }
    if (tid < 256) { const int d = tid; float nn = SCL[64] * ldgf(n0 + (size_t)(b * MH + h) * MD + d);
        for (int s = 0; s < 8; ++s) nn += SCL[32 + s] * KL[s * 256 + d];
        stgf(nout + (size_t)(b * MH + h) * MD + d, nn); }
    if (tid == 0) stgf(mout + b * MH + h, SCL[65]);
    WG_BAR();
    { const int v = tid & 255, th = tid >> 8;
#pragma unroll
      for (int i = 0; i < 4; ++i) { const int t = th + 2 * i; float num = SCL[16 + t] * CQ[t * 256 + v], den = SCL[16 + t] * SCL[48 + t];
          for (int s = 0; s <= t; ++s) { num += SP[t * 8 + s] * VL[s * 256 + v]; den += SP[t * 8 + s]; }
          HS[t * 256 + v] = num / fmaxf(fabsf(den), SCL[24 + t]); } }
    WG_BAR();
    { float ss = 0.f;
#pragma unroll
      for (int i = 0; i < 4; ++i) { const float x = HS[wave * 256 + lane + 64 * i]; ss += x * x; }
      ss = wave_sum(ss); if (lane == 0) SCL[56 + wave] = 1.0f / sqrtf(ss * (1.0f / MD) + EPS); }
    WG_BAR();
    { const int v = tid & 255, th = tid >> 8;
#pragma unroll
      for (int i = 0; i < 4; ++i) { const int t = th + 2 * i; const float o = ldgf(QKVO + (size_t)(r0 + t) * 4096 + 3072 + h * MD + v);
          const float y = HS[t * 256 + v] * SCL[56 + t] * ldgf(gm + h * MD + v) * sigmoidf_(o);
          *(GAS u16*)(MIX + (size_t)(MP + r0 + t) * DM + h * MD + v) = (u16)f2bf(y); } }
    WG_BAR();
}

constexpr int NWAVES = 8, NTHREADS = 512;
#ifndef MK_N_LAUNCHES
#define MK_N_LAUNCHES 1
#endif
constexpr int N_PHASES = 9;
constexpr size_t MiB = 1u << 20;
constexpr size_t WS_CTL = 0, CTL_ZERO_BYTES = 1 * MiB;
constexpr size_t WS_WIN = 2 * MiB, WS_WOUT = 30 * MiB, WS_WUP = 38 * MiB, WS_WDN = 82 * MiB, WS_ROPE = 104 * MiB, WS_GATES = 108 * MiB, WS_XN = 109 * MiB;
constexpr size_t WS_MQ = 142 * MiB, WS_MK = 158 * MiB, WS_MV = 174 * MiB, WS_MO = 190 * MiB, WS_AQ = 206 * MiB, WS_AK = 222 * MiB, WS_AV = 238 * MiB;
constexpr size_t WS_U = 254 * MiB, WS_CST = 286 * MiB, WS_SMALL = 318 * MiB, WS_MIXED = 334 * MiB, WS_X1 = 367 * MiB, WS_X1G = 433 * MiB, WS_SS = 466 * MiB;
constexpr size_t WS_ACT = 470 * MiB, WS_UB = 561 * MiB, WS_PART = 567 * MiB, WS_END = 585 * MiB;
constexpr size_t SM_CHS = 0, SM_MST = 64 * 1024, SM_KMP = 128 * 1024, SM_UN = 256 * 1024, SM_NST = 512 * 1024, SM_QKVO = 1 * MiB, SM_KMS = 2 * MiB, SM_QS = 4 * MiB,
                 SM_KSN = 4 * MiB + 256 * 1024, SM_VSN = 4 * MiB + 512 * 1024, SM_SEL = 4 * MiB + 768 * 1024, SM_SSS1 = 4 * MiB + 800 * 1024, SM_SSS2 = 4 * MiB + 832 * 1024;
constexpr int CW_TMO = 0, CW_BAR = 4096, CW_UPCNT = 8192, CW_AFLAG = 16384, CW_P4Q = 12288;
constexpr int RING_BYTES = 131072, XCH_OFF = 131072, MISC_OFF = 163840 - 256, LDS_BYTES = 163840;
constexpr int SELT_OFF = 67584, KML_OFF = 69632;

#define RLX_AGENT __ATOMIC_RELAXED, __HIP_MEMORY_SCOPE_AGENT
static_assert(WS_MK - WS_MQ == 16 * MiB && WS_MV - WS_MK == 16 * MiB && WS_MO - WS_MV == 16 * MiB && WS_AK - WS_AQ == 16 * MiB && WS_AV - WS_AK == 16 * MiB, "EpiIn's section strides");
static_assert(SM_KSN - SM_QS == 256 * 1024 && SM_VSN - SM_KSN == 256 * 1024 && O_VP - O_KP == (size_t)MP * AW && O_VS - O_KS == (size_t)MS * AW, "skinny_epi_in's section strides");
#define XB_TMO      128
#define XB_XCNT(j)  (256  + 64 * (j))
#define XB_XSUB(j)  (1280 + 64 * (j))
#define XB_XGEN(j)  (2304 + 64 * (j))
#define XB_TOP      3328
#define XB_TOPGEN   3392
#define XCD_BAR_WORDS 3456
#define XB_SPIN_CAP (1u << 18)

__device__ __forceinline__ unsigned xb_ld(unsigned* p)              { return __hip_atomic_load(p, __ATOMIC_RELAXED, __HIP_MEMORY_SCOPE_AGENT); }
__device__ __forceinline__ unsigned xb_add(unsigned* p, unsigned v) { return __hip_atomic_fetch_add(p, v, __ATOMIC_RELAXED, __HIP_MEMORY_SCOPE_AGENT); }
__device__ __forceinline__ unsigned xb_xcc_id() { return (unsigned)__builtin_amdgcn_s_getreg((3 << 11) | 20) & 0xFu; }
#define XB_SPIN(cond, bar) do { unsigned _sp = 0; while (cond) { __builtin_amdgcn_s_sleep(1); \
    if ((++_sp & 255u) == 0u) { if (xb_ld(&(bar)[XB_TMO])) break; if (_sp > XB_SPIN_CAP) { atomicAdd(&(bar)[XB_TMO], 1u); break; } } } } while (0)

struct XcdBarrier {
    unsigned* bar; unsigned x;
    volatile LAS unsigned* st;
};

__device__ __forceinline__ XcdBarrier xcd_barrier_post(unsigned* bar, volatile LAS unsigned* st, int xb_tid) {
    XcdBarrier b; b.bar = bar; b.x = xb_xcc_id(); b.st = st;
    if (xb_tid == 0) (void)xb_add(&bar[XB_XCNT(b.x)], 1u);
    return b;
}
__device__ __forceinline__ void xcd_barrier_complete(unsigned* bar, unsigned x, unsigned& nloc, unsigned& nx) {
    const unsigned G = gridDim.x * gridDim.y * gridDim.z;
    unsigned sum, cnt, mine, sp = 0u;
    for (;;) {
        sum = 0u; cnt = 0u; mine = 0u;
#pragma unroll
        for (unsigned j = 0; j < 16; ++j) { const unsigned c = xb_ld(&bar[XB_XCNT(j)]); sum += c; cnt += (c > 0u) ? 1u : 0u; mine = (j == x) ? c : mine; }
        if (sum == G) break;
        __builtin_amdgcn_s_sleep(1);
        if ((++sp & 255u) == 0u) { if (xb_ld(&bar[XB_TMO])) break; if (sp > XB_SPIN_CAP) { atomicAdd(&bar[XB_TMO], 1u); break; } }
    }
    nloc = mine > 0u ? mine : 1u; nx = cnt > 0u ? cnt : 1u;
}

__device__ __forceinline__ void xcd_barrier(const XcdBarrier& b, int xb_tid) {
    asm volatile("s_waitcnt vmcnt(0)" ::: "memory");
    __syncthreads();
    if (xb_tid == 0) {
        unsigned* bar = b.bar;
        __builtin_amdgcn_s_waitcnt(0);
        unsigned nloc = b.st[0], nx = b.st[1];
        if (nloc == 0u) { xcd_barrier_complete(bar, b.x, nloc, nx); b.st[0] = nloc; b.st[1] = nx; }
        const unsigned old = xb_add(&bar[XB_XSUB(b.x)], 1u);
        const unsigned gen = old / nloc;
        if (old + 1u == (gen + 1u) * nloc) {
            __builtin_amdgcn_fence(__ATOMIC_RELEASE, "agent");
            asm volatile("s_waitcnt vmcnt(0)" ::: "memory");
            const unsigned og = xb_add(&bar[XB_TOP], 1u);
            const unsigned tg = og / nx;
            if (og + 1u == (tg + 1u) * nx) xb_add(&bar[XB_TOPGEN], 1u);
            else XB_SPIN(xb_ld(&bar[XB_TOPGEN]) == tg, bar);
            __builtin_amdgcn_fence(__ATOMIC_ACQUIRE, "agent");
            xb_add(&bar[XB_XGEN(b.x)], 1u);
            asm volatile("s_waitcnt vmcnt(0)" ::: "memory");
        } else {
            XB_SPIN(xb_ld(&bar[XB_XGEN(b.x)]) == gen, bar);
            __builtin_amdgcn_fence(__ATOMIC_ACQUIRE, "agent");
            asm volatile("s_waitcnt vmcnt(0)" ::: "memory");
        }
    }
    __syncthreads();
}

#ifdef DBG_CHECK
__device__ __forceinline__ float dbg_bf(const u16* p) { return bf2f(*(const GAS u16*)p); }
__device__ __forceinline__ void dbg_count(gu32* ctl, int cls) { if (cls >= 0 && cls < 14) { gu32* c = ctl + 20000 + cls; if (__hip_atomic_load(c, __ATOMIC_RELAXED, __HIP_MEMORY_SCOPE_AGENT) < 4000000u) __hip_atomic_fetch_add(c, 1u, __ATOMIC_RELAXED, __HIP_MEMORY_SCOPE_AGENT); } }
__device__ __forceinline__ void dbg_mlstm_token(int bh, int c, int tl, const u16* MQ, const u16* MK, const u16* MV, const u16* MO, const float* GATES, const u16* CST, const float* NST, const float* MST,
                                const float* gm, const u16* MIX, LAS float* L, gu32* ctl, int tid, int cls) {
    const int b = bh >> 2, h = bh & 3, row0 = b * TP + c * CH, row = row0 + tl;
    LAS float* W = L; LAS float* SC = L + 128; LAS float* RED = L + 160;
    if (tid == 0) { const float mc = ldgf(MST + bh * 33 + c); float bc = 0.f, pm = -__builtin_inff();
        for (int s = 0; s <= tl; ++s) { const float ig = ldgf(GATES + (size_t)(row0 + s) * 8 + h), lf = ldgf(GATES + (size_t)(row0 + s) * 8 + 4 + h); bc += lf; const float a = ig - bc; W[s] = a; pm = fmaxf(pm, a); }
        const float Mt = fmaxf(mc, pm); SC[0] = Mt; SC[1] = __expf(mc - Mt); SC[2] = __expf(-(bc + Mt)); }
    __syncthreads();
    if (tid < 128) { float d = 0.f; if (tid <= tl) { for (int i = 0; i < MD; ++i) d += dbg_bf(MQ + (size_t)row * MW + h * MD + i) * dbg_bf(MK + (size_t)(row0 + tid) * MW + h * MD + i); d *= __expf(W[tid] - SC[0]); }
        __syncthreads(); W[tid] = d; } else __syncthreads();
    __syncthreads();
    float num = 0.f, den = 0.f, cq = 0.f, nq = 0.f;
    if (tid < 256) { const int v = tid;
        for (int s = 0; s <= tl; ++s) { num += W[s] * dbg_bf(MV + (size_t)(row0 + s) * MW + h * MD + v); den += W[s]; }
        for (int d = 0; d < MD; ++d) { const float q = dbg_bf(MQ + (size_t)row * MW + h * MD + d); cq += dbg_bf(CST + (size_t)(bh * NCH + c) * MD * MD + (size_t)v * MD + d) * q; nq += ldgf(NST + (size_t)(bh * NCH + c) * MD + d) * q; }
        num += SC[1] * cq; den += SC[1] * nq; }
    const float hval = num / fmaxf(fabsf(den), SC[2]);
    RED[tid] = (tid < 256) ? hval * hval : 0.f;
    __syncthreads();
    if (tid == 0) { float s = 0.f; for (int i = 0; i < 256; ++i) s += RED[i]; SC[3] = 1.0f / sqrtf(s * (1.0f / MD) + EPS); }
    __syncthreads();
    if (tid < 256) { const int v = tid; const float o = dbg_bf(MO + (size_t)row * MW + h * MD + v); const float y = hval * SC[3] * ldgf(gm + h * MD + v) * sigmoidf_(o);
        const float mine = dbg_bf(MIX + (size_t)row * DM + h * MD + v);
        if (fabsf(mine - y) > 0.02f + 0.03f * fabsf(y)) dbg_count(ctl, cls); }
    __syncthreads();
}
__device__ __forceinline__ void dbg_attn_token(int bh16, int t, const u16* AQ, const u16* AK, const u16* AV, const u16* MIX, LAS float* L, gu32* ctl, int tid, int cls) {
    const int b = bh16 >> 3, h = bh16 & 7, own = t >> 8;
    const u16* Q = AQ + ((size_t)bh16 * TP + t) * AD; const u16* K = AK + (size_t)bh16 * TP * AD; const u16* V = AV + (size_t)bh16 * TP * AD;
    LAS float* QL = L; LAS float* BS = L + 128; LAS float* SCO = L + 160; LAS float* RED = L + 160 + 1024; LAS int* SELB = (LAS int*)(L + 150);
    if (tid < 128) QL[tid] = dbg_bf(Q + tid);
    __syncthreads();
    if (tid < 16) { float s = 0.f; if (tid < own) { for (int d = 0; d < AD; ++d) { float km = 0.f; for (int r = 0; r < 256; ++r) km += dbg_bf(K + (size_t)(tid * 256 + r) * AD + d); s += QL[d] * km * (1.0f / 256.0f); } } BS[tid] = s; }
    __syncthreads();
    if (tid == 0) { int nsel = 0;
        if (own <= 3) { for (int n = 0; n < own; ++n) SELB[nsel++] = n; }
        else { unsigned used = 0u;
            for (int k = 0; k < 3; ++k) { int best = 0; float bv = -__builtin_inff(); for (int n = 0; n < own; ++n) if (!((used >> n) & 1u) && BS[n] > bv) { bv = BS[n]; best = n; } used |= 1u << best; SELB[nsel++] = best; } }
        SELB[3] = nsel; }
    __syncthreads();
    const int nsel = SELB[3];
    for (int e = tid; e < 1024; e += 512) { const int slot = e >> 8, kk = e & 255; float s = -__builtin_inff();
        int blk = -1; if (slot == 0) blk = own; else if (slot - 1 < nsel) blk = (slot == 1) ? SELB[0] : (slot == 2) ? SELB[1] : SELB[2];
        if (blk >= 0) { const int key = blk * 256 + kk; if (key <= t) { float d = 0.f; for (int i = 0; i < AD; ++i) d += QL[i] * dbg_bf(K + (size_t)key * AD + i); s = d * ATT_SCALE; } }
        SCO[e] = s; }
    __syncthreads();
    if (tid == 0) { float mx = -__builtin_inff(); for (int e = 0; e < 1024; ++e) mx = fmaxf(mx, SCO[e]); float sm = 0.f; for (int e = 0; e < 1024; ++e) { const float p = __expf(SCO[e] - mx); SCO[e] = p; sm += p; } BS[0] = 1.0f / sm; }
    __syncthreads();
    if (tid < 128) { float o = 0.f;
        for (int e = 0; e < 1024; ++e) { const float p = SCO[e]; if (p > 0.f) { const int slot = e >> 8, kk = e & 255; const int blk = (slot == 0) ? own : (slot == 1) ? SELB[0] : (slot == 2) ? SELB[1] : SELB[2]; o += p * dbg_bf(V + (size_t)(blk * 256 + kk) * AD + tid); } }
        o *= BS[0];
        const float mine = dbg_bf(MIX + (size_t)(b * TP + t) * DM + MW + h * AD + tid);
        if (fabsf(mine - o) > 0.004f + 0.05f * fabsf(o)) dbg_count(ctl, cls); }
    __syncthreads();
}

__device__ __forceinline__ void dbg_sattn_token(int b, int q, int h, const float* QS, const float* KSN, const float* VSN, const float* cache_k, const float* cache_v, const int* page_table,
                                                const u16* MIX, LAS float* L, gu32* ctl, int tid, int cls) {
    const int row = b * TS + q;
    LAS float* QL = L; LAS float* BS = L + 128; LAS int* SELB = (LAS int*)(L + 200); LAS float* SCO = L + 256; LAS float* AUX = L + 256 + 1024;
    if (tid < 128) QL[tid] = ldgf(QS + ((size_t)row * AH + h) * AD + tid);
    __syncthreads();
    if (tid < 64) { float s = 0.f;
        for (int d = 0; d < AD; ++d) { float km = 0.f;
            for (int r = 0; r < 256; ++r) { const int page = *(const GAS int*)(page_table + b * NPAGES + 2 * tid + (r >> 7)); km += ldgf(cache_k + ((size_t)page * PAGE + (r & 127)) * AW + h * AD + d); }
            s += QL[d] * km * (1.0f / 256.0f); }
        BS[tid] = s; }
    __syncthreads();
    if (tid == 0) { unsigned long long used = 0ull;
        for (int k = 0; k < 3; ++k) { int best = 0; float bv = -__builtin_inff(); for (int n = 0; n < 64; ++n) if (!((used >> n) & 1ull) && BS[n] > bv) { bv = BS[n]; best = n; } used |= 1ull << best; SELB[k] = best; } }
    __syncthreads();
    for (int e = tid; e < 1024; e += 512) { const int slot = e >> 8, kk = e & 255; float s = -__builtin_inff();
        if (slot < 3) { const int blk = (slot == 0) ? SELB[0] : (slot == 1) ? SELB[1] : SELB[2]; const int page = *(const GAS int*)(page_table + b * NPAGES + 2 * blk + (kk >> 7));
            float d = 0.f; for (int i = 0; i < AD; ++i) d += QL[i] * ldgf(cache_k + ((size_t)page * PAGE + (kk & 127)) * AW + h * AD + i); s = d * ATT_SCALE; }
        else if (kk <= q) { float d = 0.f; for (int i = 0; i < AD; ++i) d += QL[i] * ldgf(KSN + ((size_t)(b * TS + kk) * AH + h) * AD + i); s = d * ATT_SCALE; }
        SCO[e] = s; }
    __syncthreads();
    if (tid == 0) { float mx = -__builtin_inff(); for (int e = 0; e < 1024; ++e) mx = fmaxf(mx, SCO[e]); float sm = 0.f; for (int e = 0; e < 1024; ++e) { const float p = __expf(SCO[e] - mx); SCO[e] = p; sm += p; } AUX[0] = 1.0f / sm; }
    __syncthreads();
    if (tid < 128) { float o = 0.f;
        for (int e = 0; e < 1024; ++e) { const float p = SCO[e]; if (p > 0.f) { const int slot = e >> 8, kk = e & 255;
            if (slot < 3) { const int blk = (slot == 0) ? SELB[0] : (slot == 1) ? SELB[1] : SELB[2]; const int page = *(const GAS int*)(page_table + b * NPAGES + 2 * blk + (kk >> 7));
                o += p * ldgf(cache_v + ((size_t)page * PAGE + (kk & 127)) * AW + h * AD + tid); }
            else o += p * ldgf(VSN + ((size_t)(b * TS + kk) * AH + h) * AD + tid); } }
        o *= AUX[0];
        const float mine = dbg_bf(MIX + (size_t)(MP + row) * DM + MW + h * AD + tid);
        if (fabsf(mine - o) > 0.004f + 0.05f * fabsf(o)) dbg_count(ctl, cls); }
    __syncthreads();
}

__device__ __forceinline__ void dbg_qs_token(int row, int head, const float* x_s, const float* g1, const float* w_in, const float* QS, LAS float* L, gu32* ctl, int tid, int cls) {
    LAS float* HN = L; LAS float* QV = L + 2048; LAS float* AUX = L + 2048 + 128;
    float ss = 0.f; for (int k = tid; k < DM; k += 512) { const float v = ldgf(x_s + (size_t)row * DM + k); ss += v * v; }
    ss = wave_sum(ss); if ((tid & 63) == 0) AUX[tid >> 6] = ss;
    __syncthreads();
    float tot = 0.f; for (int w = 0; w < 8; ++w) tot += AUX[w];
    const float rstd = 1.0f / sqrtf(tot * (1.0f / DM) + EPS);
    for (int k = tid; k < DM; k += 512) HN[k] = ldgf(x_s + (size_t)row * DM + k) * rstd * ldgf(g1 + k);
    __syncthreads();
    if (tid < 128) { float a = 0.f; for (int k = 0; k < DM; ++k) a += HN[k] * ldgf(w_in + (size_t)k * NIN + 4104 + head * 128 + tid); QV[tid] = a; }
    __syncthreads();
    if (tid < 128) { const int dl = tid & 63, t = row & 7; const double inv = exp(-(double)dl * (9.210340371976184 / 64.0)); float s, c; sincos_d((double)(PAST + t) * inv, s, c);
        const float x1 = QV[dl], x2 = QV[dl + 64]; const float ref = tid < 64 ? x1 * c - x2 * s : x2 * c + x1 * s;
        const float mine = ldgf(QS + ((size_t)row * AH + head) * AD + tid);
        if (fabsf(mine - ref) > 0.02f + 0.02f * fabsf(ref)) dbg_count(ctl, cls); }
    __syncthreads();
}
#endif

__device__ __forceinline__ void moba_select(int bh16, int own, const u16* AQ, const float* KMP, LAS unsigned* SELT, LAS float* KML, int tid) {
    if (own <= 3) { if (tid < 256) SELT[tid] = (1u << own) - 1u; return; }
    *(LAS f32x4*)(KML + 4 * tid) = ldg4(KMP + (size_t)bh16 * 16 * AD + 4 * tid);
    const int row = tid >> 1, half = tid & 1;
    const u16* qp = AQ + ((size_t)bh16 * TP + own * 256 + row) * AD + 64 * half;
    u32x4 qv[8];
#pragma unroll
    for (int i = 0; i < 8; ++i) qv[i] = ldgu4(qp + 8 * i);
    WG_BAR();
    float b0 = -__builtin_inff(), b1 = b0, b2 = b0; int i0 = 0, i1 = 0, i2 = 0;
    for (int n = 0; n < own; ++n) {
        const LAS float* kp = KML + n * AD + 64 * half; float s = 0.f;
#pragma unroll
        for (int i = 0; i < 8; ++i) { const f32x4 k0 = *(const LAS f32x4*)(kp + 8 * i), k1 = *(const LAS f32x4*)(kp + 8 * i + 4);
            s += bflo(qv[i].x) * k0[0] + bfhi(qv[i].x) * k0[1] + bflo(qv[i].y) * k0[2] + bfhi(qv[i].y) * k0[3] + bflo(qv[i].z) * k1[0] + bfhi(qv[i].z) * k1[1] + bflo(qv[i].w) * k1[2] + bfhi(qv[i].w) * k1[3]; }
        s += __shfl_xor(s, 1);
        if (s > b0) { b2 = b1; i2 = i1; b1 = b0; i1 = i0; b0 = s; i0 = n; } else if (s > b1) { b2 = b1; i2 = i1; b1 = s; i1 = n; } else if (s > b2) { b2 = s; i2 = n; }
    }
    if (half == 0) SELT[row] = (1u << i0) | (1u << i1) | (1u << i2);
}

__device__ __forceinline__ void skinny_epi_in(int pn, int j, const LAS float* RES, float* QKVO, float* QS, float* kout, const float* rcos, const float* rsin, int tid) {
    if (tid >= 256) return;
    const int row = tid >> 2, q = tid & 3; const f32x4 a = *(const LAS f32x4*)(RES + row * 32 + 4 * q), bq = *(const LAS f32x4*)(RES + row * 32 + 16 + 4 * q);
    if (pn < 16) { float* p = QKVO + (size_t)row * 4096 + pn * 256 + 16 * j + 4 * q; stg4(p, a); stg4(p + 128, bq); return; }
    const int aa = pn - 16, sec = aa >> 2, pt = aa & 3, tc = 16 * j + 4 * q, head = 2 * pt + (tc >> 6), dl = tc & 63, t = row & 7;
    f32x4 x1 = a, x2 = bq;
    if (sec < 2) { const f32x4 c = ldg4(rcos + (size_t)(TP + t) * 64 + dl), s = ldg4(rsin + (size_t)(TP + t) * 64 + dl); x1 = a * c - bq * s; x2 = bq * c + a * s; }
    float* dst = QS + (size_t)sec * 65536 + ((size_t)row * AH + head) * AD + dl; stg4(dst, x1); stg4(dst + 64, x2);
    if (sec >= 1) { float* fo = kout + (size_t)(sec - 1) * ((size_t)MS * AW) + (size_t)row * AW + head * AD + dl; stg4(fo, x1); stg4(fo + 64, x2); }
}
template <bool WITH_G>
__device__ __forceinline__ void skinny_epi_res(int su, int ca, const LAS float* RES, const float* res, float* out, u16* outg, const float* g, float* SSS, int tid) {
    if (tid >= 256) return;
    const int row = tid >> 2, q = tid & 3; float ss = 0.f;
#pragma unroll
    for (int h = 0; h < 2; ++h) { const int col = ca + 128 * h + 4 * q; const f32x4 v = *(const LAS f32x4*)(RES + row * 32 + 16 * h + 4 * q) + ldg4(res + (size_t)row * DM + col);
        stg4(out + (size_t)row * DM + col, v); ss += dot4(v, v);
        if (WITH_G) { const f32x4 gv = ldg4(g + col); u32x2 w; w.x = cvtpk(v[0] * gv[0], v[1] * gv[1]); w.y = cvtpk(v[2] * gv[2], v[3] * gv[3]); stgu2(outg + (size_t)row * DM + col, w); } }
    ss += __shfl_xor(ss, 1); ss += __shfl_xor(ss, 2);
    if (q == 0) stgf(SSS + row * 64 + su, ss);
}
__device__ __forceinline__ void skinny_epi_up(int pn, int j, LAS float* RES, const LAS float* RSTDL, const float* stconv, const float* conv_w, const float* conv_b, u16* ACTs, float* conv_out, int tid) {
    { const int row = tid >> 3; f32x4 v = *(LAS f32x4*)(RES + 4 * tid); v = v * RSTDL[row]; *(LAS f32x4*)(RES + 4 * tid) = v; }
    WG_BAR();
    if (tid < 256) {
        const int row = tid >> 2, q = tid & 3, b = row >> 3, t = row & 7;
        float cv[2][4];
#pragma unroll
        for (int h = 0; h < 2; ++h)
#pragma unroll
            for (int e = 0; e < 4; ++e) {
                const int tcol = 16 * h + 4 * q + e, oc = h * DFF + pn * 128 + 16 * j + 4 * q + e;
                const float u0 = RES[row * 32 + tcol];
                const float um1 = (t >= 1) ? RES[(row - 1) * 32 + tcol] : ldgf(stconv + ((size_t)b * 2 + 1) * NUP + oc);
                const float um2 = (t >= 2) ? RES[(row - 2) * 32 + tcol] : ldgf(stconv + ((size_t)b * 2 + t) * NUP + oc);
                cv[h][e] = ldgf(conv_b + oc) + ldgf(conv_w + oc) * um2 + ldgf(conv_w + NUP + oc) * um1 + ldgf(conv_w + 2 * NUP + oc) * u0;
                if (t >= 6) stgf(conv_out + ((size_t)b * 2 + (t - 6)) * NUP + oc, u0);
            }
        u32x2 w; float a[4];
#pragma unroll
        for (int e = 0; e < 4; ++e) a[e] = cv[0][e] / (1.0f + __expf(-cv[0][e])) * cv[1][e];
        w.x = cvtpk(a[0], a[1]); w.y = cvtpk(a[2], a[3]);
        stgu2(ACTs + (size_t)row * DFF + pn * 128 + 16 * j + 4 * q, w);
    }
}

#ifdef DBG_SCALE_MASK
#ifndef DBG_SCALE_F
#define DBG_SCALE_F 2.0f
#endif
#define DBG_YS(m) ((((m) < MP) ? ((DBG_SCALE_MASK >> 0) & 1) : ((DBG_SCALE_MASK >> 1) & 1)) ? DBG_SCALE_F : 1.0f)
#else
#define DBG_YS(m) 1.0f
#endif
#ifndef PH_MASK
#define PH_MASK 0x1ff
#endif
struct Args { const void* in[20]; float* out; unsigned char* ws; int ph_lo, ph_hi, li, pad; };

__global__ void __launch_bounds__(NTHREADS, 2) hymba_fwd(Args args) {
    extern __shared__ __attribute__((aligned(16))) unsigned char lds_raw[];
    LAS unsigned char* lds = (LAS unsigned char*)lds_raw;
    volatile LAS unsigned* MISC = (volatile LAS unsigned*)(lds + MISC_OFF);
    const int wave = __builtin_amdgcn_readfirstlane((int)threadIdx.x >> 6);
#define tid tid_of(wave)
#define lane (tid_of(wave) & 63)
    const int G = gridDim.x; const int bx = blockIdx.x; const int vcu = (G % 8 == 0) ? (bx % 8) * (G / 8) + bx / 8 : bx;
    unsigned char* const ws = args.ws; float* const out = args.out;
#define ctl ((gu32*)(ws + WS_CTL))
#define x_p ((const float*)args.in[0])
#define x_s ((const float*)args.in[1])
#define cache_k ((const float*)args.in[2])
#define cache_v ((const float*)args.in[3])
#define page_table ((const int*)args.in[4])
#define st_C ((const float*)args.in[5])
#define st_n ((const float*)args.in[6])
#define st_m ((const float*)args.in[7])
#define st_conv ((const float*)args.in[8])
#define g1 ((const float*)args.in[9])
#define w_in ((const float*)args.in[10])
#define b_gates ((const float*)args.in[11])
#define gmn ((const float*)args.in[12])
#define w_out ((const float*)args.in[13])
#define g2 ((const float*)args.in[14])
#define w_up ((const float*)args.in[15])
#define conv_w ((const float*)args.in[16])
#define conv_b ((const float*)args.in[17])
#define w_down ((const float*)args.in[18])
#define gf ((const float*)args.in[19])
#define WIN ((u16*)(ws + WS_WIN))
#define WOUT ((u16*)(ws + WS_WOUT))
#define WUP ((u16*)(ws + WS_WUP))
#define WDN ((u16*)(ws + WS_WDN))
#define RCOS ((float*)(ws + WS_ROPE))
#define RSIN ((float*)(ws + WS_ROPE + 2 * MiB))
#define GATES ((float*)(ws + WS_GATES))
#define XN ((u16*)(ws + WS_XN))
#define MQ ((u16*)(ws + WS_MQ))
#define MK ((u16*)(ws + WS_MK))
#define MV ((u16*)(ws + WS_MV))
#define MO ((u16*)(ws + WS_MO))
#define AQ ((u16*)(ws + WS_AQ))
#define AK ((u16*)(ws + WS_AK))
#define AV ((u16*)(ws + WS_AV))
#define UU ((u16*)(ws + WS_U))
#define CST ((u16*)(ws + WS_CST))
#define CHS ((float*)((ws + WS_SMALL) + SM_CHS))
#define MST ((float*)((ws + WS_SMALL) + SM_MST))
#define KMP ((float*)((ws + WS_SMALL) + SM_KMP))
#define UN ((float*)((ws + WS_SMALL) + SM_UN))
#define NST ((float*)((ws + WS_SMALL) + SM_NST))
#define QKVO ((float*)((ws + WS_SMALL) + SM_QKVO))
#define KMS ((float*)((ws + WS_SMALL) + SM_KMS))
#define QS ((float*)((ws + WS_SMALL) + SM_QS))
#define KSN ((float*)((ws + WS_SMALL) + SM_KSN))
#define VSN ((float*)((ws + WS_SMALL) + SM_VSN))
#define SEL ((int*)((ws + WS_SMALL) + SM_SEL))
#define SSS1 ((float*)((ws + WS_SMALL) + SM_SSS1))
#define SSS2 ((float*)((ws + WS_SMALL) + SM_SSS2))
#define MIXED ((u16*)(ws + WS_MIXED))
#define X1 ((float*)(ws + WS_X1))
#define X1G ((u16*)(ws + WS_X1G))
#define SS1 ((float*)(ws + WS_SS))
#define SS2 ((float*)(ws + WS_SS + 2 * MiB))
#define ACT ((u16*)(ws + WS_ACT))
#define UB ((float*)(ws + WS_UB))
#define PART ((float*)(ws + WS_PART))
    for (int u = tid; u < 64; u += NTHREADS) ((LAS unsigned*)(lds + MISC_OFF))[u] = 0u;
    __syncthreads();
    XcdBarrier bar; bar.bar = (unsigned*)(ctl + CW_BAR); bar.x = 0; bar.st = nullptr;
    if (MK_N_LAUNCHES != N_PHASES) bar = xcd_barrier_post((unsigned*)(ctl + CW_BAR) + args.li * XCD_BAR_WORDS, MISC + 8, tid);
    const int lo = args.ph_lo, hi = args.ph_hi;
#define IN(k) (((PH_MASK >> (k)) & 1) && lo <= (k) && (k) < hi)
#if defined(DBG_REPEAT) && DBG_REPEAT == 41
#define DBG_P4A 2
#else
#define DBG_P4A 1
#endif
#if defined(DBG_REPEAT) && DBG_REPEAT == 42
#define DBG_P4B 2
#else
#define DBG_P4B 1
#endif
#if defined(DBG_REPEAT) && DBG_REPEAT == 11
#define DBG_KM 2
#else
#define DBG_KM 1
#endif
#if defined(DBG_REPEAT) && DBG_REPEAT == 421
#define DBG_XN 32
#define DBG_XB 0
#elif defined(DBG_REPEAT) && DBG_REPEAT == 422
#define DBG_XN 256
#define DBG_XB 32
#elif defined(DBG_REPEAT) && DBG_REPEAT == 423
#define DBG_XN 512
#define DBG_XB 288
#else
#define DBG_XN 0
#define DBG_XB 0
#endif
#ifdef DBG_REPEAT
#define REPS(k) (((k) == DBG_REPEAT) ? 2 : 1)
#else
#define REPS(k) 1
#endif
#ifdef DBG_TIMING
#define STAMP(k) do { if (bx == 0 && tid == 0) { ((GAS unsigned long long*)(ctl + 30000))[k] = __builtin_amdgcn_s_memrealtime(); } } while (0)
#else
#define STAMP(k) do {} while (0)
#endif
#define SEAM(k) do { if (IN(k) && IN((k) + 1)) xcd_barrier(bar, tid); STAMP((k) + 1); } while (0)
    const int gw = vcu * NWAVES + wave, NGW = G * NWAVES;
    STAMP(0);

    for (int rep_ = 0; rep_ < REPS(0); ++rep_) { if (rep_) xcd_barrier(bar, tid);
    if (IN(0)) {
#if PH_MASK != 0x1ff
        for (size_t i = (size_t)bx * NTHREADS + tid; i < O_END / 4; i += (size_t)G * NTHREADS) stg4(out + 4 * i, (f32x4){0.f, 0.f, 0.f, 0.f});
#endif
        LAS float* scr = (LAS float*)(lds + wave * 16640);
        constexpr int I_IN = 32 * 112, I_OUT = 32 * 32, I_UP = 32 * 176, NITEMS = I_IN + I_OUT + I_UP;
        for (int it = gw; it < NITEMS; it += NGW) {
            int r = it;
            if (r < I_IN) { const int kb = r / 112, n0 = (r % 112) * 64; transpose_item(w_in, DM, NIN, WIN, kb * 64, n0, win_src_col(n0), scr, lane); continue; } r -= I_IN;
            if (r < I_OUT) { const int kb = r / 32, n0 = (r % 32) * 64; transpose_item(w_out, DM, DM, WOUT, kb * 64, n0, n0, scr, lane); continue; } r -= I_OUT;
            { const int kb = r / 176, n0 = (r % 176) * 64; transpose_item(w_up, DM, NUP, WUP, kb * 64, n0, wup_src_col(n0), scr, lane); }
        }
        for (int idx = vcu * NTHREADS + tid; idx < (TP + TS) * 64; idx += G * NTHREADS) {
            const int p = idx >> 6, i = idx & 63; const int pos = p < TP ? p : PAST + (p - TP);
            const double inv = exp(-(double)i * (9.210340371976184 / 64.0));
            float s, c; sincos_d((double)pos * inv, s, c); stgf(RCOS + idx, c); stgf(RSIN + idx, s);
        }
        __syncthreads();
        LAS float* GW = (LAS float*)lds; LAS float* G1L = (LAS float*)(lds + 65536);
        for (int i = tid; i < 8 * DM; i += NTHREADS) { const int k = i >> 3, j = i & 7; GW[j * DM + k] = ldgf(g1 + k) * ldgf(w_in + (size_t)k * NIN + 4096 + j); }
        for (int i = tid; i < DM; i += NTHREADS) G1L[i] = ldgf(g1 + i);
        __syncthreads();
        for (int m = gw; m < MT; m += NGW) norm1_row(m < MP ? x_p + (size_t)m * DM : x_s + (size_t)(m - MP) * DM, XN + (size_t)m * DM, GATES + (size_t)m * 8, GW, G1L, b_gates, lane);
        __syncthreads();
    }
    }
    SEAM(0);
    for (int rep_ = 0; rep_ < REPS(1); ++rep_) { if (rep_) xcd_barrier(bar, tid);
    if (IN(1)) {
        pg8::Gemm g{XN, WIN, MP, NING, DM}; pg8::StaticOrder S; S.init(MP, NING, G, bx);
        EpiIn E{MQ, AQ, out + O_KP, RCOS, RSIN};
        pg8::gemm_phase<EpiIn, pg8::StaticOrder, true, true>(lds, g, S, E, tid);
        if (G == 256 && bx >= 128) { for (int u4 = 0; u4 < 4; ++u4) kmean_sample_unit((bx - 128) * 4 + u4, cache_k, page_table, KMS, lds, tid); }
        for (int su = vcu; su < 224; su += G) { const int pn = su >> 3, j = su & 7;
            skinny_unit(XN + (size_t)MP * DM, WIN, DM, pn * 256 + 16 * j, pn * 256 + 16 * j + 128, lds, tid, wave, lane);
            skinny_epi_in(pn, j, (const LAS float*)(lds + 65536), QKVO, QS, out + O_KS, RCOS, RSIN, tid);
            WG_BAR(); }
    }
    }
    SEAM(1);
    for (int rep_ = 0; rep_ < REPS(2); ++rep_) { if (rep_) xcd_barrier(bar, tid);
    if (IN(2)) {
        const int km0 = (G == 256) ? 512 : 0;
        for (int it = vcu; it < 512 + (512 - km0); it += G) {
            int tid_o = tid; asm volatile("" : "+v"(tid_o)); const int lane_o = tid_o & 63, wave_o = __builtin_amdgcn_readfirstlane(tid_o >> 6);
            if (it < 256) mlstm_A_unit(it, MK, MV, GATES, UU, UN, CHS, lds, tid_o, wave_o, lane_o);
            else if (it < 512) kmean_prompt_unit(it - 256, AK, KMP, lds, tid_o);
            else kmean_sample_unit(km0 + it - 512, cache_k, page_table, KMS, lds, tid_o);
        }
    }
    }
    SEAM(2);
    for (int rep_ = 0; rep_ < REPS(3); ++rep_) { if (rep_) xcd_barrier(bar, tid);
    if (IN(3)) {
        mlstm_B(vcu * NTHREADS + tid, G * NTHREADS, UU, UN, CHS, CST, NST, MST, out + O_CP, out + O_NP, out + O_MP);
        for (int su = vcu; su < 64; su += G) sample_select_unit(su, QS, KMS, SEL, lds, tid);
    }
    }
    SEAM(3);
    for (int rep_ = 0; rep_ < REPS(4); ++rep_) { if (rep_) xcd_barrier(bar, tid);
    if (IN(4)) {
#ifndef P4_MASK
#define P4_MASK 0xf
#endif
        {
            gu32* qhead = ctl + CW_P4Q;
            LAS unsigned* qslot = (LAS unsigned*)(lds + MISC_OFF + 64);
            const bool stat = (G >= 128);
            int u = (stat && vcu < 128) ? vcu : -1;
            for (;;) {
                if (u < 0) {
                    if (tid == 0) *qslot = (stat ? 128u : 0u) + __hip_atomic_fetch_add(qhead, 1u, __ATOMIC_RELAXED, __HIP_MEMORY_SCOPE_AGENT);
                    WG_BAR();
                    u = (int)*qslot;
                    WG_BAR();
                }
                if (u >= 928) break;
                int tid_o = tid; asm volatile("" : "+v"(tid_o)); const int lane_o = tid_o & 63, wave_o = __builtin_amdgcn_readfirstlane(tid_o >> 6);
                if (u < 128) { const int item = u;
                const int bh16 = item >> 3, x = item & 7;
                const u16* Qb = AQ + (size_t)bh16 * TP * AD; const u16* Kb = AK + (size_t)bh16 * TP * AD; const u16* Vb = AV + (size_t)bh16 * TP * AD;
                const int b = bh16 >> 3, h = bh16 & 7;
                u16* Ob = MIXED + (size_t)b * TP * DM + MW + h * AD;
                const moba::HeadRef H{Qb, Kb, Vb};
                moba::BlockRef c0{Ob + (size_t)(15 - x) * 256 * DM, 15 - x, 0, 4 * (16 - x), nullptr, nullptr};
                moba::BlockRef c1{Ob + (size_t)x * 256 * DM, x, 0, 4 * (x + 1), nullptr, nullptr};
                moba::Seam S;
                moba_select(bh16, c0.own, AQ, KMP, (LAS unsigned*)(lds + SELT_OFF), (LAS float*)(lds + KML_OFF), tid_o);
                moba::moba_prime(H, c0, (char*)lds_raw, S, tid_o);
                moba::moba_block<0>(H, c0, c1, (char*)lds_raw, S, (const unsigned*)(lds_raw + SELT_OFF), nullptr, tid_o);
                asm volatile("" : "+v"(tid_o));
                moba_select(bh16, c1.own, AQ, KMP, (LAS unsigned*)(lds + SELT_OFF), (LAS float*)(lds + KML_OFF), tid_o);
                __syncthreads();
                moba::moba_block<0>(H, c1, c1, (char*)lds_raw, S, (const unsigned*)(lds_raw + SELT_OFF), nullptr, tid_o);
                }
                else if (u < 160) sample_mlstm_unit(u - 128, QKVO, GATES, st_C, st_n, st_m, gmn, out + O_CS, out + O_NS, out + O_MS, MIXED, lds, tid_o, wave_o, lane_o);
                else if (u < 416) mlstm_C_unit(u - 160, MQ, MK, MV, MO, GATES, CST, NST, MST, gmn, MIXED, lds, tid_o, wave_o, lane_o);
                else sample_attend_unit(u - 416, QS, KSN, VSN, cache_k, cache_v, page_table, SEL, MIXED, lds, tid_o, wave_o, lane_o);
                u = -1;
            }
        }
    }
    }
    SEAM(4);
    for (int rep_ = 0; rep_ < REPS(5); ++rep_) { if (rep_) xcd_barrier(bar, tid);
    if (IN(5)) {
        pg8::Gemm g{MIXED, WOUT, MP, DM, DM}; pg8::StaticOrder S; S.init(MP, DM, G, bx);
        EpiRes<true> E{x_p, X1, X1G, g2, SS1};
        pg8::gemm_phase<EpiRes<true>, pg8::StaticOrder, true, true>(lds, g, S, E, tid);
        for (int su = vcu; su < 64; su += G) { const int pn = su >> 3, j = su & 7, ca = pn * 256 + 16 * j;
            skinny_unit(MIXED + (size_t)MP * DM, WOUT, DM, ca, ca + 128, lds, tid, wave, lane);
            skinny_epi_res<true>(su, ca, (const LAS float*)(lds + 65536), x_s, X1 + (size_t)MP * DM, X1G + (size_t)MP * DM, g2, SSS1, tid);
            WG_BAR(); }
    }
    }
    SEAM(5);
    for (int rep_ = 0; rep_ < REPS(6); ++rep_) { if (rep_) xcd_barrier(bar, tid);
    if (IN(6)) {
        pg8::Gemm g{X1G, WUP, MP, NUP, DM}; pg8::StaticOrder S; S.init(MP, NUP, G, bx);
        EpiUp E{lds + XCH_OFF, SS1, conv_w, conv_b, ACT, UB, ctl + CW_UPCNT, out + O_CVP, (void*)(ws + 600 * MiB)};
        pg8::gemm_phase<EpiUp, pg8::StaticOrder, true, true>(lds, g, S, E, tid);
        const bool half_idle = (G == 256);
        const int ncv = half_idle ? 128 : G, icv = half_idle ? bx - 128 : vcu;
        if (!half_idle || bx >= 128) {
            LAS float* scr = (LAS float*)(lds + wave * 16640);
            for (int it = icv * NWAVES + wave; it < 88 * 32; it += ncv * NWAVES) { const int kb = it / 32, n0 = (it % 32) * 64; transpose_item(w_down, DFF, DM, WDN, kb * 64, n0, n0, scr, lane); }
            WG_BAR();
            LAS float* RSTDL = (LAS float*)(lds + 65536 + 8192);
            { const int row = tid >> 3, part = tid & 7; const f32x4 a = ldg4(SSS1 + row * 64 + 8 * part), b4 = ldg4(SSS1 + row * 64 + 8 * part + 4);
              float s = ((a[0] + a[1]) + (a[2] + a[3])) + ((b4[0] + b4[1]) + (b4[2] + b4[3])); s += __shfl_xor(s, 1); s += __shfl_xor(s, 2); s += __shfl_xor(s, 4);
              if (part == 0) RSTDL[row] = 1.0f / sqrtf(s * (1.0f / DM) + EPS); }
            WG_BAR();
            for (int su = icv; su < 352; su += ncv) { const int pn = su >> 3, j = su & 7, ca = pn * 256 + 16 * j;
                skinny_unit(X1G + (size_t)MP * DM, WUP, DM, ca, ca + 128, lds, tid, wave, lane);
                skinny_epi_up(pn, j, (LAS float*)(lds + 65536), RSTDL, st_conv, conv_w, conv_b, ACT + (size_t)MP * DFF, out + O_CVS, tid);
                WG_BAR(); }
        }
    }
    }
    SEAM(6);
#ifdef DBG_CHECK
    if (lo == 102) {
        LAS float* L = (LAS float*)lds;
        for (int s = bx; s < 2048; s += G) {
#if DBG_CHECK == 1
            const int bh = s >> 8, c = (s >> 3) & 31, w = s & 7, tl = 16 * w + ((c + 3 * w) & 15);
            dbg_mlstm_token(bh, c, tl, MQ, MK, MV, MO, GATES, CST, NST, MST, gmn, MIXED, L, ctl, tid, DBG_CLS_M(bh, c, w, tl));
#elif DBG_CHECK == 2
            const int bh16 = s >> 7, own = (s >> 3) & 15, r = s & 7, t = own * 256 + 32 * r + ((own * 5 + r * 3) & 31);
            dbg_attn_token(bh16, t, AQ, AK, AV, MIXED, L, ctl, tid, DBG_CLS_A(bh16, own, r, t));
#elif DBG_CHECK == 4
            if (s < 512) { const int row = s >> 3, head = s & 7; dbg_qs_token(row, head, x_s, g1, w_in, QS, L, ctl, tid, head); }
#else
            if (s < 512) { const int b = s >> 6, q = (s >> 3) & 7, h = s & 7; dbg_sattn_token(b, q, h, QS, KSN, VSN, cache_k, cache_v, page_table, MIXED, L, ctl, tid, DBG_CLS_S(b, q, h)); }
#endif
        }
    }
    if (lo == 101 && bx == 0 && tid < 14) {
        size_t o0 = 0, o1 = 0;
#define DBG_O(k, A, B) if (tid == (k)) { o0 = (A); o1 = (B); }
        DBG_O(0, O_YP, O_YS) DBG_O(1, O_YS, O_KP) DBG_O(2, O_KP, O_VP) DBG_O(3, O_VP, O_KS) DBG_O(4, O_KS, O_VS) DBG_O(5, O_VS, O_CP) DBG_O(6, O_CP, O_NP) DBG_O(7, O_NP, O_MP)
        DBG_O(8, O_MP, O_CS) DBG_O(9, O_CS, O_NS) DBG_O(10, O_NS, O_MS) DBG_O(11, O_MS, O_CVP) DBG_O(12, O_CVP, O_CVS) DBG_O(13, O_CVS, O_END)
#undef DBG_O
        const unsigned cnt = __hip_atomic_load(ctl + 20000 + tid, RLX_AGENT);
        for (size_t i = 0; i < cnt && o0 + i < o1; ++i) *(GAS unsigned*)(out + o0 + i) = 0xAAAAAAAAu;
    }
#endif
#ifdef DBG_UFULL
    if (lo == 100) {
        const float* UF = (const float*)(ws + 600 * MiB);
        for (size_t idx = (size_t)bx * NTHREADS + tid; idx < (size_t)MP * DFF; idx += (size_t)G * NTHREADS) {
            const int row = (int)(idx / DFF), j = (int)(idx % DFF), t = row & (TP - 1), pn = j >> 7, tc = j & 127;
            float cv[2];
            for (int h2 = 0; h2 < 2; ++h2) { const int oc = h2 * DFF + j; const size_t ui = (size_t)pn * 256 + h2 * 128 + tc;
                const float u0 = ldgf(UF + (size_t)row * NUP + ui), um1 = t >= 1 ? ldgf(UF + (size_t)(row - 1) * NUP + ui) : 0.f, um2 = t >= 2 ? ldgf(UF + (size_t)(row - 2) * NUP + ui) : 0.f;
                cv[h2] = ldgf(conv_b + oc) + ldgf(conv_w + oc) * um2 + ldgf(conv_w + NUP + oc) * um1 + ldgf(conv_w + 2 * NUP + oc) * u0; }
            const float a = cv[0] / (1.0f + __expf(-cv[0])) * cv[1];
#ifdef DBG_CMP
            { const float mine = bf2f(*(const GAS u16*)(ACT + (size_t)row * DFF + j)); const int cls = DBG_CLS(row, j);
              if (fabsf(mine - a) > 0.02f + 0.02f * fabsf(a) && cls < 14) { gu32* cw_ = ctl + 20000 + cls; if (__hip_atomic_load(cw_, RLX_AGENT) < 4000000u) __hip_atomic_fetch_add(cw_, 1u, RLX_AGENT); } }
#else
            *(GAS u16*)(ACT + (size_t)row * DFF + j) = (u16)f2bf(a);
#endif
        }
    }
#ifdef DBG_CMP
    if (lo == 101 && bx == 0 && tid < 14) {
        const size_t offs[15] = {O_YP, O_YS, O_KP, O_VP, O_KS, O_VS, O_CP, O_NP, O_MP, O_CS, O_NS, O_MS, O_CVP, O_CVS, O_END};
        size_t o0 = 0, o1 = 0;
        for (int k = 0; k < 14; ++k) if (k == tid) { o0 = offs[k]; o1 = offs[k + 1]; }
        const unsigned cnt = __hip_atomic_load(ctl + 20000 + tid, RLX_AGENT);
        for (size_t i = 0; i < cnt && o0 + i < o1; ++i) *(GAS unsigned*)(out + o0 + i) = 0xAAAAAAAAu;
    }
#endif
#endif
    for (int rep_ = 0; rep_ < REPS(7); ++rep_) { if (rep_) xcd_barrier(bar, tid);
    if (IN(7)) {
        pg8::Gemm g{ACT, WDN, MP, DM, DFF}; pg8::StaticOrder S; S.init(MP, DM, G, bx);
        EpiRes<false> E{X1, out + O_YP, nullptr, nullptr, SS2};
        pg8::gemm_phase<EpiRes<false>, pg8::StaticOrder, true, true>(lds, g, S, E, tid);
        for (int su = vcu; su < 64; su += G) { const int pn = su >> 3, j = su & 7, ca = pn * 256 + 16 * j;
            skinny_unit(ACT + (size_t)MP * DFF, WDN, DFF, ca, ca + 128, lds, tid, wave, lane);
            skinny_epi_res<false>(su, ca, (const LAS float*)(lds + 65536), X1 + (size_t)MP * DM, out + O_YS, nullptr, nullptr, SSS2, tid);
            WG_BAR(); }
    }
    }
    SEAM(7);
    if (IN(8)) {
        for (int m = gw; m < MT; m += NGW) {
            float s; float* p;
            if (m < MP) { s = lane < 32 ? ldgf(SS2 + (size_t)m * 32 + lane) : 0.f; p = out + O_YP + (size_t)m * DM; }
            else { s = ldgf(SSS2 + (m - MP) * 64 + lane); p = out + O_YS + (size_t)(m - MP) * DM; }
            const float rstd = 1.0f / sqrtf(wave_sum(s) * (1.0f / DM) + EPS);
#pragma unroll
            for (int i = 0; i < 8; ++i) { const f32x4 v = ldg4(p + 256 * i + 4 * lane), g = ldg4(gf + 256 * i + 4 * lane); stg4(p + 256 * i + 4 * lane, v * rstd * g * DBG_YS(m)); }
        }
#ifdef DBG_SCALE_MASK
#define DBG_SC(j, A, B) if ((DBG_SCALE_MASK >> (j)) & 1) for (size_t i = (A) + (size_t)bx * NTHREADS + tid; i < (B); i += (size_t)G * NTHREADS) stgf(out + i, DBG_SCALE_F * ldgf(out + i));
        DBG_SC(2, O_KP, O_VP) DBG_SC(3, O_VP, O_KS) DBG_SC(4, O_KS, O_VS) DBG_SC(5, O_VS, O_CP) DBG_SC(6, O_CP, O_NP) DBG_SC(7, O_NP, O_MP)
        DBG_SC(8, O_MP, O_CS) DBG_SC(9, O_CS, O_NS) DBG_SC(10, O_NS, O_MS) DBG_SC(11, O_MS, O_CVP) DBG_SC(12, O_CVP, O_CVS) DBG_SC(13, O_CVS, O_END)
#undef DBG_SC
#endif
    }
#ifdef DBG_TIMING
    STAMP(9);
    if (bx == 0) {
        __syncthreads();
        if (tid < 10) { const unsigned long long* ts = (const unsigned long long*)(ctl + 30000);
            unsigned long long t0 = 0, t1 = 0; size_t o0 = 0;
#define DBG_T(k, A, B, O) if (tid == (k)) { t0 = *(const GAS unsigned long long*)(ts + (A)); t1 = *(const GAS unsigned long long*)(ts + (B)); o0 = (O); }
            DBG_T(0, 0, 1, O_YP) DBG_T(1, 1, 2, O_YS) DBG_T(2, 2, 3, O_KP) DBG_T(3, 3, 4, O_VP) DBG_T(4, 4, 5, O_KS) DBG_T(5, 5, 6, O_VS) DBG_T(6, 6, 7, O_CP) DBG_T(7, 7, 8, O_NP) DBG_T(8, 8, 9, O_CVP) DBG_T(9, 0, 9, O_CVS)
#undef DBG_T
            const unsigned us = (unsigned)((t1 - t0) / 100ull); const unsigned bk = (us + DBG_TOFF) / DBG_TBUCKET + 1u;
            for (unsigned i = 0; i < bk && i < 2000; ++i) *(GAS unsigned*)(out + o0 + i) = 0xAAAAAAAAu; }
    }
#endif
#undef IN
#undef SEAM
#undef tid
#undef lane
#undef x_p
#undef x_s
#undef cache_k
#undef cache_v
#undef page_table
#undef st_C
#undef st_n
#undef st_m
#undef st_conv
#undef g1
#undef w_in
#undef b_gates
#undef gmn
#undef w_out
#undef g2
#undef w_up
#undef conv_w
#undef conv_b
#undef w_down
#undef gf
#undef WIN
#undef WOUT
#undef WUP
#undef WDN
#undef RCOS
#undef RSIN
#undef GATES
#undef XN
#undef MQ
#undef MK
#undef MV
#undef MO
#undef AQ
#undef AK
#undef AV
#undef UU
#undef CST
#undef CHS
#undef MST
#undef KMP
#undef UN
#undef NST
#undef QKVO
#undef KMS
#undef QS
#undef KSN
#undef VSN
#undef SEL
#undef SSS1
#undef SSS2
#undef MIXED
#undef X1
#undef X1G
#undef SS1
#undef SS2
#undef ACT
#undef UB
#undef PART
#undef ctl
}

extern "C" void kernel_launch(void* const* d_in, const int* in_sizes, int n_in, void* d_out, int out_size, void* d_ws, size_t ws_size, hipStream_t stream) {
    static int grid = 0;
    if (grid == 0) {
        if (n_in != 20 || (size_t)out_size != O_END || ws_size < WS_END) { fprintf(stderr, "kernel_launch: unexpected shapes (n_in %d, out %d, ws %zu)\n", n_in, out_size, ws_size); grid = -1; return; }
        int dev = 0, cus = 0, per_cu = 0;
        if (hipGetDevice(&dev) != hipSuccess || hipDeviceGetAttribute(&cus, hipDeviceAttributeMultiprocessorCount, dev) != hipSuccess) { grid = -1; return; }
        if (hipFuncSetAttribute((const void*)hymba_fwd, hipFuncAttributeMaxDynamicSharedMemorySize, LDS_BYTES) != hipSuccess) { fprintf(stderr, "kernel_launch: hipFuncSetAttribute failed\n"); grid = -1; return; }
        if (hipOccupancyMaxActiveBlocksPerMultiprocessor(&per_cu, (const void*)hymba_fwd, NTHREADS, LDS_BYTES) != hipSuccess || per_cu < 1) { fprintf(stderr, "kernel_launch: occupancy query says %d\n", per_cu); }
        (void)hipGetLastError();
        grid = cus;
    }
    if (grid < 0) return;
    (void)hipMemsetAsync((char*)d_ws + WS_CTL, 0, CTL_ZERO_BYTES, stream);
    Args a{};
    for (int i = 0; i < 20; ++i) a.in[i] = d_in[i];
    a.out = (float*)d_out; a.ws = (unsigned char*)d_ws;
    for (int li = 0; li < MK_N_LAUNCHES; ++li) {
        if (MK_N_LAUNCHES == 1) { a.ph_lo = 0; a.ph_hi = N_PHASES; } else { a.ph_lo = li; a.ph_hi = li + 1; }
        a.li = (MK_N_LAUNCHES == N_PHASES) ? 0 : li; a.pad = 0;
#ifdef DBG_UFULL
        if (li == 7) { Args a2 = a; a2.ph_lo = 100; a2.ph_hi = 101; hipLaunchKernelGGL(hymba_fwd, dim3(grid), dim3(NTHREADS), LDS_BYTES, stream, a2); }
#endif
        hipLaunchKernelGGL(hymba_fwd, dim3(grid), dim3(NTHREADS), LDS_BYTES, stream, a);
    }
#ifdef DBG_CMP
    { Args a3 = a; a3.ph_lo = 101; a3.ph_hi = 102; hipLaunchKernelGGL(hymba_fwd, dim3(grid), dim3(NTHREADS), LDS_BYTES, stream, a3); }
#endif
#ifdef DBG_CHECK
    { Args a3 = a; a3.ph_lo = 102; a3.ph_hi = 103; hipLaunchKernelGGL(hymba_fwd, dim3(grid), dim3(NTHREADS), LDS_BYTES, stream, a3);
      a3.ph_lo = 101; a3.ph_hi = 102; hipLaunchKernelGGL(hymba_fwd, dim3(grid), dim3(NTHREADS), LDS_BYTES, stream, a3); }
#endif
}
```
